# Optimizing an MI355X kernel written in HIP

```python
import jax, jax.numpy as jnp
from jax import lax
import numpy as np

D_MODEL = 1024
BATCH = 8
SEQ = 4096
DEPTH = 1

D_RNN = D_MODEL // 2
RNN_BLOCKS = 8
RNN_BLOCK = D_RNN // RNN_BLOCKS
CONV_WIDTH = 4
LRU_C = 8.0
N_HEADS = 8
HEAD_DIM = 64
N_KV = 2
REP = N_HEADS // N_KV
D_ATT = N_HEADS * HEAD_DIM
CMP_LEN = 32
CMP_STRIDE = 16
CMP_HIDDEN = 256
SLC_BLOCK = 64
SLC_TOPK = 16
WINDOW = 512
Q_BLOCK = 64
D_FF = 4 * D_MODEL
EPS = 1e-6
NEG = -1e30
FORCED = 1e4

kernel_name = 'hybrid_rglru_nsa_block'


def rms_norm(x, g):
    xf = x.astype(jnp.float32)
    y = xf * lax.rsqrt(jnp.mean(xf * xf, axis=-1, keepdims=True) + EPS)
    return (y * g.astype(jnp.float32)).astype(x.dtype)


def modulate(h, shift, scale):
    return h * (1.0 + scale[:, None, :]) + shift[:, None, :]


def alibi_slopes():
    return jnp.asarray(2.0 ** (-8.0 * np.arange(1, N_HEADS + 1) / N_HEADS), jnp.float32)


def causal_depthwise_conv(x, w, b):
    y = lax.conv_general_dilated(x, w[:, None, :], window_strides=(1,), padding=[(CONV_WIDTH - 1, 0)],
                                 dimension_numbers=('NWC', 'WIO', 'NWC'), feature_group_count=x.shape[-1])
    return y + b


def block_diag(x, w, b):
    xb = x.reshape(x.shape[:-1] + (RNN_BLOCKS, RNN_BLOCK))
    return jnp.einsum('bsni,nij->bsnj', xb, w.astype(jnp.float32)).reshape(x.shape) + b.astype(jnp.float32)


def rg_lru(x, w_a, b_a, w_x, b_x, lam):
    xf = x.astype(jnp.float32)
    r = jax.nn.sigmoid(block_diag(xf, w_a, b_a))
    i = jax.nn.sigmoid(block_diag(xf, w_x, b_x))
    log_a = -LRU_C * r * jax.nn.softplus(-lam.astype(jnp.float32))
    a = jnp.exp(log_a)
    u = jnp.sqrt(-jnp.expm1(2.0 * log_a)) * (i * xf)

    def combine(e1, e2):
        a1, b1 = e1
        a2, b2 = e2
        return a1 * a2, a2 * b1 + b2

    _, h = lax.associative_scan(combine, (a, u), axis=1)
    return h.astype(x.dtype)


def to_heads(t):
    B, S, _ = t.shape
    return t.reshape(B, S, N_KV, HEAD_DIM).transpose(0, 2, 1, 3)


def compress_blocks(k, pos_emb, w1, w2):
    B, G, S, D = k.shape
    n_cmp = (S - CMP_LEN) // CMP_STRIDE + 1
    idx = CMP_STRIDE * jnp.arange(n_cmp)[:, None] + jnp.arange(CMP_LEN)[None, :]
    blocks = (k[:, :, idx] + pos_emb).reshape(B, G, n_cmp, CMP_LEN * D)
    return jax.nn.gelu(blocks @ w1) @ w2


def nsa_attention(q, k_c, v_c, k_s, v_s, k_w, v_w, gate_logits,
                  cmp_pos_k, cmp_w1_k, cmp_w2_k, cmp_pos_v, cmp_w1_v, cmp_w2_v):
    B, S, _ = q.shape
    f32 = jnp.float32
    n_cmp = (S - CMP_LEN) // CMP_STRIDE + 1
    n_slc = S // SLC_BLOCK
    n_sel = min(SLC_TOPK, n_slc)
    n_qb = S // Q_BLOCK
    qh = q.reshape(B, S, N_KV, REP, HEAD_DIM).transpose(0, 2, 3, 1, 4) * (HEAD_DIM ** -0.5)
    kc = compress_blocks(to_heads(k_c), cmp_pos_k, cmp_w1_k, cmp_w2_k)
    vc = compress_blocks(to_heads(v_c), cmp_pos_v, cmp_w1_v, cmp_w2_v).astype(f32)
    ks = to_heads(k_s).reshape(B, N_KV, n_slc, SLC_BLOCK, HEAD_DIM)
    vs = to_heads(v_s).reshape(B, N_KV, n_slc, SLC_BLOCK, HEAD_DIM)
    pad = ((0, 0), (0, 0), (WINDOW, 0), (0, 0))
    kw = jnp.pad(to_heads(k_w), pad)
    vw = jnp.pad(to_heads(v_w), pad)
    gates = jax.nn.sigmoid(gate_logits.astype(f32)).reshape(B, S, 3, N_KV, REP).transpose(2, 0, 3, 4, 1)
    slopes = alibi_slopes().reshape(1, N_KV, REP, 1, 1)
    c_start = CMP_STRIDE * jnp.arange(n_cmp)
    cmp_end = c_start + (CMP_LEN - 1)
    s_start = SLC_BLOCK * jnp.arange(n_slc)
    overlap = ((c_start[:, None] < s_start[None, :] + SLC_BLOCK) &
               (c_start[:, None] + CMP_LEN > s_start[None, :])).astype(f32)
    blk_ids = jnp.arange(n_slc)
    gather = jax.vmap(jax.vmap(lambda kb, ix: kb[ix]))

    def one_block(i):
        q0 = i * Q_BLOCK
        qb = lax.dynamic_slice_in_dim(qh, q0, Q_BLOCK, axis=3)
        t = q0 + jnp.arange(Q_BLOCK)
        d_c = (t[:, None] - cmp_end[None, :]).astype(f32)
        sc = jnp.einsum('bgrqd,bgcd->bgrqc', qb, kc).astype(f32) - slopes * d_c
        sc = jnp.where(d_c >= 0, sc, NEG)
        p_c = jax.nn.softmax(sc, axis=-1) * (t >= CMP_LEN - 1).astype(f32)[:, None]
        o_c = jnp.einsum('bgrqc,bgcd->bgrqd', p_c, vc)
        imp = jnp.einsum('bgrqc,cj->bgqj', p_c, overlap)
        cur = t // SLC_BLOCK
        forced = (blk_ids[None, :] == 0) | (blk_ids[None, :] == cur[:, None]) | (blk_ids[None, :] == cur[:, None] - 1)
        visible = s_start[None, :] <= t[:, None]
        imp = jnp.where(forced, FORCED, jnp.where(visible, imp, NEG))
        _, sel = lax.top_k(imp, n_sel)
        k_sel = gather(ks, sel)
        v_sel = gather(vs, sel).astype(f32)
        pos = sel[..., None] * SLC_BLOCK + jnp.arange(SLC_BLOCK)
        d_s = (t[:, None, None] - pos).astype(f32)[:, :, None]
        ss = jnp.einsum('bgrqd,bgqnkd->bgrqnk', qb, k_sel).astype(f32) - slopes[..., None] * d_s
        ss = jnp.where(d_s >= 0, ss, NEG)
        p_s = jax.nn.softmax(ss.reshape(ss.shape[:4] + (-1,)), axis=-1).reshape(ss.shape)
        o_s = jnp.einsum('bgrqnk,bgqnkd->bgrqd', p_s, v_sel)
        kwb = lax.dynamic_slice_in_dim(kw, q0, WINDOW + Q_BLOCK, axis=2)
        vwb = lax.dynamic_slice_in_dim(vw, q0, WINDOW + Q_BLOCK, axis=2).astype(f32)
        s_pos = q0 - WINDOW + jnp.arange(WINDOW + Q_BLOCK)
        d_w = (t[:, None] - s_pos[None, :]).astype(f32)
        ok = (d_w >= 0) & (d_w < WINDOW) & (s_pos[None, :] >= 0)
        sw = jnp.einsum('bgrqd,bgkd->bgrqk', qb, kwb).astype(f32) - slopes * d_w
        sw = jnp.where(ok, sw, NEG)
        o_w = jnp.einsum('bgrqk,bgkd->bgrqd', jax.nn.softmax(sw, axis=-1), vwb)
        gb = lax.dynamic_slice_in_dim(gates, q0, Q_BLOCK, axis=4)[..., None]
        return gb[0] * o_c + gb[1] * o_s + gb[2] * o_w

    out = lax.map(one_block, jnp.arange(n_qb))
    return out.transpose(1, 0, 4, 2, 3, 5).reshape(B, S, D_ATT).astype(q.dtype)


def hybrid_mixer(h, w_in, conv_w, conv_b, lru_wa, lru_ba, lru_wx, lru_bx, lru_lambda,
                 cmp_pos_k, cmp_w1_k, cmp_w2_k, cmp_pos_v, cmp_w1_v, cmp_w2_v,
                 norm_rnn_out, norm_att_out, w_out):
    sizes = [D_RNN, D_RNN, D_ATT] + [N_KV * HEAD_DIM] * 6 + [3 * N_HEADS]
    splits = np.cumsum(sizes)[:-1].tolist()
    z = h @ w_in
    g_rnn, x_rnn, q, k_c, v_c, k_s, v_s, k_w, v_w, gate_logits = jnp.split(z, splits, axis=-1)
    rnn = jax.nn.gelu(g_rnn) * rg_lru(causal_depthwise_conv(x_rnn, conv_w, conv_b),
                                      lru_wa, lru_ba, lru_wx, lru_bx, lru_lambda)
    att = nsa_attention(q, k_c, v_c, k_s, v_s, k_w, v_w, gate_logits,
                        cmp_pos_k, cmp_w1_k, cmp_w2_k, cmp_pos_v, cmp_w1_v, cmp_w2_v)
    y = jnp.concatenate([rms_norm(rnn, norm_rnn_out), rms_norm(att, norm_att_out)], axis=-1)
    return y @ w_out


def setup_inputs(seed: int = 0) -> dict:
    key = jax.random.key(seed)
    ks = jax.random.split(key, 32)
    L = DEPTH
    f32 = jnp.float32

    def nrm(k, shape, scale):
        return jax.random.normal(k, shape, f32) * scale

    def gain(k, n):
        return 1.0 + 0.05 * jax.random.normal(k, (L, n), f32)

    d_in = 2 * D_RNN + D_ATT + 6 * N_KV * HEAD_DIM + 3 * N_HEADS
    u = jax.random.uniform(ks[31], (L, D_RNN), f32, minval=0.9, maxval=0.999)
    a0 = u ** (1.0 / LRU_C)
    lam = jnp.log(a0) - jnp.log1p(-a0)
    return {
        'x': nrm(ks[0], (BATCH, SEQ, D_MODEL), 1.0),
        'c': nrm(ks[1], (BATCH, D_MODEL), 1.0),
        'ada_w': nrm(ks[2], (L, D_MODEL, 6 * D_MODEL), 0.1 * D_MODEL ** -0.5),
        'ada_b': nrm(ks[3], (L, 6 * D_MODEL), 0.01),
        'pre_norm_mix': gain(ks[4], D_MODEL),
        'w_in': nrm(ks[5], (L, D_MODEL, d_in), D_MODEL ** -0.5),
        'conv_w': nrm(ks[6], (L, CONV_WIDTH, D_RNN), CONV_WIDTH ** -0.5),
        'conv_b': nrm(ks[7], (L, D_RNN), 0.01),
        'lru_wa': nrm(ks[8], (L, RNN_BLOCKS, RNN_BLOCK, RNN_BLOCK), RNN_BLOCK ** -0.5),
        'lru_ba': nrm(ks[9], (L, D_RNN), 0.01),
        'lru_wx': nrm(ks[10], (L, RNN_BLOCKS, RNN_BLOCK, RNN_BLOCK), RNN_BLOCK ** -0.5),
        'lru_bx': nrm(ks[11], (L, D_RNN), 0.01),
        'lru_lambda': lam,
        'cmp_pos_k': nrm(ks[12], (L, CMP_LEN, HEAD_DIM), 0.1),
        'cmp_w1_k': nrm(ks[13], (L, CMP_LEN * HEAD_DIM, CMP_HIDDEN), (CMP_LEN * HEAD_DIM) ** -0.5),
        'cmp_w2_k': nrm(ks[14], (L, CMP_HIDDEN, HEAD_DIM), CMP_HIDDEN ** -0.5),
        'cmp_pos_v': nrm(ks[15], (L, CMP_LEN, HEAD_DIM), 0.1),
        'cmp_w1_v': nrm(ks[16], (L, CMP_LEN * HEAD_DIM, CMP_HIDDEN), (CMP_LEN * HEAD_DIM) ** -0.5),
        'cmp_w2_v': nrm(ks[17], (L, CMP_HIDDEN, HEAD_DIM), CMP_HIDDEN ** -0.5),
        'norm_rnn_out': gain(ks[18], D_RNN),
        'norm_att_out': gain(ks[19], D_ATT),
        'w_out': nrm(ks[20], (L, D_RNN + D_ATT, D_MODEL), (D_RNN + D_ATT) ** -0.5),
        'post_norm_mix': gain(ks[21], D_MODEL),
        'pre_norm_mlp': gain(ks[22], D_MODEL),
        'w_ff1': nrm(ks[23], (L, D_MODEL, D_FF), D_MODEL ** -0.5),
        'w_ff2': nrm(ks[24], (L, D_FF, D_MODEL), D_FF ** -0.5),
        'post_norm_mlp': gain(ks[25], D_MODEL),
    }


def reference(x, c, ada_w, ada_b, pre_norm_mix, w_in, conv_w, conv_b, lru_wa, lru_ba, lru_wx, lru_bx,
              lru_lambda, cmp_pos_k, cmp_w1_k, cmp_w2_k, cmp_pos_v, cmp_w1_v, cmp_w2_v,
              norm_rnn_out, norm_att_out, w_out, post_norm_mix, pre_norm_mlp, w_ff1, w_ff2, post_norm_mlp):
    for l in range(DEPTH):
        mod = jax.nn.silu(c) @ ada_w[l] + ada_b[l]
        sh1, sc1, g1, sh2, sc2, g2 = jnp.split(mod, 6, axis=-1)
        h = modulate(rms_norm(x, pre_norm_mix[l]), sh1, sc1)
        y = hybrid_mixer(h, w_in[l], conv_w[l], conv_b[l], lru_wa[l], lru_ba[l], lru_wx[l], lru_bx[l],
                         lru_lambda[l], cmp_pos_k[l], cmp_w1_k[l], cmp_w2_k[l], cmp_pos_v[l], cmp_w1_v[l],
                         cmp_w2_v[l], norm_rnn_out[l], norm_att_out[l], w_out[l])
        x = x + (1.0 + g1[:, None, :]) * rms_norm(y, post_norm_mix[l])
        h = modulate(rms_norm(x, pre_norm_mlp[l]), sh2, sc2)
        y = jnp.square(jax.nn.relu(h @ w_ff1[l])) @ w_ff2[l]
        x = x + (1.0 + g2[:, None, :]) * rms_norm(y, post_norm_mlp[l])
    return x
```

```cpp
#include <hip/hip_runtime.h>
#include <hip/hip_cooperative_groups.h>
#include <cstdio>
#include <cstdint>
namespace cg = cooperative_groups;

#define LAS __attribute__((address_space(3)))
typedef unsigned short bf16_t;
typedef short bf16x8 __attribute__((ext_vector_type(8)));
typedef short s16x4 __attribute__((ext_vector_type(4)));
typedef float f32x4 __attribute__((ext_vector_type(4)));
typedef float f32x16 __attribute__((ext_vector_type(16)));
typedef unsigned u32x4 __attribute__((ext_vector_type(4)));
typedef unsigned u32x2 __attribute__((ext_vector_type(2)));

namespace pg8 {
constexpr int BM = 256, BK = 64, HALF = 128, HTB = HALF * BK * 2, STAGE_BYTES = 8 * HTB, NXCD = 8, WGM = 8;
__host__ __device__ __forceinline__ int lds_byte(int r, int c) { const int st = (r >> 4) * 2 + (c >> 5), rr = r & 15, cc = c & 31, ob = rr * 64 + cc * 2; return st * 1024 + (ob ^ (((ob >> 9) & 1) << 5)); }
__host__ __device__ __forceinline__ void stage_rc(int b, int& R, int& C) { const int st = b / 1024, sb = b % 1024, swz = sb ^ (((sb >> 9) & 1) << 5); R = (st >> 1) * 16 + swz / 64; C = (st & 1) * 32 + (swz % 64) / 2; }
__host__ __device__ __forceinline__ int perm32(int rho) { const int n = rho >> 4, i = rho & 15; return 8 * (i >> 2) + 4 * n + (i & 3); }

struct Unit { int pm, pn; };
struct Gemm { const bf16_t* A; const bf16_t* Bt; int M, N, K, lda; };

struct StaticOrder {
    int nM, nN, nwg, G, c;
    __device__ void init(int M, int N, int G_, int c_) { nM = M / BM; nN = N / BM; nwg = nM * nN; G = G_; c = c_; }
    __device__ bool next(int i, Unit& u) const {
        const long L = (long)i * G + c; if (L >= nwg) return false;
        int wgid = (int)L; { const int q = nwg / NXCD, r = nwg % NXCD, xcd = wgid % NXCD, off = wgid / NXCD; wgid = (xcd < r ? xcd * (q + 1) : r * (q + 1) + (xcd - r) * q) + off; }
        const int nig = WGM * nN, gid = wgid / nig, fm = gid * WGM, gsz = (nM - fm) < WGM ? (nM - fm) : WGM;
        u.pm = fm + ((wgid % nig) % gsz); u.pn = (wgid % nig) / gsz; return true;
    }
};
struct ColOrder {
    int nM, G, c;
    __device__ bool next(int i, Unit& u) const { const long L = (long)i * G + c; if (c < 0 || L >= nM) return false; u.pm = (int)L; u.pn = 0; return true; }
};

__device__ __forceinline__ unsigned cvt_pk_bf16(float lo, float hi) { unsigned r; asm volatile("v_cvt_pk_bf16_f32 %0, %1, %2" : "=v"(r) : "v"(lo), "v"(hi)); return r; }

template <class Epi, class Sched>
__device__ __forceinline__ void gemm_phase(LAS unsigned char* lds, const Gemm g, const Sched& S, const Epi& E) {
    int tid = threadIdx.x; asm volatile("" : "+v"(tid));
    const int wid = __builtin_amdgcn_readfirstlane(tid >> 6), lane = tid & 63, wr = wid >> 2, wc = wid & 3, fr = lane & 15, fq = lane >> 4;
    const int K = g.K, nt = K / BK, lda = g.lda;
    unsigned voffA[2], voffB[2];
#pragma unroll
    for (int i = 0; i < 2; ++i) { int R, C; stage_rc(tid * 16 + i * 8192, R, C); const int Rb = Epi::PERM ? ((R & ~31) + perm32(R & 31)) : R;
        voffA[i] = (unsigned)(R * lda + C) * 2u; voffB[i] = (unsigned)(Rb * K + C) * 2u; }
    const size_t kstep = (size_t)(BK * 2);
    const size_t hstepA = (size_t)HALF * lda * 2, hstepB = (size_t)HALF * K * 2;
    const size_t tstepA = 2 * hstepA, tstepB = 2 * hstepB;
    const unsigned ldsw = (unsigned)wid * 1024u;
    const int aoff = lds_byte(wr * 64 + fr, fq * 8), boff = lds_byte(wc * 32 + fr, fq * 8);
#define PG8_SA(b, h) (((b) * 2 + (h)) * HTB)
#define PG8_SB(b, h) ((4 + (b) * 2 + (h)) * HTB)
#define PG8_STAGE(bufoff, gbase, voff) do { _Pragma("unroll") for (int _i = 0; _i < 2; ++_i) \
        __builtin_amdgcn_global_load_lds((const unsigned*)((const char*)(gbase) + (voff)[_i]), (LAS unsigned*)(lds + (bufoff) + ldsw + _i * 8192), 16, 0, 0); } while (0)
#define PG8_LDA(dst, b, h) do { _Pragma("unroll") for (int m = 0; m < 4; ++m) _Pragma("unroll") for (int k = 0; k < 2; ++k) dst[m][k] = *(const LAS bf16x8*)(lds + PG8_SA(b, h) + aoff + m * 2048 + k * 1024); } while (0)
#define PG8_LDB(dst, b, h) do { _Pragma("unroll") for (int n = 0; n < 2; ++n) _Pragma("unroll") for (int k = 0; k < 2; ++k) dst[n][k] = *(const LAS bf16x8*)(lds + PG8_SB(b, h) + boff + n * 2048 + k * 1024); } while (0)
#define PG8_MMA(ai, bj, At, Bt) do { __builtin_amdgcn_s_setprio(1); _Pragma("unroll") for (int m = 0; m < 4; ++m) _Pragma("unroll") for (int n = 0; n < 2; ++n) _Pragma("unroll") for (int k = 0; k < 2; ++k) \
        acc[ai][bj][m][n] = __builtin_amdgcn_mfma_f32_16x16x32_bf16(Bt[n][k], At[m][k], acc[ai][bj][m][n], 0, 0, 0); __builtin_amdgcn_s_setprio(0); } while (0)
#define PG8_WAIT_V(n) asm volatile("s_waitcnt vmcnt(" #n ")" ::: "memory")
#define PG8_WAIT_L(n) asm volatile("s_waitcnt lgkmcnt(" #n ")" ::: "memory")
#define PG8_BAR __builtin_amdgcn_s_barrier()
#define PG8_SCHED __builtin_amdgcn_sched_barrier(0)
    Unit cur, nxt; int ui = 0;
    if (!S.next(0, cur)) return;
    f32x4 acc[2][2][4][2];
#pragma unroll
    for (int a = 0; a < 2; ++a)
#pragma unroll
        for (int b = 0; b < 2; ++b)
#pragma unroll
            for (int m = 0; m < 4; ++m)
#pragma unroll
                for (int n = 0; n < 2; ++n) acc[a][b][m][n] = (f32x4){0.f, 0.f, 0.f, 0.f};
    bf16x8 At[4][2], B0[2][2], B1[2][2];
    const char* cA = (const char*)g.A + (size_t)cur.pm * tstepA; const char* cB = (const char*)g.Bt + (size_t)cur.pn * tstepB;
    PG8_STAGE(PG8_SB(0, 0), cB, voffB); PG8_STAGE(PG8_SB(0, 1), cB + hstepB, voffB); PG8_STAGE(PG8_SA(0, 0), cA, voffA); PG8_STAGE(PG8_SA(0, 1), cA + hstepA, voffA);
    if (wr == 1) PG8_BAR;
    PG8_WAIT_V(2); PG8_BAR;
    PG8_STAGE(PG8_SB(1, 0), cB + kstep, voffB); PG8_STAGE(PG8_SA(1, 0), cA + kstep, voffA); PG8_STAGE(PG8_SB(1, 1), cB + hstepB + kstep, voffB);
    PG8_WAIT_V(6); PG8_BAR;
    for (;;) {
        const bool has_next = S.next(ui + 1, nxt);
        const char* nA = has_next ? (const char*)g.A + (size_t)nxt.pm * tstepA : cA; const char* nB = has_next ? (const char*)g.Bt + (size_t)nxt.pn * tstepB : cB;
        for (int t = 0; t < nt; t += 2) {
            const bool last = (t == nt - 2);
            const char* a1 = cA + (size_t)(t + 1) * kstep;
            const char* a2 = last ? nA : cA + (size_t)(t + 2) * kstep; const char* b2 = last ? nB : cB + (size_t)(t + 2) * kstep;
            const char* a3 = a2 + kstep; const char* b3 = b2 + kstep;
            PG8_LDB(B0, 0, 0); PG8_LDB(B1, 0, 1); PG8_SCHED; PG8_LDA(At, 0, 0); PG8_STAGE(PG8_SA(1, 1), a1 + hstepA, voffA);
            PG8_WAIT_V(8); PG8_WAIT_L(0); PG8_BAR; PG8_MMA(0, 0, At, B0); PG8_MMA(0, 1, At, B1); PG8_BAR; PG8_SCHED;
            PG8_LDA(At, 0, 1); PG8_STAGE(PG8_SB(0, 0), b2, voffB); PG8_STAGE(PG8_SB(0, 1), b2 + hstepB, voffB); PG8_STAGE(PG8_SA(0, 0), a2, voffA);
            PG8_WAIT_V(8); PG8_WAIT_L(0); PG8_BAR; PG8_MMA(1, 0, At, B0); PG8_MMA(1, 1, At, B1); PG8_BAR; PG8_SCHED;
            PG8_LDB(B0, 1, 0); PG8_LDB(B1, 1, 1); PG8_SCHED; PG8_LDA(At, 1, 0); PG8_STAGE(PG8_SA(0, 1), a2 + hstepA, voffA);
            PG8_WAIT_V(8); PG8_WAIT_L(0); PG8_BAR; PG8_MMA(0, 0, At, B0); PG8_MMA(0, 1, At, B1); PG8_BAR; PG8_SCHED;
            PG8_LDA(At, 1, 1); PG8_STAGE(PG8_SB(1, 0), b3, voffB); PG8_STAGE(PG8_SB(1, 1), b3 + hstepB, voffB); PG8_STAGE(PG8_SA(1, 0), a3, voffA);
            PG8_WAIT_V(8); PG8_WAIT_L(0); PG8_BAR; PG8_MMA(1, 0, At, B0); PG8_MMA(1, 1, At, B1); PG8_BAR; PG8_SCHED;
        }
        if (wr == 0) PG8_BAR;
        E(acc, cur, wr, wc, fr, fq);
        if (!has_next) break;
#pragma unroll
        for (int a = 0; a < 2; ++a)
#pragma unroll
            for (int b = 0; b < 2; ++b)
#pragma unroll
                for (int m = 0; m < 4; ++m)
#pragma unroll
                    for (int n = 0; n < 2; ++n) acc[a][b][m][n] = (f32x4){0.f, 0.f, 0.f, 0.f};
        cur = nxt; cA = nA; cB = nB; ++ui;
        if (wr == 1) PG8_BAR;
    }
    PG8_WAIT_V(0);
    PG8_BAR;
#undef PG8_SA
#undef PG8_SB
#undef PG8_STAGE
#undef PG8_LDA
#undef PG8_LDB
#undef PG8_MMA
#undef PG8_WAIT_V
#undef PG8_WAIT_L
#undef PG8_BAR
#undef PG8_SCHED
}
}

constexpr int BATCH = 8, SEQ = 4096, DM = 1024, M = BATCH * SEQ, NZ = 2560, DFF = 4096, NMOD = 6 * DM;
constexpr float EPS = 1e-6f, NEGF = -1e30f, LOG2E = 1.4426950408889634f;
constexpr size_t MiB = 1u << 20, KiB = 1024;
constexpr size_t WS_MOD = 64 * KiB;
constexpr size_t WS_CB1P = 320 * KiB;
constexpr size_t WS_CB1 = 384 * KiB;
constexpr size_t WS_LRUC = 400 * KiB;
constexpr size_t WS_WAT = 448 * KiB, WS_WXT = 512 * KiB;
constexpr size_t WS_CW2KT = 576 * KiB, WS_CW2VT = 640 * KiB;
constexpr size_t WS_WINT = 2 * MiB, WS_WOUTT = 8 * MiB, WS_WFF1T = 10 * MiB, WS_WFF2T = 18 * MiB, WS_CW1KT = 26 * MiB, WS_CW1VT = 27 * MiB;
constexpr size_t WS_CHIDK = 28 * MiB, WS_CHIDV = 30 * MiB;
constexpr size_t WS_H = 32 * MiB;
constexpr size_t WS_GRNN = 96 * MiB, WS_XRNN = 128 * MiB, WS_Q = 160 * MiB;
constexpr size_t WS_KV = 192 * MiB, KV_STRIDE = 8 * MiB;
constexpr size_t WS_GATE = 240 * MiB;
constexpr size_t WS_KCMP = 244 * MiB, WS_VCMPT = WS_KCMP + 512 * KiB;
constexpr size_t WS_RA = 246 * MiB, WS_RH = 247 * MiB;
constexpr size_t WS_YCAT = 256 * MiB;
constexpr size_t WS_Y = 320 * MiB;
constexpr size_t WS_HID = 96 * MiB;
constexpr size_t WS_Y2 = 352 * MiB;
constexpr size_t WS_END = 480 * MiB;
constexpr int LDS_BYTES = 147456;

struct Args { const float* in[27]; float* out; unsigned char* ws; };

struct Frame {
    LAS unsigned char* lds; int tid, lane, wave, G, bid; unsigned char* ws; const float* const* in;
};

__device__ __forceinline__ unsigned f2bf(float f) { unsigned u = __builtin_bit_cast(unsigned, f); return (u + 0x7fffu + ((u >> 16) & 1u)) >> 16; }
__device__ __forceinline__ unsigned pk2(float lo, float hi) { return f2bf(lo) | (f2bf(hi) << 16); }
__device__ __forceinline__ float bf2f(bf16_t b) { return __builtin_bit_cast(float, (unsigned)b << 16); }
__device__ __forceinline__ float wave_sum(float v) {
#pragma unroll
    for (int o = 1; o < 64; o <<= 1) v += __shfl_xor(v, o);
    return v;
}
__device__ __forceinline__ float sigmoidf_(float x) { return 1.0f / (1.0f + __expf(-x)); }
__device__ __forceinline__ float gelu_tanh(float v) { const float u = 0.7978845608028654f * (v + 0.044715f * v * v * v); return v / (1.0f + __expf(-2.0f * u)); }
#define LDS_FENCE() asm volatile("s_waitcnt lgkmcnt(0)" ::: "memory")
__device__ __forceinline__ int fresh_tid() { int t = threadIdx.x; asm volatile("" : "+v"(t)); return t; }

struct EpiF32 {
    static constexpr bool PERM = false;
    float* O; int ldc;
    __device__ __forceinline__ void operator()(const f32x4 (&acc)[2][2][4][2], const pg8::Unit& u, int wr, int wc, int fr, int fq) const {
        const int row0 = u.pm * 256 + wr * 64 + fr, col0 = u.pn * 256 + wc * 32 + 4 * fq;
#pragma unroll
        for (int ai = 0; ai < 2; ++ai)
#pragma unroll
            for (int m = 0; m < 4; ++m) { float* rowp = O + (size_t)(row0 + ai * 128 + m * 16) * ldc + col0;
#pragma unroll
                for (int bj = 0; bj < 2; ++bj)
#pragma unroll
                    for (int n = 0; n < 2; ++n) *(f32x4*)(rowp + bj * 128 + n * 16) = acc[ai][bj][m][n]; }
    }
};
template <int ACT  > struct EpiBf16 {
    static constexpr bool PERM = true;
    bf16_t* O; int ldc; const float* bias;
    __device__ __forceinline__ void operator()(const f32x4 (&acc)[2][2][4][2], const pg8::Unit& u, int wr, int wc, int fr, int fq) const {
        const int row0 = u.pm * 256 + wr * 64 + fr, col0 = u.pn * 256 + wc * 32 + 8 * fq;
        f32x4 bv[2][2];
#pragma unroll
        for (int bj = 0; bj < 2; ++bj)
#pragma unroll
            for (int n = 0; n < 2; ++n) bv[bj][n] = (ACT == 2) ? *(const f32x4*)(bias + col0 + bj * 128 + 4 * n) : (f32x4){0.f, 0.f, 0.f, 0.f};
#pragma unroll
        for (int ai = 0; ai < 2; ++ai)
#pragma unroll
            for (int m = 0; m < 4; ++m) { bf16_t* rowp = O + (size_t)(row0 + ai * 128 + m * 16) * ldc + col0;
#pragma unroll
                for (int bj = 0; bj < 2; ++bj) { f32x4 v0 = acc[ai][bj][m][0] + bv[bj][0], v1 = acc[ai][bj][m][1] + bv[bj][1];
#pragma unroll
                    for (int e = 0; e < 4; ++e) {
                        if (ACT == 1) { const float a = fmaxf(v0[e], 0.f), b = fmaxf(v1[e], 0.f); v0[e] = a * a; v1[e] = b * b; }
                        if (ACT == 2) { v0[e] = gelu_tanh(v0[e]); v1[e] = gelu_tanh(v1[e]); } }
                    u32x4 w; w.x = pk2(v0[0], v0[1]); w.y = pk2(v0[2], v0[3]); w.z = pk2(v1[0], v1[1]); w.w = pk2(v1[2], v1[3]);
                    *(u32x4*)(rowp + bj * 128) = w; } }
    }
};
struct EpiZ {
    static constexpr bool PERM = true;
    unsigned char* ws;
    __device__ __forceinline__ void operator()(const f32x4 (&acc)[2][2][4][2], const pg8::Unit& u, int wr, int wc, int fr, int fq) const {
        const int row0 = u.pm * 256 + wr * 64 + fr, pn = u.pn;
        if (pn < 6) {
            bf16_t* base = (bf16_t*)(ws + (pn < 2 ? WS_GRNN : pn < 4 ? WS_XRNN : WS_Q)); const float sc = pn >= 4 ? 0.125f : 1.0f;
            const int col0 = (pn & 1) * 256 + wc * 32 + 8 * fq;
#pragma unroll
            for (int ai = 0; ai < 2; ++ai)
#pragma unroll
                for (int m = 0; m < 4; ++m) { bf16_t* rowp = base + (size_t)(row0 + ai * 128 + m * 16) * 512 + col0;
#pragma unroll
                    for (int bj = 0; bj < 2; ++bj) { const f32x4 v0 = acc[ai][bj][m][0] * sc, v1 = acc[ai][bj][m][1] * sc;
                        u32x4 w; w.x = pk2(v0[0], v0[1]); w.y = pk2(v0[2], v0[3]); w.z = pk2(v1[0], v1[1]); w.w = pk2(v1[2], v1[3]);
                        *(u32x4*)(rowp + bj * 128) = w; } }
        } else if (pn < 9) {
            const int p = pn - 6, g = wc >> 1, d0 = 32 * (wc & 1) + 8 * fq;
            bf16_t* Kb = (bf16_t*)(ws + WS_KV + (size_t)(2 * p) * KV_STRIDE); bf16_t* Vb = (bf16_t*)(ws + WS_KV + (size_t)(2 * p + 1) * KV_STRIDE);
#pragma unroll
            for (int ai = 0; ai < 2; ++ai)
#pragma unroll
                for (int m = 0; m < 4; ++m) { const int row = row0 + ai * 128 + m * 16, b = row >> 12, s = row & 4095;
                    { const f32x4 v0 = acc[ai][0][m][0], v1 = acc[ai][0][m][1];
                      u32x4 w; w.x = pk2(v0[0], v0[1]); w.y = pk2(v0[2], v0[3]); w.z = pk2(v1[0], v1[1]); w.w = pk2(v1[2], v1[3]);
                      *(u32x4*)(Kb + ((size_t)(b * 2 + g) * 4096 + s) * 64 + d0) = w; }
                    if (p == 0) { const f32x4 v0 = acc[ai][1][m][0], v1 = acc[ai][1][m][1];
                      u32x4 w; w.x = pk2(v0[0], v0[1]); w.y = pk2(v0[2], v0[3]); w.z = pk2(v1[0], v1[1]); w.w = pk2(v1[2], v1[3]);
                      *(u32x4*)(Vb + ((size_t)(b * 2 + g) * 4096 + s) * 64 + d0) = w; }
                    else { bf16_t* vp = Vb + ((size_t)(b * 2 + g) * 64 + d0) * 4096 + s;
#pragma unroll
                      for (int n = 0; n < 2; ++n)
#pragma unroll
                          for (int e = 0; e < 4; ++e) vp[(size_t)(4 * n + e) * 4096] = (bf16_t)f2bf(acc[ai][1][m][n][e]); } }
        } else {
            if (wc == 0 && fq < 3) { float* G = (float*)(ws + WS_GATE);
#pragma unroll
                for (int ai = 0; ai < 2; ++ai)
#pragma unroll
                    for (int m = 0; m < 4; ++m) { float* gp = G + (size_t)(row0 + ai * 128 + m * 16) * 24 + 8 * fq;
#pragma unroll
                        for (int n = 0; n < 2; ++n) { f32x4 v = acc[ai][0][m][n];
#pragma unroll
                            for (int e = 0; e < 4; ++e) v[e] = sigmoidf_(v[e]);
                            *(f32x4*)(gp + 4 * n) = v; } } }
        }
    }
};

__device__ __forceinline__ void tr_item(const float* W, int K, int N, bf16_t* WT, int NT, const float* gA, const float* gB, LAS float* scr, int item, int lane) {
    const int nblk = NT / 32, kb = item / nblk, nb = item % nblk, k0 = 64 * kb, n0 = 32 * nb;
#pragma unroll 8
    for (int i = 0; i < 32; ++i) { const int kk = 2 * i + (lane >> 5), n = n0 + (lane & 31), k = k0 + kk;
        float v = (n < N) ? W[(size_t)k * N + n] : 0.f;
        if (gA) v *= (k < 512) ? gA[k] : gB[k - 512];
        scr[kk * 33 + (lane & 31)] = v; }
    LDS_FENCE();
    const int c = lane & 7;
#pragma unroll
    for (int j = 0; j < 4; ++j) { const int n = (lane >> 3) + 8 * j; const LAS float* s = scr + (8 * c) * 33 + n;
        u32x4 o; o.x = pk2(s[0 * 33], s[1 * 33]); o.y = pk2(s[2 * 33], s[3 * 33]); o.z = pk2(s[4 * 33], s[5 * 33]); o.w = pk2(s[6 * 33], s[7 * 33]);
        *(u32x4*)(WT + (size_t)(n0 + n) * K + k0 + 8 * c) = o; }
    LDS_FENCE();
}
__device__ __forceinline__ void p0_mod_item(Frame& F, int item) {
    LAS float* sc = (LAS float*)F.lds; LAS float* red = (LAS float*)(F.lds + 32768);
    const float* c = F.in[1]; const float* ada_w = F.in[2]; const float* ada_b = F.in[3];
    for (int idx = F.tid; idx < 8192; idx += 512) { const float v = c[idx]; sc[idx] = v / (1.0f + __expf(-v)); }
    __syncthreads();
    float acc[8];
#pragma unroll
    for (int b = 0; b < 8; ++b) acc[b] = 0.f;
    const int kbase = 128 * F.wave; const float* wp = ada_w + (size_t)kbase * NMOD + 64 * item + F.lane;
#pragma unroll 8
    for (int kk = 0; kk < 128; ++kk) { const float wv = wp[(size_t)kk * NMOD];
#pragma unroll
        for (int b = 0; b < 8; ++b) acc[b] += sc[b * 1024 + kbase + kk] * wv; }
#pragma unroll
    for (int b = 0; b < 8; ++b) red[(F.wave * 8 + b) * 64 + F.lane] = acc[b];
    __syncthreads();
    { const int b = F.tid >> 6, col = F.tid & 63; float s = ada_b[64 * item + col];
#pragma unroll
      for (int w = 0; w < 8; ++w) s += red[(w * 8 + b) * 64 + col];
      ((float*)(F.ws + WS_MOD))[b * NMOD + 64 * item + col] = s; }
    __syncthreads();
}
__device__ __forceinline__ void p0_prologue(Frame& F) {
    for (int it = F.bid; it < NMOD / 64; it += F.G) p0_mod_item(F, it);
    LAS float* scr = (LAS float*)(F.lds + F.wave * 16384);
    const int gw = F.bid * 8 + F.wave, NGW = F.G * 8;
    constexpr int I_IN = 16 * (NZ / 32), I_OUT = 16 * 32, I_F1 = 16 * 128, I_F2 = 64 * 32, I_C1 = 32 * 8, I_C2 = 4 * 2, I_L = 2;
    constexpr int NTR = I_IN + I_OUT + I_F1 + I_F2 + 2 * I_C1 + 2 * I_C2 + 16 * I_L;
    constexpr int NITEMS = NTR + 128 + 8;
    unsigned char* ws = F.ws;
    for (int it = gw; it < NITEMS; it += NGW) {
        int r = it;
        if (r < I_IN) { tr_item(F.in[5], DM, 2328, (bf16_t*)(ws + WS_WINT), NZ, nullptr, nullptr, scr, r, F.lane); continue; } r -= I_IN;
        if (r < I_OUT) { tr_item(F.in[21], DM, DM, (bf16_t*)(ws + WS_WOUTT), DM, F.in[19], F.in[20], scr, r, F.lane); continue; } r -= I_OUT;
        if (r < I_F1) { tr_item(F.in[24], DM, DFF, (bf16_t*)(ws + WS_WFF1T), DFF, nullptr, nullptr, scr, r, F.lane); continue; } r -= I_F1;
        if (r < I_F2) { tr_item(F.in[25], DFF, DM, (bf16_t*)(ws + WS_WFF2T), DM, nullptr, nullptr, scr, r, F.lane); continue; } r -= I_F2;
        if (r < I_C1) { tr_item(F.in[14], 2048, 256, (bf16_t*)(ws + WS_CW1KT), 256, nullptr, nullptr, scr, r, F.lane); continue; } r -= I_C1;
        if (r < I_C1) { tr_item(F.in[17], 2048, 256, (bf16_t*)(ws + WS_CW1VT), 256, nullptr, nullptr, scr, r, F.lane); continue; } r -= I_C1;
        if (r < I_C2) { tr_item(F.in[15], 256, 64, (bf16_t*)(ws + WS_CW2KT), 64, nullptr, nullptr, scr, r, F.lane); continue; } r -= I_C2;
        if (r < I_C2) { tr_item(F.in[18], 256, 64, (bf16_t*)(ws + WS_CW2VT), 64, nullptr, nullptr, scr, r, F.lane); continue; } r -= I_C2;
        if (r < 8 * I_L) { const int n = r / I_L; tr_item(F.in[8] + n * 4096, 64, 64, (bf16_t*)(ws + WS_WAT) + n * 4096, 64, nullptr, nullptr, scr, r % I_L, F.lane); continue; } r -= 8 * I_L;
        if (r < 8 * I_L) { const int n = r / I_L; tr_item(F.in[10] + n * 4096, 64, 64, (bf16_t*)(ws + WS_WXT) + n * 4096, 64, nullptr, nullptr, scr, r % I_L, F.lane); continue; } r -= 8 * I_L;
        if (r < 128) {
            const int mat = r >> 6, cgp = (r >> 4) & 3, ks = r & 15; const float* pos = F.in[mat ? 16 : 13]; const float* w1 = F.in[mat ? 17 : 14];
            float a = 0.f; const int col = 64 * cgp + F.lane;
#pragma unroll 8
            for (int kk = 0; kk < 128; ++kk) { const int k = 128 * ks + kk; a += pos[k] * w1[(size_t)k * 256 + col]; }
            ((float*)(ws + WS_CB1P))[(mat * 16 + ks) * 256 + col] = a; continue; } r -= 128;
        { const int ch = 64 * r + F.lane; const float lam = F.in[12][ch]; ((float*)(ws + WS_LRUC))[ch] = -8.0f * log1pf(expf(-lam)); }
    }
}

__device__ __forceinline__ void p1_rows(Frame& F) {
    if (F.bid == 0) { const int mat = F.tid >> 8, col = F.tid & 255; float s = 0.f; const float* P = (const float*)(F.ws + WS_CB1P);
#pragma unroll
        for (int ks = 0; ks < 16; ++ks) s += P[(mat * 16 + ks) * 256 + col];
        ((float*)(F.ws + WS_CB1))[mat * 256 + col] = s; }
    const float* x = F.in[0]; const float* g = F.in[4]; const float* mod = (const float*)(F.ws + WS_MOD); bf16_t* H = (bf16_t*)(F.ws + WS_H);
    const int gw = F.bid * 8 + F.wave, NGW = F.G * 8;
    for (int rb = gw; rb < M / 16; rb += NGW) {
        const int b = (rb * 16) >> 12; f32x4 Gk[4], Sh[4];
#pragma unroll
        for (int j = 0; j < 4; ++j) { const int k = 4 * F.lane + 256 * j; const f32x4 gg = *(const f32x4*)(g + k), sc = *(const f32x4*)(mod + b * NMOD + 1024 + k);
            Gk[j] = gg * (sc + 1.0f); Sh[j] = *(const f32x4*)(mod + b * NMOD + k); }
        for (int rr = 0; rr < 16; ++rr) { const size_t row = (size_t)rb * 16 + rr; const f32x4* xr = (const f32x4*)(x + row * DM) + F.lane;
            f32x4 v[4]; float s = 0.f;
#pragma unroll
            for (int j = 0; j < 4; ++j) { v[j] = xr[64 * j]; s += (v[j].x * v[j].x + v[j].y * v[j].y) + (v[j].z * v[j].z + v[j].w * v[j].w); }
            const float rstd = rsqrtf(wave_sum(s) * (1.0f / DM) + EPS);
            unsigned long long* o8 = (unsigned long long*)(H + row * DM) + F.lane;
#pragma unroll
            for (int j = 0; j < 4; ++j) { const f32x4 h = v[j] * rstd * Gk[j] + Sh[j]; o8[64 * j] = (unsigned long long)pk2(h.x, h.y) | ((unsigned long long)pk2(h.z, h.w) << 32); } }
    }
}
__device__ __forceinline__ void p7_rows(Frame& F, float* out) {
    const float* x = F.in[0]; const float* pnm = F.in[22]; const float* pre = F.in[23]; const float* mod = (const float*)(F.ws + WS_MOD);
    const float* Y = (const float*)(F.ws + WS_Y); bf16_t* H = (bf16_t*)(F.ws + WS_H);
    const int gw = F.bid * 8 + F.wave, NGW = F.G * 8;
    for (int rb = gw; rb < M / 16; rb += NGW) {
        const int b = (rb * 16) >> 12; f32x4 A1[4], G2[4], S2[4];
#pragma unroll
        for (int j = 0; j < 4; ++j) { const int k = 4 * F.lane + 256 * j;
            A1[j] = *(const f32x4*)(pnm + k) * (*(const f32x4*)(mod + b * NMOD + 2048 + k) + 1.0f);
            G2[j] = *(const f32x4*)(pre + k) * (*(const f32x4*)(mod + b * NMOD + 4096 + k) + 1.0f);
            S2[j] = *(const f32x4*)(mod + b * NMOD + 3072 + k); }
        for (int rr = 0; rr < 16; ++rr) { const size_t row = (size_t)rb * 16 + rr;
            const f32x4* xr = (const f32x4*)(x + row * DM) + F.lane; const f32x4* yr = (const f32x4*)(Y + row * DM) + F.lane;
            f32x4 xv[4], yv[4]; float s = 0.f;
#pragma unroll
            for (int j = 0; j < 4; ++j) { xv[j] = xr[64 * j]; yv[j] = yr[64 * j]; s += (yv[j].x * yv[j].x + yv[j].y * yv[j].y) + (yv[j].z * yv[j].z + yv[j].w * yv[j].w); }
            const float rstd = rsqrtf(wave_sum(s) * (1.0f / DM) + EPS); float s2 = 0.f;
            f32x4* orow = (f32x4*)(out + row * DM) + F.lane;
#pragma unroll
            for (int j = 0; j < 4; ++j) { xv[j] = xv[j] + A1[j] * (yv[j] * rstd); orow[64 * j] = xv[j]; s2 += (xv[j].x * xv[j].x + xv[j].y * xv[j].y) + (xv[j].z * xv[j].z + xv[j].w * xv[j].w); }
            const float rstd2 = rsqrtf(wave_sum(s2) * (1.0f / DM) + EPS);
            unsigned long long* o8 = (unsigned long long*)(H + row * DM) + F.lane;
#pragma unroll
            for (int j = 0; j < 4; ++j) { const f32x4 h = xv[j] * rstd2 * G2[j] + S2[j]; o8[64 * j] = (unsigned long long)pk2(h.x, h.y) | ((unsigned long long)pk2(h.z, h.w) << 32); } }
    }
}
__device__ __forceinline__ void p10_rows(Frame& F, float* out) {
    const float* pnm = F.in[26]; const float* mod = (const float*)(F.ws + WS_MOD); const float* Y = (const float*)(F.ws + WS_Y2);
    const int gw = F.bid * 8 + F.wave, NGW = F.G * 8;
    for (int rb = gw; rb < M / 16; rb += NGW) {
        const int b = (rb * 16) >> 12; f32x4 A2[4];
#pragma unroll
        for (int j = 0; j < 4; ++j) { const int k = 4 * F.lane + 256 * j; A2[j] = *(const f32x4*)(pnm + k) * (*(const f32x4*)(mod + b * NMOD + 5120 + k) + 1.0f); }
        for (int rr = 0; rr < 16; ++rr) { const size_t row = (size_t)rb * 16 + rr;
            f32x4* orow = (f32x4*)(out + row * DM) + F.lane; const f32x4* yr = (const f32x4*)(Y + row * DM) + F.lane;
            f32x4 xv[4], yv[4]; float s = 0.f;
#pragma unroll
            for (int j = 0; j < 4; ++j) { xv[j] = orow[64 * j]; yv[j] = yr[64 * j]; s += (yv[j].x * yv[j].x + yv[j].y * yv[j].y) + (yv[j].z * yv[j].z + yv[j].w * yv[j].w); }
            const float rstd = rsqrtf(wave_sum(s) * (1.0f / DM) + EPS);
#pragma unroll
            for (int j = 0; j < 4; ++j) orow[64 * j] = xv[j] + A2[j] * (yv[j] * rstd); }
    }
}

constexpr int RNN_WL = 11264, RNN_PART_OFF = 8 * RNN_WL;
template <int PASS> __device__ __forceinline__ void rnn_item(Frame& F, int b, int chunk) {
    const int n = F.wave, lane = F.lane, ch = 64 * n + lane, fr = lane & 15, fq = lane >> 4;
    LAS unsigned char* wl = F.lds + n * RNN_WL;
    LAS bf16_t* xcb = (LAS bf16_t*)wl; LAS float* Ab = (LAS float*)(wl + 2304); LAS float* Gb = (LAS float*)(wl + 6656);
    LAS float* part = (LAS float*)(F.lds + RNN_PART_OFF);
    const float* conv_w = F.in[6]; const float cw0 = conv_w[ch], cw1 = conv_w[512 + ch], cw2 = conv_w[1024 + ch], cw3 = conv_w[1536 + ch], cb = F.in[7][ch];
    const bf16_t* WA = (const bf16_t*)(F.ws + WS_WAT) + n * 4096; const bf16_t* WX = (const bf16_t*)(F.ws + WS_WXT) + n * 4096;
    bf16x8 waf[4][2], wxf[4][2]; f32x4 ba4[4], bx4[4], lc4[4];
#pragma unroll
    for (int nb = 0; nb < 4; ++nb) {
#pragma unroll
        for (int ks = 0; ks < 2; ++ks) { waf[nb][ks] = *(const bf16x8*)(WA + (16 * nb + fr) * 64 + 32 * ks + 8 * fq); wxf[nb][ks] = *(const bf16x8*)(WX + (16 * nb + fr) * 64 + 32 * ks + 8 * fq); }
        const int c0 = 64 * n + 16 * nb + 4 * fq;
        ba4[nb] = *(const f32x4*)(F.in[9] + c0); bx4[nb] = *(const f32x4*)(F.in[11] + c0); lc4[nb] = *(const f32x4*)((const float*)(F.ws + WS_LRUC) + c0); }
    const bf16_t* XR = (const bf16_t*)(F.ws + WS_XRNN); const bf16_t* GR = (const bf16_t*)(F.ws + WS_GRNN); bf16_t* YC = (bf16_t*)(F.ws + WS_YCAT);
    const int t0 = chunk * 64; const size_t rowbase = (size_t)b * SEQ;
    float xm3 = 0.f, xm2 = 0.f, xm1 = 0.f;
    if (chunk > 0) { xm3 = bf2f(XR[(rowbase + t0 - 3) * 512 + ch]); xm2 = bf2f(XR[(rowbase + t0 - 2) * 512 + ch]); xm1 = bf2f(XR[(rowbase + t0 - 1) * 512 + ch]); }
    float h = 0.f, ap = 1.f;
    float* RA = (float*)(F.ws + WS_RA); float* RH = (float*)(F.ws + WS_RH);
    if (PASS == 2) { for (int c2 = 0; c2 < chunk; ++c2) { const size_t o = (size_t)(b * 64 + c2) * 512 + ch; h = RA[o] * h + RH[o]; } }
    for (int sub = 0; sub < 4; ++sub) {
        float xc[16]; const size_t r0 = rowbase + t0 + 16 * sub;
#pragma unroll
        for (int tt = 0; tt < 16; ++tt) { const float xv = bf2f(XR[(r0 + tt) * 512 + ch]); xc[tt] = cb + cw0 * xm3 + cw1 * xm2 + cw2 * xm1 + cw3 * xv; xm3 = xm2; xm2 = xm1; xm1 = xv; xcb[tt * 72 + lane] = (bf16_t)f2bf(xc[tt]); }
        LDS_FENCE();
        bf16x8 xb[2];
#pragma unroll
        for (int ks = 0; ks < 2; ++ks) xb[ks] = *(const LAS bf16x8*)(xcb + fr * 72 + 32 * ks + 8 * fq);
#pragma unroll
        for (int nb = 0; nb < 4; ++nb) { f32x4 aA = {0.f, 0.f, 0.f, 0.f}, aX = {0.f, 0.f, 0.f, 0.f};
#pragma unroll
            for (int ks = 0; ks < 2; ++ks) { aA = __builtin_amdgcn_mfma_f32_16x16x32_bf16(waf[nb][ks], xb[ks], aA, 0, 0, 0); aX = __builtin_amdgcn_mfma_f32_16x16x32_bf16(wxf[nb][ks], xb[ks], aX, 0, 0, 0); }
            f32x4 av, gv;
#pragma unroll
            for (int e = 0; e < 4; ++e) { const float rr = sigmoidf_(aA[e] + ba4[nb][e]), ii = sigmoidf_(aX[e] + bx4[nb][e]); const float la = lc4[nb][e] * rr;
                av[e] = __expf(la); gv[e] = sqrtf(fmaxf(-expm1f(2.0f * la), 0.f)) * ii; }
            *(LAS f32x4*)(Ab + fr * 68 + 16 * nb + 4 * fq) = av; *(LAS f32x4*)(Gb + fr * 68 + 16 * nb + 4 * fq) = gv; }
        LDS_FENCE();
        float y[16];
#pragma unroll
        for (int tt = 0; tt < 16; ++tt) { const float a = Ab[tt * 68 + lane], gg = Gb[tt * 68 + lane]; h = a * h + gg * xc[tt]; ap *= a;
            if (PASS == 2) y[tt] = h * gelu_tanh(bf2f(GR[(r0 + tt) * 512 + ch])); }
        LDS_FENCE();
        if (PASS == 2) {
#pragma unroll
            for (int tt = 0; tt < 16; ++tt) { const float v = wave_sum(y[tt] * y[tt]); if (lane == 0) part[((sub & 1) * 8 + n) * 16 + tt] = v; }
            __syncthreads();
#pragma unroll
            for (int tt = 0; tt < 16; ++tt) { float tot = 0.f;
#pragma unroll
                for (int w = 0; w < 8; ++w) tot += part[((sub & 1) * 8 + w) * 16 + tt];
                const float rstd = rsqrtf(tot * (1.0f / 512.0f) + EPS);
                YC[(r0 + tt) * 1024 + ch] = (bf16_t)f2bf(y[tt] * rstd); }
        }
    }
    if (PASS == 1) { const size_t o = (size_t)(b * 64 + chunk) * 512 + ch; RA[o] = ap; RH[o] = h; }
    if (PASS == 2) __syncthreads();
}

__device__ __forceinline__ void cmp2_item(Frame& F, int item) {
    const int mat = item >> 8, rb = item & 255, lane = F.lane, fr = lane & 15, fq = lane >> 4;
    const bf16_t* Hd = (const bf16_t*)(F.ws + (mat ? WS_CHIDV : WS_CHIDK)) + (size_t)(16 * rb + fr) * 256 + 8 * fq;
    const bf16_t* W2 = (const bf16_t*)(F.ws + (mat ? WS_CW2VT : WS_CW2KT)) + (size_t)fr * 256 + 8 * fq;
    f32x4 acc[4];
#pragma unroll
    for (int nb = 0; nb < 4; ++nb) acc[nb] = (f32x4){0.f, 0.f, 0.f, 0.f};
#pragma unroll
    for (int ks = 0; ks < 8; ++ks) { const bf16x8 hb = *(const bf16x8*)(Hd + 32 * ks);
#pragma unroll
        for (int nb = 0; nb < 4; ++nb) { const bf16x8 wf = *(const bf16x8*)(W2 + (size_t)(16 * nb) * 256 + 32 * ks); acc[nb] = __builtin_amdgcn_mfma_f32_16x16x32_bf16(wf, hb, acc[nb], 0, 0, 0); } }
    const int R = 16 * rb + fr;
    if (mat == 0) { bf16_t* O = (bf16_t*)(F.ws + WS_KCMP) + (size_t)R * 64 + 4 * fq;
#pragma unroll
        for (int nb = 0; nb < 4; ++nb) { u32x2 w; w.x = pk2(acc[nb][0], acc[nb][1]); w.y = pk2(acc[nb][2], acc[nb][3]); *(u32x2*)(O + 16 * nb) = w; }
    } else { const int bg = R >> 8, c = R & 255; bf16_t* O = (bf16_t*)(F.ws + WS_VCMPT) + (size_t)bg * 64 * 256 + c;
#pragma unroll
        for (int nb = 0; nb < 4; ++nb)
#pragma unroll
            for (int e = 0; e < 4; ++e) O[(size_t)(16 * nb + 4 * fq + e) * 256] = (bf16_t)f2bf(acc[nb][e]); }
}

constexpr int AT_BUF = 35840, AT_K1 = 9216, AT_V0 = 18432, AT_V1 = 27136, AT_IMP = 2 * AT_BUF, AT_IMP_BYTES = 8 * 32 * 65 * 4;
constexpr int AT_SELM = AT_IMP + AT_IMP_BYTES, AT_UNION = AT_SELM + 512, AT_SSQ = AT_UNION + 16;
static_assert(AT_SSQ + 1024 <= LDS_BYTES, "attention LDS map");
struct TileSrc { const bf16_t* k0; const bf16_t* k1; const bf16_t* v0; const bf16_t* v1; };
__device__ __forceinline__ void at_load(u32x4 (&st)[4], const TileSrc& s, int vpitch, int tid) {
    st[0] = *(const u32x4*)(s.k0 + tid * 8); st[1] = *(const u32x4*)(s.k1 + tid * 8);
    const int dim = tid >> 3, part = tid & 7;
    st[2] = *(const u32x4*)(s.v0 + (size_t)dim * vpitch + part * 8); st[3] = *(const u32x4*)(s.v1 + (size_t)dim * vpitch + part * 8);
}
__device__ __forceinline__ void at_store(LAS unsigned char* buf, const u32x4 (&st)[4], int tid) {
    const int key = tid >> 3, part = tid & 7;
    *(LAS u32x4*)(buf + key * 144 + part * 16) = st[0];
    *(LAS u32x4*)(buf + AT_K1 + key * 144 + part * 16) = st[1];
    LAS unsigned char* v0 = buf + AT_V0 + key * 136 + part * 16; LAS unsigned char* v1 = buf + AT_V1 + key * 136 + part * 16;
    *(LAS u32x2*)(v0) = (u32x2){st[2].x, st[2].y}; *(LAS u32x2*)(v0 + 8) = (u32x2){st[2].z, st[2].w};
    *(LAS u32x2*)(v1) = (u32x2){st[3].x, st[3].y}; *(LAS u32x2*)(v1 + 8) = (u32x2){st[3].z, st[3].w};
}
__device__ __forceinline__ void at_qk(f32x16 (&s)[2], const LAS unsigned char* kb, const bf16x8 (&qf)[4], int r32, int hi) {
#pragma unroll
    for (int kb2 = 0; kb2 < 2; ++kb2) { f32x16 a = {};
#pragma unroll
        for (int ks = 0; ks < 4; ++ks) { const bf16x8 kf = *(const LAS bf16x8*)(kb + (32 * kb2 + r32) * 144 + (16 * ks + 8 * hi) * 2); a = __builtin_amdgcn_mfma_f32_32x32x16_bf16(kf, qf[ks], a, 0, 0, 0); }
        s[kb2] = a; }
}
__device__ __forceinline__ void at_mask(f32x16 (&s)[2], int base_d, int step, int dmax, bool rowok, float slope2, int hi) {
#pragma unroll
    for (int kb2 = 0; kb2 < 2; ++kb2)
#pragma unroll
        for (int r = 0; r < 16; ++r) { const int key = 32 * kb2 + (r & 3) + 8 * (r >> 2) + 4 * hi; const int d = base_d - step * key;
            const bool ok = rowok && d >= 0 && d < dmax; s[kb2][r] = ok ? fmaf(s[kb2][r], LOG2E, -slope2 * (float)d) : NEGF; }
}
__device__ __forceinline__ float at_max(const f32x16 (&s)[2]) {
    float mx = s[0][0];
#pragma unroll
    for (int r = 1; r < 16; ++r) mx = fmaxf(mx, s[0][r]);
#pragma unroll
    for (int r = 0; r < 16; ++r) mx = fmaxf(mx, s[1][r]);
    return fmaxf(mx, __shfl_xor(mx, 32));
}
__device__ __forceinline__ void at_pv(f32x16 (&O)[2], const LAS unsigned char* vb, const f32x16 (&p)[2], int r32, int hi) {
#pragma unroll
    for (int kb2 = 0; kb2 < 2; ++kb2)
#pragma unroll
        for (int s2 = 0; s2 < 2; ++s2) {
            u32x4 pw; pw.x = pk2(p[kb2][8 * s2 + 0], p[kb2][8 * s2 + 1]); pw.y = pk2(p[kb2][8 * s2 + 2], p[kb2][8 * s2 + 3]); pw.z = pk2(p[kb2][8 * s2 + 4], p[kb2][8 * s2 + 5]); pw.w = pk2(p[kb2][8 * s2 + 6], p[kb2][8 * s2 + 7]);
            const bf16x8 pf = __builtin_bit_cast(bf16x8, pw);
#pragma unroll
            for (int db = 0; db < 2; ++db) { const LAS unsigned char* va = vb + (32 * db + r32) * 136 + (32 * kb2 + 16 * s2 + 4 * hi) * 2;
                const u32x2 lo = *(const LAS u32x2*)(va), hh = *(const LAS u32x2*)(va + 16);
                const bf16x8 vf = __builtin_bit_cast(bf16x8, (u32x4){lo.x, lo.y, hh.x, hh.y});
                O[db] = __builtin_amdgcn_mfma_f32_32x32x16_bf16(vf, pf, O[db], 0, 0, 0); } }
}
__device__ __forceinline__ void at_online(f32x16 (&s)[2], float& m, float& l, f32x16 (&O)[2], const LAS unsigned char* vb, int r32, int hi) {
    const float mn = fmaxf(m, at_max(s)); const float f = __builtin_amdgcn_exp2f(m - mn); m = mn; float ps = 0.f;
#pragma unroll
    for (int kb2 = 0; kb2 < 2; ++kb2)
#pragma unroll
        for (int r = 0; r < 16; ++r) { const float p = __builtin_amdgcn_exp2f(s[kb2][r] - mn); s[kb2][r] = p; ps += p; }
    l = l * f + ps;
#pragma unroll
    for (int db = 0; db < 2; ++db)
#pragma unroll
        for (int r = 0; r < 16; ++r) O[db][r] *= f;
    at_pv(O, vb, s, r32, hi);
}

__device__ __forceinline__ void attn_item(Frame& F, int b, int i) {
    const int tid = F.tid, lane = F.lane, h = F.wave, g = h >> 2, r32 = lane & 31, hi = lane >> 5;
    const int q0 = 32 * i, tq = q0 + r32; const size_t row = (size_t)b * SEQ + tq;
    LAS unsigned char* lds = F.lds;
    LAS float* IMP = (LAS float*)(lds + AT_IMP); LAS unsigned long long* SELM = (LAS unsigned long long*)(lds + AT_SELM);
    LAS unsigned* UNI = (LAS unsigned*)(lds + AT_UNION); LAS float* SSQ = (LAS float*)(lds + AT_SSQ);
    const bf16_t* Qp = (const bf16_t*)(F.ws + WS_Q) + row * 512 + h * 64 + 8 * hi;
    bf16x8 qf[4];
#pragma unroll
    for (int ks = 0; ks < 4; ++ks) qf[ks] = *(const bf16x8*)(Qp + 16 * ks);
    const float slope2 = __builtin_amdgcn_exp2f(-(float)(h + 1)) * LOG2E;
    const float* GT = (const float*)(F.ws + WS_GATE) + row * 24; const float gate_c = GT[h], gate_s = GT[8 + h], gate_w = GT[16 + h];
    f32x16 out[2]; out[0] = f32x16{}; out[1] = f32x16{};
    if (tid < 4) UNI[tid] = 0u;
    const int koff = g ? AT_K1 : 0, voff = g ? AT_V1 : AT_V0;
    const size_t bg0 = (size_t)b * 2;
    u32x4 st[4];
    const bf16_t* KC = (const bf16_t*)(F.ws + WS_KCMP); const bf16_t* VC = (const bf16_t*)(F.ws + WS_VCMPT);
    const int nc = (i >> 5) + 1;
#define CMP_SRC(jc) TileSrc{KC + ((bg0 + 0) * 256 + 64 * (jc)) * 64, KC + ((bg0 + 1) * 256 + 64 * (jc)) * 64, VC + (bg0 + 0) * 64 * 256 + 64 * (jc), VC + (bg0 + 1) * 64 * 256 + 64 * (jc)}
    float m = NEGF, l = 0.f;
    { at_load(st, CMP_SRC(0), 256, tid); at_store(lds, st, tid); __syncthreads(); }
    for (int jc = 0; jc < nc; ++jc) {
        LAS unsigned char* buf = lds + (jc & 1) * AT_BUF; const bool more = jc + 1 < nc;
        if (more) at_load(st, CMP_SRC(jc + 1), 256, tid);
        f32x16 s[2]; at_qk(s, buf + koff, qf, r32, hi); at_mask(s, tq - 31 - 1024 * jc, 16, 0x7fffffff, true, slope2, hi);
        const float mn = fmaxf(m, at_max(s)); float ps = 0.f;
#pragma unroll
        for (int kb2 = 0; kb2 < 2; ++kb2)
#pragma unroll
            for (int r = 0; r < 16; ++r) ps += __builtin_amdgcn_exp2f(s[kb2][r] - mn);
        l = l * __builtin_amdgcn_exp2f(m - mn) + ps; m = mn;
        if (more) at_store(lds + ((jc + 1) & 1) * AT_BUF, st, tid);
        __syncthreads();
    }
    {
        const float ltot = l + __shfl_xor(l, 32); const float inv = (tq >= 31) ? 1.0f / ltot : 0.f;
        f32x16 O[2]; O[0] = f32x16{}; O[1] = f32x16{}; float carry = 0.f;
        { at_load(st, CMP_SRC(0), 256, tid); at_store(lds, st, tid); __syncthreads(); }
        for (int jc = 0; jc < nc; ++jc) {
            LAS unsigned char* buf = lds + (jc & 1) * AT_BUF; const bool more = jc + 1 < nc;
            if (more) at_load(st, CMP_SRC(jc + 1), 256, tid);
            f32x16 s[2]; at_qk(s, buf + koff, qf, r32, hi); at_mask(s, tq - 31 - 1024 * jc, 16, 0x7fffffff, true, slope2, hi);
#pragma unroll
            for (int kb2 = 0; kb2 < 2; ++kb2)
#pragma unroll
                for (int r = 0; r < 16; ++r) s[kb2][r] = __builtin_amdgcn_exp2f(s[kb2][r] - m) * inv;
            float sum4[8], recv[8];
#pragma unroll
            for (int g8 = 0; g8 < 8; ++g8) { const int kb2 = g8 >> 2, qq = g8 & 3; sum4[g8] = (s[kb2][4 * qq] + s[kb2][4 * qq + 1]) + (s[kb2][4 * qq + 2] + s[kb2][4 * qq + 3]); recv[g8] = __shfl_xor(s[kb2][4 * qq + 3], 32); }
#pragma unroll
            for (int g8 = 0; g8 < 8; ++g8) { const float extra = hi ? recv[g8] : (g8 ? recv[g8 > 0 ? g8 - 1 : 0] : carry);
                IMP[(h * 32 + r32) * 65 + 16 * jc + 2 * g8 + hi] = sum4[g8] + extra; }
            carry = recv[7];
            at_pv(O, buf + voff, s, r32, hi);
            if (more) at_store(lds + ((jc + 1) & 1) * AT_BUF, st, tid);
            __syncthreads();
        }
#pragma unroll
        for (int db = 0; db < 2; ++db)
#pragma unroll
            for (int r = 0; r < 16; ++r) out[db][r] = gate_c * O[db][r];
    }
#undef CMP_SRC
    {
        unsigned long long un0 = 0ull, un1 = 0ull;
        for (int pp = 0; pp < 8; ++pp) { const int g2 = pp >> 2, q = 4 * h + (pp & 3), t = q0 + q, cur_t = t >> 6;
            float v = 0.f;
#pragma unroll
            for (int hh = 0; hh < 4; ++hh) v += IMP[((4 * g2 + hh) * 32 + q) * 65 + lane];
            const bool forced = (lane == 0) || (lane == cur_t) || (lane == cur_t - 1), vis = lane <= cur_t;
            const float val = forced ? 1e4f : (vis ? v : NEGF); int rank = 0;
#pragma unroll
            for (int jj = 0; jj < 64; ++jj) { const float o = __builtin_bit_cast(float, __builtin_amdgcn_readlane(__builtin_bit_cast(int, val), jj)); rank += ((o > val) || (o == val && jj < lane)) ? 1 : 0; }
            const unsigned long long mask = __ballot((rank < 16) && vis);
            if (lane == 0) SELM[g2 * 32 + q] = mask;
            if (g2) un1 |= mask; else un0 |= mask; }
        if (lane == 0) { atomicOr((unsigned*)&UNI[0], (unsigned)un0); atomicOr((unsigned*)&UNI[1], (unsigned)(un0 >> 32)); atomicOr((unsigned*)&UNI[2], (unsigned)un1); atomicOr((unsigned*)&UNI[3], (unsigned)(un1 >> 32)); }
        __syncthreads();
    }
    const bf16_t* KVb = (const bf16_t*)(F.ws + WS_KV);
#define KV_SRC(kidx, j) TileSrc{KVb + (size_t)(kidx) * (KV_STRIDE / 2) + ((bg0 + 0) * 4096 + 64 * (j)) * 64, KVb + (size_t)(kidx) * (KV_STRIDE / 2) + ((bg0 + 1) * 4096 + 64 * (j)) * 64, \
        KVb + (size_t)((kidx) + 1) * (KV_STRIDE / 2) + (bg0 + 0) * 64 * 4096 + 64 * (j), KVb + (size_t)((kidx) + 1) * (KV_STRIDE / 2) + (bg0 + 1) * 64 * 4096 + 64 * (j)}
    {
        const unsigned u0 = __builtin_amdgcn_readfirstlane(UNI[0]), u1 = __builtin_amdgcn_readfirstlane(UNI[1]), u2 = __builtin_amdgcn_readfirstlane(UNI[2]), u3 = __builtin_amdgcn_readfirstlane(UNI[3]);
        const unsigned long long U0 = ((unsigned long long)u1 << 32) | u0, U1 = ((unsigned long long)u3 << 32) | u2, Ug = g ? U1 : U0;
        unsigned long long rem = U0 | U1;
        const unsigned long long mysel = SELM[g * 32 + r32];
        m = NEGF; l = 0.f; f32x16 O[2]; O[0] = f32x16{}; O[1] = f32x16{};
        int j = __builtin_ctzll(rem); rem &= rem - 1;
        { at_load(st, KV_SRC(2, j), 4096, tid); at_store(lds, st, tid); __syncthreads(); }
        int par = 0;
        for (;;) {
            LAS unsigned char* buf = lds + par * AT_BUF; const bool more = rem != 0ull; const int jn = more ? __builtin_ctzll(rem) : 0; rem &= rem - 1;
            if (more) at_load(st, KV_SRC(2, jn), 4096, tid);
            if ((Ug >> j) & 1ull) { f32x16 s[2]; at_qk(s, buf + koff, qf, r32, hi); at_mask(s, tq - 64 * j, 1, 0x7fffffff, ((mysel >> j) & 1ull) != 0ull, slope2, hi);
                at_online(s, m, l, O, buf + voff, r32, hi); }
            if (more) at_store(lds + (par ^ 1) * AT_BUF, st, tid);
            __syncthreads();
            if (!more) break;
            j = jn; par ^= 1;
        }
        const float ltot = l + __shfl_xor(l, 32); const float sc = gate_s / ltot;
#pragma unroll
        for (int db = 0; db < 2; ++db)
#pragma unroll
            for (int r = 0; r < 16; ++r) out[db][r] += sc * O[db][r];
    }
    {
        const int jhi = q0 >> 6; int jlo = (q0 - 511) >> 6; if (jlo < 0) jlo = 0;
        m = NEGF; l = 0.f; f32x16 O[2]; O[0] = f32x16{}; O[1] = f32x16{};
        { at_load(st, KV_SRC(4, jlo), 4096, tid); at_store(lds, st, tid); __syncthreads(); }
        for (int j = jlo; j <= jhi; ++j) {
            LAS unsigned char* buf = lds + ((j - jlo) & 1) * AT_BUF; const bool more = j < jhi;
            if (more) at_load(st, KV_SRC(4, j + 1), 4096, tid);
            f32x16 s[2]; at_qk(s, buf + koff, qf, r32, hi); at_mask(s, tq - 64 * j, 1, 512, true, slope2, hi);
            at_online(s, m, l, O, buf + voff, r32, hi);
            if (more) at_store(lds + ((j - jlo + 1) & 1) * AT_BUF, st, tid);
            __syncthreads();
        }
        const float ltot = l + __shfl_xor(l, 32); const float sc = gate_w / ltot;
#pragma unroll
        for (int db = 0; db < 2; ++db)
#pragma unroll
            for (int r = 0; r < 16; ++r) out[db][r] += sc * O[db][r];
    }
#undef KV_SRC
    {
        float ss = 0.f;
#pragma unroll
        for (int db = 0; db < 2; ++db)
#pragma unroll
            for (int r = 0; r < 16; ++r) ss += out[db][r] * out[db][r];
        ss += __shfl_xor(ss, 32);
        if (hi == 0) SSQ[h * 32 + r32] = ss;
        __syncthreads();
        float tot = 0.f;
#pragma unroll
        for (int hh = 0; hh < 8; ++hh) tot += SSQ[hh * 32 + r32];
        const float rstd = rsqrtf(tot * (1.0f / 512.0f) + EPS);
        bf16_t* yp = (bf16_t*)(F.ws + WS_YCAT) + row * 1024 + 512 + h * 64 + 4 * hi;
#pragma unroll
        for (int db = 0; db < 2; ++db)
#pragma unroll
            for (int qq = 0; qq < 4; ++qq) { u32x2 w; w.x = pk2(out[db][4 * qq] * rstd, out[db][4 * qq + 1] * rstd); w.y = pk2(out[db][4 * qq + 2] * rstd, out[db][4 * qq + 3] * rstd);
                *(u32x2*)(yp + 32 * db + 8 * qq) = w; }
        __syncthreads();
    }
}

__global__ void __launch_bounds__(512) hybrid_fwd(Args args) {
    extern __shared__ __attribute__((aligned(16))) unsigned char lds_raw[];
    cg::grid_group grid = cg::this_grid();
    Frame F; F.lds = (LAS unsigned char*)lds_raw; F.tid = threadIdx.x; F.lane = F.tid & 63; F.wave = __builtin_amdgcn_readfirstlane(F.tid >> 6);
    F.G = gridDim.x; F.bid = blockIdx.x; F.ws = args.ws; F.in = args.in;
    unsigned char* ws = args.ws;
#define REFRESH() do { F.tid = fresh_tid(); F.lane = F.tid & 63; F.wave = __builtin_amdgcn_readfirstlane(F.tid >> 6); } while (0)
#define GRID_BAR() do { grid.sync(); REFRESH(); } while (0)
    p0_prologue(F);
    GRID_BAR();
    p1_rows(F);
    GRID_BAR();
    { pg8::Gemm g{(const bf16_t*)(ws + WS_H), (const bf16_t*)(ws + WS_WINT), M, NZ, DM, DM}; pg8::StaticOrder S; S.init(M, NZ, F.G, F.bid);
      EpiZ E{ws}; pg8::gemm_phase<EpiZ, pg8::StaticOrder>(F.lds, g, S, E); }
    GRID_BAR();
    { const float* cb1 = (const float*)(ws + WS_CB1);
      { pg8::Gemm g{(const bf16_t*)(ws + WS_KV), (const bf16_t*)(ws + WS_CW1KT), 4096, 256, 2048, 1024}; pg8::ColOrder S{16, F.G, F.bid};
        EpiBf16<2> E{(bf16_t*)(ws + WS_CHIDK), 256, cb1}; pg8::gemm_phase<EpiBf16<2>, pg8::ColOrder>(F.lds, g, S, E); }
      { pg8::Gemm g{(const bf16_t*)(ws + WS_KV + KV_STRIDE), (const bf16_t*)(ws + WS_CW1VT), 4096, 256, 2048, 1024}; pg8::ColOrder S{16, F.G, (F.bid + F.G - 16) % F.G};
        EpiBf16<2> E{(bf16_t*)(ws + WS_CHIDV), 256, cb1 + 256}; pg8::gemm_phase<EpiBf16<2>, pg8::ColOrder>(F.lds, g, S, E); }
      __syncthreads();
      for (int it = F.bid; it < 512; it += F.G) rnn_item<1>(F, it >> 6, it & 63); }
    GRID_BAR();
    { const int gw = F.bid * 8 + F.wave, NGW = F.G * 8; for (int it = gw; it < 512; it += NGW) cmp2_item(F, it); }
    GRID_BAR();
    { for (int n = F.bid; n < 1024; n += F.G) { const int k = n >> 8, c = n & 255, b = c >> 5, r = c & 31; const int i = (k == 0) ? r : (k == 1) ? 63 - r : (k == 2) ? 64 + r : 127 - r; attn_item(F, b, i); }
      __syncthreads();
      for (int it = F.bid; it < 512; it += F.G) rnn_item<2>(F, it >> 6, it & 63); }
    GRID_BAR();
    { pg8::Gemm g{(const bf16_t*)(ws + WS_YCAT), (const bf16_t*)(ws + WS_WOUTT), M, DM, DM, DM}; pg8::StaticOrder S; S.init(M, DM, F.G, F.bid);
      EpiF32 E{(float*)(ws + WS_Y), DM}; pg8::gemm_phase<EpiF32, pg8::StaticOrder>(F.lds, g, S, E); }
    GRID_BAR();
    p7_rows(F, args.out);
    GRID_BAR();
    { pg8::Gemm g{(const bf16_t*)(ws + WS_H), (const bf16_t*)(ws + WS_WFF1T), M, DFF, DM, DM}; pg8::StaticOrder S; S.init(M, DFF, F.G, F.bid);
      EpiBf16<1> E{(bf16_t*)(ws + WS_HID), DFF, nullptr}; pg8::gemm_phase<EpiBf16<1>, pg8::StaticOrder>(F.lds, g, S, E); }
    GRID_BAR();
    { pg8::Gemm g{(const bf16_t*)(ws + WS_HID), (const bf16_t*)(ws + WS_WFF2T), M, DM, DFF, DFF}; pg8::StaticOrder S; S.init(M, DM, F.G, F.bid);
      EpiF32 E{(float*)(ws + WS_Y2), DM}; pg8::gemm_phase<EpiF32, pg8::StaticOrder>(F.lds, g, S, E); }
    GRID_BAR();
    p10_rows(F, args.out);
}

extern "C" void kernel_launch(void* const* d_in, const int* in_sizes, int n_in, void* d_out, int out_size, void* d_ws, size_t ws_size, hipStream_t stream) {
    static int grid = 0;
    if (grid == 0) {
        if (n_in != 27 || out_size != M * DM || ws_size < WS_END) { fprintf(stderr, "kernel_launch: unexpected problem (n_in %d out %d ws %zu)\n", n_in, out_size, ws_size); grid = -1; return; }
        int dev = 0, cus = 0, per_cu = 0;
        (void)hipGetDevice(&dev); (void)hipDeviceGetAttribute(&cus, hipDeviceAttributeMultiprocessorCount, dev);
        (void)hipFuncSetAttribute((const void*)hybrid_fwd, hipFuncAttributeMaxDynamicSharedMemorySize, LDS_BYTES);
        if (hipOccupancyMaxActiveBlocksPerMultiprocessor(&per_cu, (const void*)hybrid_fwd, 512, LDS_BYTES) != hipSuccess || per_cu < 1) per_cu = 1;
        (void)hipGetLastError();
        grid = cus * 1;
        fprintf(stderr, "kernel_launch: grid %d (per_cu %d)\n", grid, per_cu);
    }
    if (grid < 0) return;
    Args a{};
    for (int i = 0; i < 27; ++i) a.in[i] = (const float*)d_in[i];
    a.out = (float*)d_out; a.ws = (unsigned char*)d_ws;
    void* kargs[] = {&a};
    hipError_t e = hipLaunchCooperativeKernel((const void*)hybrid_fwd, dim3(grid), dim3(512), kargs, LDS_BYTES, stream);
    if (e != hipSuccess) fprintf(stderr, "kernel_launch: cooperative launch failed: %s\n", hipGetErrorString(e));
}
```

```cpp
#include <hip/hip_runtime.h>
#include <hip/hip_cooperative_groups.h>
#include <cstdio>
#include <cstdint>
namespace cg = cooperative_groups;

#define LAS __attribute__((address_space(3)))
typedef unsigned short bf16_t;
typedef short bf16x8 __attribute__((ext_vector_type(8)));
typedef short s16x4 __attribute__((ext_vector_type(4)));
typedef float f32x4 __attribute__((ext_vector_type(4)));
typedef float f32x16 __attribute__((ext_vector_type(16)));
typedef unsigned u32x4 __attribute__((ext_vector_type(4)));
typedef unsigned u32x2 __attribute__((ext_vector_type(2)));

namespace pg8 {
constexpr int BM = 256, BK = 64, HALF = 128, HTB = HALF * BK * 2, STAGE_BYTES = 8 * HTB, NXCD = 8, WGM = 8;
__host__ __device__ __forceinline__ int lds_byte(int r, int c) { const int st = (r >> 4) * 2 + (c >> 5), rr = r & 15, cc = c & 31, ob = rr * 64 + cc * 2; return st * 1024 + (ob ^ (((ob >> 9) & 1) << 5)); }
__host__ __device__ __forceinline__ void stage_rc(int b, int& R, int& C) { const int st = b / 1024, sb = b % 1024, swz = sb ^ (((sb >> 9) & 1) << 5); R = (st >> 1) * 16 + swz / 64; C = (st & 1) * 32 + (swz % 64) / 2; }
__host__ __device__ __forceinline__ int perm32(int rho) { const int n = rho >> 4, i = rho & 15; return 8 * (i >> 2) + 4 * n + (i & 3); }

struct Unit { int pm, pn; };
struct Gemm { const bf16_t* A; const bf16_t* Bt; int M, N, K, lda; };

struct StaticOrder {
    int nM, nN, nwg, G, c;
    __device__ void init(int M, int N, int G_, int c_) { nM = M / BM; nN = N / BM; nwg = nM * nN; G = G_; c = c_; }
    __device__ bool next(int i, Unit& u) const {
        const long L = (long)i * G + c; if (L >= nwg) return false;
        int wgid = (int)L; { const int q = nwg / NXCD, r = nwg % NXCD, xcd = wgid % NXCD, off = wgid / NXCD; wgid = (xcd < r ? xcd * (q + 1) : r * (q + 1) + (xcd - r) * q) + off; }
        const int nig = WGM * nN, gid = wgid / nig, fm = gid * WGM, gsz = (nM - fm) < WGM ? (nM - fm) : WGM;
        u.pm = fm + ((wgid % nig) % gsz); u.pn = (wgid % nig) / gsz; return true;
    }
};
struct ColOrder {
    int nM, G, c;
    __device__ bool next(int i, Unit& u) const { const long L = (long)i * G + c; if (c < 0 || L >= nM) return false; u.pm = (int)L; u.pn = 0; return true; }
};

__device__ __forceinline__ unsigned cvt_pk_bf16(float lo, float hi) { unsigned r; asm volatile("v_cvt_pk_bf16_f32 %0, %1, %2" : "=v"(r) : "v"(lo), "v"(hi)); return r; }

template <class Epi, class Sched>
__device__ __forceinline__ void gemm_phase(LAS unsigned char* lds, const Gemm g, const Sched& S, const Epi& E) {
    int tid = threadIdx.x; asm volatile("" : "+v"(tid));
    const int wid = __builtin_amdgcn_readfirstlane(tid >> 6), lane = tid & 63, wr = wid >> 2, wc = wid & 3, fr = lane & 15, fq = lane >> 4;
    const int K = g.K, nt = K / BK, lda = g.lda;
    unsigned voffA[2], voffB[2];
#pragma unroll
    for (int i = 0; i < 2; ++i) { int R, C; stage_rc(tid * 16 + i * 8192, R, C); const int Rb = Epi::PERM ? ((R & ~31) + perm32(R & 31)) : R;
        voffA[i] = (unsigned)(R * lda + C) * 2u; voffB[i] = (unsigned)(Rb * K + C) * 2u; }
    const size_t kstep = (size_t)(BK * 2);
    const size_t hstepA = (size_t)HALF * lda * 2, hstepB = (size_t)HALF * K * 2;
    const size_t tstepA = 2 * hstepA, tstepB = 2 * hstepB;
    const unsigned ldsw = (unsigned)wid * 1024u;
    const int aoff = lds_byte(wr * 64 + fr, fq * 8), boff = lds_byte(wc * 32 + fr, fq * 8);
#define PG8_SA(b, h) (((b) * 2 + (h)) * HTB)
#define PG8_SB(b, h) ((4 + (b) * 2 + (h)) * HTB)
#define PG8_STAGE(bufoff, gbase, voff) do { _Pragma("unroll") for (int _i = 0; _i < 2; ++_i) \
        __builtin_amdgcn_global_load_lds((const unsigned*)((const char*)(gbase) + (voff)[_i]), (LAS unsigned*)(lds + (bufoff) + ldsw + _i * 8192), 16, 0, 0); } while (0)
#define PG8_LDA(dst, b, h) do { _Pragma("unroll") for (int m = 0; m < 4; ++m) _Pragma("unroll") for (int k = 0; k < 2; ++k) dst[m][k] = *(const LAS bf16x8*)(lds + PG8_SA(b, h) + aoff + m * 2048 + k * 1024); } while (0)
#define PG8_LDB(dst, b, h) do { _Pragma("unroll") for (int n = 0; n < 2; ++n) _Pragma("unroll") for (int k = 0; k < 2; ++k) dst[n][k] = *(const LAS bf16x8*)(lds + PG8_SB(b, h) + boff + n * 2048 + k * 1024); } while (0)
#define PG8_MMA(ai, bj, At, Bt) do { __builtin_amdgcn_s_setprio(1); _Pragma("unroll") for (int m = 0; m < 4; ++m) _Pragma("unroll") for (int n = 0; n < 2; ++n) _Pragma("unroll") for (int k = 0; k < 2; ++k) \
        acc[ai][bj][m][n] = __builtin_amdgcn_mfma_f32_16x16x32_bf16(Bt[n][k], At[m][k], acc[ai][bj][m][n], 0, 0, 0); __builtin_amdgcn_s_setprio(0); } while (0)
#define PG8_WAIT_V(n) asm volatile("s_waitcnt vmcnt(" #n ")" ::: "memory")
#define PG8_WAIT_L(n) asm volatile("s_waitcnt lgkmcnt(" #n ")" ::: "memory")
#define PG8_BAR __builtin_amdgcn_s_barrier()
#define PG8_SCHED __builtin_amdgcn_sched_barrier(0)
    Unit cur, nxt; int ui = 0;
    if (!S.next(0, cur)) return;
    f32x4 acc[2][2][4][2];
#pragma unroll
    for (int a = 0; a < 2; ++a)
#pragma unroll
        for (int b = 0; b < 2; ++b)
#pragma unroll
            for (int m = 0; m < 4; ++m)
#pragma unroll
                for (int n = 0; n < 2; ++n) acc[a][b][m][n] = (f32x4){0.f, 0.f, 0.f, 0.f};
    bf16x8 At[4][2], B0[2][2], B1[2][2];
    const char* cA = (const char*)g.A + (size_t)cur.pm * tstepA; const char* cB = (const char*)g.Bt + (size_t)cur.pn * tstepB;
    PG8_STAGE(PG8_SB(0, 0), cB, voffB); PG8_STAGE(PG8_SB(0, 1), cB + hstepB, voffB); PG8_STAGE(PG8_SA(0, 0), cA, voffA); PG8_STAGE(PG8_SA(0, 1), cA + hstepA, voffA);
    if (wr == 1) PG8_BAR;
    PG8_WAIT_V(2); PG8_BAR;
    PG8_STAGE(PG8_SB(1, 0), cB + kstep, voffB); PG8_STAGE(PG8_SA(1, 0), cA + kstep, voffA); PG8_STAGE(PG8_SB(1, 1), cB + hstepB + kstep, voffB);
    PG8_WAIT_V(6); PG8_BAR;
    for (;;) {
        const bool has_next = S.next(ui + 1, nxt);
        const char* nA = has_next ? (const char*)g.A + (size_t)nxt.pm * tstepA : cA; const char* nB = has_next ? (const char*)g.Bt + (size_t)nxt.pn * tstepB : cB;
        for (int t = 0; t < nt; t += 2) {
            const bool last = (t == nt - 2);
            const char* a1 = cA + (size_t)(t + 1) * kstep;
            const char* a2 = last ? nA : cA + (size_t)(t + 2) * kstep; const char* b2 = last ? nB : cB + (size_t)(t + 2) * kstep;
            const char* a3 = a2 + kstep; const char* b3 = b2 + kstep;
            PG8_LDB(B0, 0, 0); PG8_LDB(B1, 0, 1); PG8_SCHED; PG8_LDA(At, 0, 0); PG8_STAGE(PG8_SA(1, 1), a1 + hstepA, voffA);
            PG8_WAIT_V(8); PG8_WAIT_L(0); PG8_BAR; PG8_MMA(0, 0, At, B0); PG8_MMA(0, 1, At, B1); PG8_BAR; PG8_SCHED;
            PG8_LDA(At, 0, 1); PG8_STAGE(PG8_SB(0, 0), b2, voffB); PG8_STAGE(PG8_SB(0, 1), b2 + hstepB, voffB); PG8_STAGE(PG8_SA(0, 0), a2, voffA);
            PG8_WAIT_V(8); PG8_WAIT_L(0); PG8_BAR; PG8_MMA(1, 0, At, B0); PG8_MMA(1, 1, At, B1); PG8_BAR; PG8_SCHED;
            PG8_LDB(B0, 1, 0); PG8_LDB(B1, 1, 1); PG8_SCHED; PG8_LDA(At, 1, 0); PG8_STAGE(PG8_SA(0, 1), a2 + hstepA, voffA);
            PG8_WAIT_V(8); PG8_WAIT_L(0); PG8_BAR; PG8_MMA(0, 0, At, B0); PG8_MMA(0, 1, At, B1); PG8_BAR; PG8_SCHED;
            PG8_LDA(At, 1, 1); PG8_STAGE(PG8_SB(1, 0), b3, voffB); PG8_STAGE(PG8_SB(1, 1), b3 + hstepB, voffB); PG8_STAGE(PG8_SA(1, 0), a3, voffA);
            PG8_WAIT_V(8); PG8_WAIT_L(0); PG8_BAR; PG8_MMA(1, 0, At, B0); PG8_MMA(1, 1, At, B1); PG8_BAR; PG8_SCHED;
        }
        if (wr == 0) PG8_BAR;
        E(acc, cur, wr, wc, fr, fq);
        if (!has_next) break;
#pragma unroll
        for (int a = 0; a < 2; ++a)
#pragma unroll
            for (int b = 0; b < 2; ++b)
#pragma unroll
                for (int m = 0; m < 4; ++m)
#pragma unroll
                    for (int n = 0; n < 2; ++n) acc[a][b][m][n] = (f32x4){0.f, 0.f, 0.f, 0.f};
        cur = nxt; cA = nA; cB = nB; ++ui;
        if (wr == 1) PG8_BAR;
    }
    PG8_WAIT_V(0);
    PG8_BAR;
#undef PG8_SA
#undef PG8_SB
#undef PG8_STAGE
#undef PG8_LDA
#undef PG8_LDB
#undef PG8_MMA
#undef PG8_WAIT_V
#undef PG8_WAIT_L
#undef PG8_BAR
#undef PG8_SCHED
}
}

constexpr int BATCH = 8, SEQ = 4096, DM = 1024, M = BATCH * SEQ, NZ = 2560, DFF = 4096, NMOD = 6 * DM;
constexpr float EPS = 1e-6f, NEGF = -1e30f, LOG2E = 1.4426950408889634f;
constexpr size_t MiB = 1u << 20, KiB = 1024;
constexpr size_t WS_MOD = 64 * KiB;
constexpr size_t WS_CB1P = 320 * KiB;
constexpr size_t WS_CB1 = 384 * KiB;
constexpr size_t WS_LRUC = 400 * KiB;
constexpr size_t WS_WAT = 448 * KiB, WS_WXT = 512 * KiB;
constexpr size_t WS_CW2KT = 576 * KiB, WS_CW2VT = 640 * KiB;
constexpr size_t WS_WINT = 2 * MiB, WS_WOUTT = 8 * MiB, WS_WFF1T = 10 * MiB, WS_WFF2T = 18 * MiB, WS_CW1KT = 26 * MiB, WS_CW1VT = 27 * MiB;
constexpr size_t WS_CHIDK = 28 * MiB, WS_CHIDV = 30 * MiB;
constexpr size_t WS_H = 32 * MiB;
constexpr size_t WS_GRNN = 96 * MiB, WS_XRNN = 128 * MiB, WS_Q = 160 * MiB;
constexpr size_t WS_KV = 192 * MiB, KV_STRIDE = 8 * MiB;
constexpr size_t WS_GATE = 240 * MiB;
constexpr size_t WS_KCMP = 244 * MiB, WS_VCMPT = WS_KCMP + 512 * KiB;
constexpr size_t WS_RA = 246 * MiB, WS_RH = 247 * MiB;
constexpr size_t WS_YCAT = 256 * MiB;
constexpr size_t WS_Y = 320 * MiB;
constexpr size_t WS_HID = 96 * MiB;
constexpr size_t WS_Y2 = 352 * MiB;
constexpr size_t WS_END = 480 * MiB;
constexpr int LDS_BYTES = 147456, LDS_MISC = 147200;

struct Args { const float* in[27]; float* out; unsigned char* ws; };

struct Frame {
    LAS unsigned char* lds; int tid, lane, wave, G, bid; unsigned char* ws; const float* const* in;
};

__device__ __forceinline__ unsigned f2bf(float f) { unsigned u = __builtin_bit_cast(unsigned, f); return (u + 0x7fffu + ((u >> 16) & 1u)) >> 16; }
__device__ __forceinline__ unsigned pk2(float lo, float hi) { return f2bf(lo) | (f2bf(hi) << 16); }
__device__ __forceinline__ float bf2f(bf16_t b) { return __builtin_bit_cast(float, (unsigned)b << 16); }
__device__ __forceinline__ float wave_sum(float v) {
#pragma unroll
    for (int o = 1; o < 64; o <<= 1) v += __shfl_xor(v, o);
    return v;
}
__device__ __forceinline__ float sigmoidf_(float x) { return 1.0f / (1.0f + __expf(-x)); }
__device__ __forceinline__ float gelu_tanh(float v) { const float u = 0.7978845608028654f * (v + 0.044715f * v * v * v); return v / (1.0f + __expf(-2.0f * u)); }
#define LDS_FENCE() asm volatile("s_waitcnt lgkmcnt(0)" ::: "memory")
__device__ __forceinline__ int fresh_tid() { int t = threadIdx.x; asm volatile("" : "+v"(t)); return t; }

struct EpiF32 {
    static constexpr bool PERM = false;
    float* O; int ldc;
    __device__ __forceinline__ void operator()(const f32x4 (&acc)[2][2][4][2], const pg8::Unit& u, int wr, int wc, int fr, int fq) const {
        const int row0 = u.pm * 256 + wr * 64 + fr, col0 = u.pn * 256 + wc * 32 + 4 * fq;
#pragma unroll
        for (int ai = 0; ai < 2; ++ai)
#pragma unroll
            for (int m = 0; m < 4; ++m) { float* rowp = O + (size_t)(row0 + ai * 128 + m * 16) * ldc + col0;
#pragma unroll
                for (int bj = 0; bj < 2; ++bj)
#pragma unroll
                    for (int n = 0; n < 2; ++n) *(f32x4*)(rowp + bj * 128 + n * 16) = acc[ai][bj][m][n]; }
    }
};
template <int ACT  > struct EpiBf16 {
    static constexpr bool PERM = true;
    bf16_t* O; int ldc; const float* bias;
    __device__ __forceinline__ void operator()(const f32x4 (&acc)[2][2][4][2], const pg8::Unit& u, int wr, int wc, int fr, int fq) const {
        const int row0 = u.pm * 256 + wr * 64 + fr, col0 = u.pn * 256 + wc * 32 + 8 * fq;
        f32x4 bv[2][2];
#pragma unroll
        for (int bj = 0; bj < 2; ++bj)
#pragma unroll
            for (int n = 0; n < 2; ++n) bv[bj][n] = (ACT == 2) ? *(const f32x4*)(bias + col0 + bj * 128 + 4 * n) : (f32x4){0.f, 0.f, 0.f, 0.f};
#pragma unroll
        for (int ai = 0; ai < 2; ++ai)
#pragma unroll
            for (int m = 0; m < 4; ++m) { bf16_t* rowp = O + (size_t)(row0 + ai * 128 + m * 16) * ldc + col0;
#pragma unroll
                for (int bj = 0; bj < 2; ++bj) { f32x4 v0 = acc[ai][bj][m][0] + bv[bj][0], v1 = acc[ai][bj][m][1] + bv[bj][1];
#pragma unroll
                    for (int e = 0; e < 4; ++e) {
                        if (ACT == 1) { const float a = fmaxf(v0[e], 0.f), b = fmaxf(v1[e], 0.f); v0[e] = a * a; v1[e] = b * b; }
                        if (ACT == 2) { v0[e] = gelu_tanh(v0[e]); v1[e] = gelu_tanh(v1[e]); } }
                    u32x4 w; w.x = pk2(v0[0], v0[1]); w.y = pk2(v0[2], v0[3]); w.z = pk2(v1[0], v1[1]); w.w = pk2(v1[2], v1[3]);
                    *(u32x4*)(rowp + bj * 128) = w; } }
    }
};
struct EpiZ {
    static constexpr bool PERM = true;
    unsigned char* ws;
    __device__ __forceinline__ void operator()(const f32x4 (&acc)[2][2][4][2], const pg8::Unit& u, int wr, int wc, int fr, int fq) const {
        const int row0 = u.pm * 256 + wr * 64 + fr, pn = u.pn;
        if (pn < 6) {
            bf16_t* base = (bf16_t*)(ws + (pn < 2 ? WS_GRNN : pn < 4 ? WS_XRNN : WS_Q)); const float sc = pn >= 4 ? 0.125f : 1.0f;
            const int col0 = (pn & 1) * 256 + wc * 32 + 8 * fq;
#pragma unroll
            for (int ai = 0; ai < 2; ++ai)
#pragma unroll
                for (int m = 0; m < 4; ++m) { bf16_t* rowp = base + (size_t)(row0 + ai * 128 + m * 16) * 512 + col0;
#pragma unroll
                    for (int bj = 0; bj < 2; ++bj) { const f32x4 v0 = acc[ai][bj][m][0] * sc, v1 = acc[ai][bj][m][1] * sc;
                        u32x4 w; w.x = pk2(v0[0], v0[1]); w.y = pk2(v0[2], v0[3]); w.z = pk2(v1[0], v1[1]); w.w = pk2(v1[2], v1[3]);
                        *(u32x4*)(rowp + bj * 128) = w; } }
        } else if (pn < 9) {
            const int p = pn - 6, g = wc >> 1, d0 = 32 * (wc & 1) + 8 * fq;
            bf16_t* Kb = (bf16_t*)(ws + WS_KV + (size_t)(2 * p) * KV_STRIDE); bf16_t* Vb = (bf16_t*)(ws + WS_KV + (size_t)(2 * p + 1) * KV_STRIDE);
#pragma unroll
            for (int ai = 0; ai < 2; ++ai)
#pragma unroll
                for (int m = 0; m < 4; ++m) { const int row = row0 + ai * 128 + m * 16, b = row >> 12, s = row & 4095;
                    { const f32x4 v0 = acc[ai][0][m][0], v1 = acc[ai][0][m][1];
                      u32x4 w; w.x = pk2(v0[0], v0[1]); w.y = pk2(v0[2], v0[3]); w.z = pk2(v1[0], v1[1]); w.w = pk2(v1[2], v1[3]);
                      *(u32x4*)(Kb + ((size_t)(b * 2 + g) * 4096 + s) * 64 + d0) = w; }
                    if (p == 0) { const f32x4 v0 = acc[ai][1][m][0], v1 = acc[ai][1][m][1];
                      u32x4 w; w.x = pk2(v0[0], v0[1]); w.y = pk2(v0[2], v0[3]); w.z = pk2(v1[0], v1[1]); w.w = pk2(v1[2], v1[3]);
                      *(u32x4*)(Vb + ((size_t)(b * 2 + g) * 4096 + s) * 64 + d0) = w; }
                    else { bf16_t* vp = Vb + ((size_t)(b * 2 + g) * 64 + d0) * 4096 + s;
#pragma unroll
                      for (int n = 0; n < 2; ++n)
#pragma unroll
                          for (int e = 0; e < 4; ++e) vp[(size_t)(4 * n + e) * 4096] = (bf16_t)f2bf(acc[ai][1][m][n][e]); } }
        } else {
            if (wc == 0 && fq < 3) { float* G = (float*)(ws + WS_GATE);
#pragma unroll
                for (int ai = 0; ai < 2; ++ai)
#pragma unroll
                    for (int m = 0; m < 4; ++m) { float* gp = G + (size_t)(row0 + ai * 128 + m * 16) * 24 + 8 * fq;
#pragma unroll
                        for (int n = 0; n < 2; ++n) { f32x4 v = acc[ai][0][m][n];
#pragma unroll
                            for (int e = 0; e < 4; ++e) v[e] = sigmoidf_(v[e]);
                            *(f32x4*)(gp + 4 * n) = v; } } }
        }
    }
};

#define XB_TMO      128
#define XB_XCNT(j)  (256  + 64 * (j))
#define XB_XSUB(j)  (1280 + 64 * (j))
#define XB_XGEN(j)  (2304 + 64 * (j))
#define XB_TOP      3328
#define XB_TOPGEN   3392
#define XCD_BAR_WORDS 3456
#define XB_SPIN_CAP (1u << 18)

__device__ __forceinline__ unsigned xb_ld(unsigned* p)              { return __hip_atomic_load(p, __ATOMIC_RELAXED, __HIP_MEMORY_SCOPE_AGENT); }
__device__ __forceinline__ unsigned xb_add(unsigned* p, unsigned v) { return __hip_atomic_fetch_add(p, v, __ATOMIC_RELAXED, __HIP_MEMORY_SCOPE_AGENT); }
__device__ __forceinline__ unsigned xb_xcc_id() { return (unsigned)__builtin_amdgcn_s_getreg((3 << 11) | 20) & 0xFu; }
#define XB_SPIN(cond, bar) do { unsigned _sp = 0; while (cond) { __builtin_amdgcn_s_sleep(1); \
    if ((++_sp & 255u) == 0u) { if (xb_ld(&(bar)[XB_TMO])) break; if (_sp > XB_SPIN_CAP) { atomicAdd(&(bar)[XB_TMO], 1u); break; } } } } while (0)

struct XcdBarrier {
    unsigned* bar; unsigned x;
    volatile LAS unsigned* st;
};

__device__ __forceinline__ XcdBarrier xcd_barrier_post(unsigned* bar, volatile LAS unsigned* st) {
    XcdBarrier b; b.bar = bar; b.x = xb_xcc_id(); b.st = st;
    if (threadIdx.x == 0) (void)xb_add(&bar[XB_XCNT(b.x)], 1u);
    return b;
}
__device__ __forceinline__ void xcd_barrier_complete(unsigned* bar, unsigned x, unsigned& nloc, unsigned& nx) {
    const unsigned G = gridDim.x * gridDim.y * gridDim.z;
    unsigned sum, cnt, mine, sp = 0u;
    for (;;) {
        sum = 0u; cnt = 0u; mine = 0u;
#pragma unroll
        for (unsigned j = 0; j < 16; ++j) { const unsigned c = xb_ld(&bar[XB_XCNT(j)]); sum += c; cnt += (c > 0u) ? 1u : 0u; mine = (j == x) ? c : mine; }
        if (sum == G) break;
        __builtin_amdgcn_s_sleep(1);
        if ((++sp & 255u) == 0u) { if (xb_ld(&bar[XB_TMO])) break; if (sp > XB_SPIN_CAP) { atomicAdd(&bar[XB_TMO], 1u); break; } }
    }
    nloc = mine > 0u ? mine : 1u; nx = cnt > 0u ? cnt : 1u;
}

__device__ __forceinline__ void xcd_barrier(const XcdBarrier& b) {
    asm volatile("s_waitcnt vmcnt(0)" ::: "memory");
    __syncthreads();
    if (threadIdx.x == 0) {
        unsigned* bar = b.bar;
        __builtin_amdgcn_s_waitcnt(0);
        unsigned nloc = b.st[0], nx = b.st[1];
        if (nloc == 0u) { xcd_barrier_complete(bar, b.x, nloc, nx); b.st[0] = nloc; b.st[1] = nx; }
        const unsigned old = xb_add(&bar[XB_XSUB(b.x)], 1u);
        const unsigned gen = old / nloc;
        if (old + 1u == (gen + 1u) * nloc) {
            __builtin_amdgcn_fence(__ATOMIC_RELEASE, "agent");
            asm volatile("s_waitcnt vmcnt(0)" ::: "memory");
            const unsigned og = xb_add(&bar[XB_TOP], 1u);
            const unsigned tg = og / nx;
            if (og + 1u == (tg + 1u) * nx) xb_add(&bar[XB_TOPGEN], 1u);
            else XB_SPIN(xb_ld(&bar[XB_TOPGEN]) == tg, bar);
            __builtin_amdgcn_fence(__ATOMIC_ACQUIRE, "agent");
            xb_add(&bar[XB_XGEN(b.x)], 1u);
            asm volatile("s_waitcnt vmcnt(0)" ::: "memory");
        } else {
            XB_SPIN(xb_ld(&bar[XB_XGEN(b.x)]) == gen, bar);
            __builtin_amdgcn_fence(__ATOMIC_ACQUIRE, "agent");
            asm volatile("s_waitcnt vmcnt(0)" ::: "memory");
        }
    }
    __syncthreads();
}


__device__ __forceinline__ void tr_item(const float* W, int K, int N, bf16_t* WT, int NT, const float* gA, const float* gB, LAS float* scr, int item, int lane) {
    const int nblk = NT / 32, kb = item / nblk, nb = item % nblk, k0 = 64 * kb, n0 = 32 * nb;
#pragma unroll 8
    for (int i = 0; i < 32; ++i) { const int kk = 2 * i + (lane >> 5), n = n0 + (lane & 31), k = k0 + kk;
        float v = (n < N) ? W[(size_t)k * N + n] : 0.f;
        if (gA) v *= (k < 512) ? gA[k] : gB[k - 512];
        scr[kk * 33 + (lane & 31)] = v; }
    LDS_FENCE();
    const int c = lane & 7;
#pragma unroll
    for (int j = 0; j < 4; ++j) { const int n = (lane >> 3) + 8 * j; const LAS float* s = scr + (8 * c) * 33 + n;
        u32x4 o; o.x = pk2(s[0 * 33], s[1 * 33]); o.y = pk2(s[2 * 33], s[3 * 33]); o.z = pk2(s[4 * 33], s[5 * 33]); o.w = pk2(s[6 * 33], s[7 * 33]);
        *(u32x4*)(WT + (size_t)(n0 + n) * K + k0 + 8 * c) = o; }
    LDS_FENCE();
}
__device__ __forceinline__ void p0_mod_item(Frame& F, int item) {
    LAS float* sc = (LAS float*)F.lds; LAS float* red = (LAS float*)(F.lds + 32768);
    const float* c = F.in[1]; const float* ada_w = F.in[2]; const float* ada_b = F.in[3];
    for (int idx = F.tid; idx < 8192; idx += 512) { const float v = c[idx]; sc[idx] = v / (1.0f + __expf(-v)); }
    __syncthreads();
    float acc[8];
#pragma unroll
    for (int b = 0; b < 8; ++b) acc[b] = 0.f;
    const int kbase = 128 * F.wave; const float* wp = ada_w + (size_t)kbase * NMOD + 64 * item + F.lane;
#pragma unroll 8
    for (int kk = 0; kk < 128; ++kk) { const float wv = wp[(size_t)kk * NMOD];
#pragma unroll
        for (int b = 0; b < 8; ++b) acc[b] += sc[b * 1024 + kbase + kk] * wv; }
#pragma unroll
    for (int b = 0; b < 8; ++b) red[(F.wave * 8 + b) * 64 + F.lane] = acc[b];
    __syncthreads();
    { const int b = F.tid >> 6, col = F.tid & 63; float s = ada_b[64 * item + col];
#pragma unroll
      for (int w = 0; w < 8; ++w) s += red[(w * 8 + b) * 64 + col];
      ((float*)(F.ws + WS_MOD))[b * NMOD + 64 * item + col] = s; }
    __syncthreads();
}
__device__ __forceinline__ void p0_prologue(Frame& F) {
    for (int it = F.bid; it < NMOD / 64; it += F.G) p0_mod_item(F, it);
    LAS float* scr = (LAS float*)(F.lds + F.wave * 16384);
    const int gw = F.bid * 8 + F.wave, NGW = F.G * 8;
    constexpr int I_IN = 16 * (NZ / 32), I_OUT = 16 * 32, I_F1 = 16 * 128, I_F2 = 64 * 32, I_C1 = 32 * 8, I_C2 = 4 * 2, I_L = 2;
    constexpr int NTR = I_IN + I_OUT + I_F1 + I_F2 + 2 * I_C1 + 2 * I_C2 + 16 * I_L;
    constexpr int NITEMS = NTR + 128 + 8;
    unsigned char* ws = F.ws;
    for (int it = gw; it < NITEMS; it += NGW) {
        int r = it;
        if (r < I_IN) { tr_item(F.in[5], DM, 2328, (bf16_t*)(ws + WS_WINT), NZ, nullptr, nullptr, scr, r, F.lane); continue; } r -= I_IN;
        if (r < I_OUT) { tr_item(F.in[21], DM, DM, (bf16_t*)(ws + WS_WOUTT), DM, F.in[19], F.in[20], scr, r, F.lane); continue; } r -= I_OUT;
        if (r < I_F1) { tr_item(F.in[24], DM, DFF, (bf16_t*)(ws + WS_WFF1T), DFF, nullptr, nullptr, scr, r, F.lane); continue; } r -= I_F1;
        if (r < I_F2) { tr_item(F.in[25], DFF, DM, (bf16_t*)(ws + WS_WFF2T), DM, nullptr, nullptr, scr, r, F.lane); continue; } r -= I_F2;
        if (r < I_C1) { tr_item(F.in[14], 2048, 256, (bf16_t*)(ws + WS_CW1KT), 256, nullptr, nullptr, scr, r, F.lane); continue; } r -= I_C1;
        if (r < I_C1) { tr_item(F.in[17], 2048, 256, (bf16_t*)(ws + WS_CW1VT), 256, nullptr, nullptr, scr, r, F.lane); continue; } r -= I_C1;
        if (r < I_C2) { tr_item(F.in[15], 256, 64, (bf16_t*)(ws + WS_CW2KT), 64, nullptr, nullptr, scr, r, F.lane); continue; } r -= I_C2;
        if (r < I_C2) { tr_item(F.in[18], 256, 64, (bf16_t*)(ws + WS_CW2VT), 64, nullptr, nullptr, scr, r, F.lane); continue; } r -= I_C2;
        if (r < 8 * I_L) { const int n = r / I_L; tr_item(F.in[8] + n * 4096, 64, 64, (bf16_t*)(ws + WS_WAT) + n * 4096, 64, nullptr, nullptr, scr, r % I_L, F.lane); continue; } r -= 8 * I_L;
        if (r < 8 * I_L) { const int n = r / I_L; tr_item(F.in[10] + n * 4096, 64, 64, (bf16_t*)(ws + WS_WXT) + n * 4096, 64, nullptr, nullptr, scr, r % I_L, F.lane); continue; } r -= 8 * I_L;
        if (r < 128) {
            const int mat = r >> 6, cgp = (r >> 4) & 3, ks = r & 15; const float* pos = F.in[mat ? 16 : 13]; const float* w1 = F.in[mat ? 17 : 14];
            float a = 0.f; const int col = 64 * cgp + F.lane;
#pragma unroll 8
            for (int kk = 0; kk < 128; ++kk) { const int k = 128 * ks + kk; a += pos[k] * w1[(size_t)k * 256 + col]; }
            ((float*)(ws + WS_CB1P))[(mat * 16 + ks) * 256 + col] = a; continue; } r -= 128;
        { const int ch = 64 * r + F.lane; const float lam = F.in[12][ch]; ((float*)(ws + WS_LRUC))[ch] = -8.0f * log1pf(expf(-lam)); }
    }
}

__device__ __forceinline__ void p1_rows(Frame& F) {
    if (F.bid == 0) { const int mat = F.tid >> 8, col = F.tid & 255; float s = 0.f; const float* P = (const float*)(F.ws + WS_CB1P);
#pragma unroll
        for (int ks = 0; ks < 16; ++ks) s += P[(mat * 16 + ks) * 256 + col];
        ((float*)(F.ws + WS_CB1))[mat * 256 + col] = s; }
    const float* x = F.in[0]; const float* g = F.in[4]; const float* mod = (const float*)(F.ws + WS_MOD); bf16_t* H = (bf16_t*)(F.ws + WS_H);
    const int gw = F.bid * 8 + F.wave, NGW = F.G * 8;
    for (int rb = gw; rb < M / 16; rb += NGW) {
        const int b = (rb * 16) >> 12; f32x4 Gk[4], Sh[4];
#pragma unroll
        for (int j = 0; j < 4; ++j) { const int k = 4 * F.lane + 256 * j; const f32x4 gg = *(const f32x4*)(g + k), sc = *(const f32x4*)(mod + b * NMOD + 1024 + k);
            Gk[j] = gg * (sc + 1.0f); Sh[j] = *(const f32x4*)(mod + b * NMOD + k); }
        for (int rr = 0; rr < 16; ++rr) { const size_t row = (size_t)rb * 16 + rr; const f32x4* xr = (const f32x4*)(x + row * DM) + F.lane;
            f32x4 v[4]; float s = 0.f;
#pragma unroll
            for (int j = 0; j < 4; ++j) { v[j] = xr[64 * j]; s += (v[j].x * v[j].x + v[j].y * v[j].y) + (v[j].z * v[j].z + v[j].w * v[j].w); }
            const float rstd = rsqrtf(wave_sum(s) * (1.0f / DM) + EPS);
            unsigned long long* o8 = (unsigned long long*)(H + row * DM) + F.lane;
#pragma unroll
            for (int j = 0; j < 4; ++j) { const f32x4 h = v[j] * rstd * Gk[j] + Sh[j]; o8[64 * j] = (unsigned long long)pk2(h.x, h.y) | ((unsigned long long)pk2(h.z, h.w) << 32); } }
    }
}
__device__ __forceinline__ void p7_rows(Frame& F, float* out) {
    const float* x = F.in[0]; const float* pnm = F.in[22]; const float* pre = F.in[23]; const float* mod = (const float*)(F.ws + WS_MOD);
    const float* Y = (const float*)(F.ws + WS_Y); bf16_t* H = (bf16_t*)(F.ws + WS_H);
    const int gw = F.bid * 8 + F.wave, NGW = F.G * 8;
    for (int rb = gw; rb < M / 16; rb += NGW) {
        const int b = (rb * 16) >> 12; f32x4 A1[4], G2[4], S2[4];
#pragma unroll
        for (int j = 0; j < 4; ++j) { const int k = 4 * F.lane + 256 * j;
            A1[j] = *(const f32x4*)(pnm + k) * (*(const f32x4*)(mod + b * NMOD + 2048 + k) + 1.0f);
            G2[j] = *(const f32x4*)(pre + k) * (*(const f32x4*)(mod + b * NMOD + 4096 + k) + 1.0f);
            S2[j] = *(const f32x4*)(mod + b * NMOD + 3072 + k); }
        for (int rr = 0; rr < 16; ++rr) { const size_t row = (size_t)rb * 16 + rr;
            const f32x4* xr = (const f32x4*)(x + row * DM) + F.lane; const f32x4* yr = (const f32x4*)(Y + row * DM) + F.lane;
            f32x4 xv[4], yv[4]; float s = 0.f;
#pragma unroll
            for (int j = 0; j < 4; ++j) { xv[j] = xr[64 * j]; yv[j] = yr[64 * j]; s += (yv[j].x * yv[j].x + yv[j].y * yv[j].y) + (yv[j].z * yv[j].z + yv[j].w * yv[j].w); }
            const float rstd = rsqrtf(wave_sum(s) * (1.0f / DM) + EPS); float s2 = 0.f;
            f32x4* orow = (f32x4*)(out + row * DM) + F.lane;
#pragma unroll
            for (int j = 0; j < 4; ++j) { xv[j] = xv[j] + A1[j] * (yv[j] * rstd); orow[64 * j] = xv[j]; s2 += (xv[j].x * xv[j].x + xv[j].y * xv[j].y) + (xv[j].z * xv[j].z + xv[j].w * xv[j].w); }
            const float rstd2 = rsqrtf(wave_sum(s2) * (1.0f / DM) + EPS);
            unsigned long long* o8 = (unsigned long long*)(H + row * DM) + F.lane;
#pragma unroll
            for (int j = 0; j < 4; ++j) { const f32x4 h = xv[j] * rstd2 * G2[j] + S2[j]; o8[64 * j] = (unsigned long long)pk2(h.x, h.y) | ((unsigned long long)pk2(h.z, h.w) << 32); } }
    }
}
__device__ __forceinline__ void p10_rows(Frame& F, float* out) {
    const float* pnm = F.in[26]; const float* mod = (const float*)(F.ws + WS_MOD); const float* Y = (const float*)(F.ws + WS_Y2);
    const int gw = F.bid * 8 + F.wave, NGW = F.G * 8;
    for (int rb = gw; rb < M / 16; rb += NGW) {
        const int b = (rb * 16) >> 12; f32x4 A2[4];
#pragma unroll
        for (int j = 0; j < 4; ++j) { const int k = 4 * F.lane + 256 * j; A2[j] = *(const f32x4*)(pnm + k) * (*(const f32x4*)(mod + b * NMOD + 5120 + k) + 1.0f); }
        for (int rr = 0; rr < 16; ++rr) { const size_t row = (size_t)rb * 16 + rr;
            f32x4* orow = (f32x4*)(out + row * DM) + F.lane; const f32x4* yr = (const f32x4*)(Y + row * DM) + F.lane;
            f32x4 xv[4], yv[4]; float s = 0.f;
#pragma unroll
            for (int j = 0; j < 4; ++j) { xv[j] = orow[64 * j]; yv[j] = yr[64 * j]; s += (yv[j].x * yv[j].x + yv[j].y * yv[j].y) + (yv[j].z * yv[j].z + yv[j].w * yv[j].w); }
            const float rstd = rsqrtf(wave_sum(s) * (1.0f / DM) + EPS);
#pragma unroll
            for (int j = 0; j < 4; ++j) orow[64 * j] = xv[j] + A2[j] * (yv[j] * rstd); }
    }
}

constexpr int RNN_WL = 11264, RNN_PART_OFF = 8 * RNN_WL;
template <int PASS> __device__ __forceinline__ void rnn_item(Frame& F, int b, int chunk) {
    const int n = F.wave, lane = F.lane, ch = 64 * n + lane, fr = lane & 15, fq = lane >> 4;
    LAS unsigned char* wl = F.lds + n * RNN_WL;
    LAS bf16_t* xcb = (LAS bf16_t*)wl; LAS float* Ab = (LAS float*)(wl + 2304); LAS float* Gb = (LAS float*)(wl + 6656);
    LAS float* part = (LAS float*)(F.lds + RNN_PART_OFF);
    const float* conv_w = F.in[6]; const float cw0 = conv_w[ch], cw1 = conv_w[512 + ch], cw2 = conv_w[1024 + ch], cw3 = conv_w[1536 + ch], cb = F.in[7][ch];
    const bf16_t* WA = (const bf16_t*)(F.ws + WS_WAT) + n * 4096; const bf16_t* WX = (const bf16_t*)(F.ws + WS_WXT) + n * 4096;
    bf16x8 waf[4][2], wxf[4][2]; f32x4 ba4[4], bx4[4], lc4[4];
#pragma unroll
    for (int nb = 0; nb < 4; ++nb) {
#pragma unroll
        for (int ks = 0; ks < 2; ++ks) { waf[nb][ks] = *(const bf16x8*)(WA + (16 * nb + fr) * 64 + 32 * ks + 8 * fq); wxf[nb][ks] = *(const bf16x8*)(WX + (16 * nb + fr) * 64 + 32 * ks + 8 * fq); }
        const int c0 = 64 * n + 16 * nb + 4 * fq;
        ba4[nb] = *(const f32x4*)(F.in[9] + c0); bx4[nb] = *(const f32x4*)(F.in[11] + c0); lc4[nb] = *(const f32x4*)((const float*)(F.ws + WS_LRUC) + c0); }
    const bf16_t* XR = (const bf16_t*)(F.ws + WS_XRNN); const bf16_t* GR = (const bf16_t*)(F.ws + WS_GRNN); bf16_t* YC = (bf16_t*)(F.ws + WS_YCAT);
    const int t0 = chunk * 64; const size_t rowbase = (size_t)b * SEQ;
    float xm3 = 0.f, xm2 = 0.f, xm1 = 0.f;
    if (chunk > 0) { xm3 = bf2f(XR[(rowbase + t0 - 3) * 512 + ch]); xm2 = bf2f(XR[(rowbase + t0 - 2) * 512 + ch]); xm1 = bf2f(XR[(rowbase + t0 - 1) * 512 + ch]); }
    float h = 0.f, ap = 1.f;
    float* RA = (float*)(F.ws + WS_RA); float* RH = (float*)(F.ws + WS_RH);
    if (PASS == 2) { for (int c2 = 0; c2 < chunk; ++c2) { const size_t o = (size_t)(b * 64 + c2) * 512 + ch; h = RA[o] * h + RH[o]; } }
    for (int sub = 0; sub < 4; ++sub) {
        float xc[16]; const size_t r0 = rowbase + t0 + 16 * sub;
#pragma unroll
        for (int tt = 0; tt < 16; ++tt) { const float xv = bf2f(XR[(r0 + tt) * 512 + ch]); xc[tt] = cb + cw0 * xm3 + cw1 * xm2 + cw2 * xm1 + cw3 * xv; xm3 = xm2; xm2 = xm1; xm1 = xv; xcb[tt * 72 + lane] = (bf16_t)f2bf(xc[tt]); }
        LDS_FENCE();
        bf16x8 xb[2];
#pragma unroll
        for (int ks = 0; ks < 2; ++ks) xb[ks] = *(const LAS bf16x8*)(xcb + fr * 72 + 32 * ks + 8 * fq);
#pragma unroll
        for (int nb = 0; nb < 4; ++nb) { f32x4 aA = {0.f, 0.f, 0.f, 0.f}, aX = {0.f, 0.f, 0.f, 0.f};
#pragma unroll
            for (int ks = 0; ks < 2; ++ks) { aA = __builtin_amdgcn_mfma_f32_16x16x32_bf16(waf[nb][ks], xb[ks], aA, 0, 0, 0); aX = __builtin_amdgcn_mfma_f32_16x16x32_bf16(wxf[nb][ks], xb[ks], aX, 0, 0, 0); }
            f32x4 av, gv;
#pragma unroll
            for (int e = 0; e < 4; ++e) { const float rr = sigmoidf_(aA[e] + ba4[nb][e]), ii = sigmoidf_(aX[e] + bx4[nb][e]); const float la = lc4[nb][e] * rr;
                av[e] = __expf(la); gv[e] = sqrtf(fmaxf(-expm1f(2.0f * la), 0.f)) * ii; }
            *(LAS f32x4*)(Ab + fr * 68 + 16 * nb + 4 * fq) = av; *(LAS f32x4*)(Gb + fr * 68 + 16 * nb + 4 * fq) = gv; }
        LDS_FENCE();
        float y[16];
#pragma unroll
        for (int tt = 0; tt < 16; ++tt) { const float a = Ab[tt * 68 + lane], gg = Gb[tt * 68 + lane]; h = a * h + gg * xc[tt]; ap *= a;
            if (PASS == 2) y[tt] = h * gelu_tanh(bf2f(GR[(r0 + tt) * 512 + ch])); }
        LDS_FENCE();
        if (PASS == 2) {
#pragma unroll
            for (int tt = 0; tt < 16; ++tt) { const float v = wave_sum(y[tt] * y[tt]); if (lane == 0) part[((sub & 1) * 8 + n) * 16 + tt] = v; }
            __syncthreads();
#pragma unroll
            for (int tt = 0; tt < 16; ++tt) { float tot = 0.f;
#pragma unroll
                for (int w = 0; w < 8; ++w) tot += part[((sub & 1) * 8 + w) * 16 + tt];
                const float rstd = rsqrtf(tot * (1.0f / 512.0f) + EPS);
                YC[(r0 + tt) * 1024 + ch] = (bf16_t)f2bf(y[tt] * rstd); }
        }
    }
    if (PASS == 1) { const size_t o = (size_t)(b * 64 + chunk) * 512 + ch; RA[o] = ap; RH[o] = h; }
    if (PASS == 2) __syncthreads();
}

__device__ __forceinline__ void cmp2_item(Frame& F, int item) {
    const int mat = item >> 8, rb = item & 255, lane = F.lane, fr = lane & 15, fq = lane >> 4;
    const bf16_t* Hd = (const bf16_t*)(F.ws + (mat ? WS_CHIDV : WS_CHIDK)) + (size_t)(16 * rb + fr) * 256 + 8 * fq;
    const bf16_t* W2 = (const bf16_t*)(F.ws + (mat ? WS_CW2VT : WS_CW2KT)) + (size_t)fr * 256 + 8 * fq;
    f32x4 acc[4];
#pragma unroll
    for (int nb = 0; nb < 4; ++nb) acc[nb] = (f32x4){0.f, 0.f, 0.f, 0.f};
#pragma unroll
    for (int ks = 0; ks < 8; ++ks) { const bf16x8 hb = *(const bf16x8*)(Hd + 32 * ks);
#pragma unroll
        for (int nb = 0; nb < 4; ++nb) { const bf16x8 wf = *(const bf16x8*)(W2 + (size_t)(16 * nb) * 256 + 32 * ks); acc[nb] = __builtin_amdgcn_mfma_f32_16x16x32_bf16(wf, hb, acc[nb], 0, 0, 0); } }
    const int R = 16 * rb + fr;
    if (mat == 0) { bf16_t* O = (bf16_t*)(F.ws + WS_KCMP) + (size_t)R * 64 + 4 * fq;
#pragma unroll
        for (int nb = 0; nb < 4; ++nb) { u32x2 w; w.x = pk2(acc[nb][0], acc[nb][1]); w.y = pk2(acc[nb][2], acc[nb][3]); *(u32x2*)(O + 16 * nb) = w; }
    } else { const int bg = R >> 8, c = R & 255; bf16_t* O = (bf16_t*)(F.ws + WS_VCMPT) + (size_t)bg * 64 * 256 + c;
#pragma unroll
        for (int nb = 0; nb < 4; ++nb)
#pragma unroll
            for (int e = 0; e < 4; ++e) O[(size_t)(16 * nb + 4 * fq + e) * 256] = (bf16_t)f2bf(acc[nb][e]); }
}

constexpr int AT_BUF = 35840, AT_K1 = 9216, AT_V0 = 18432, AT_V1 = 27136, AT_IMP = 2 * AT_BUF, AT_IMP_BYTES = 8 * 32 * 65 * 4;
constexpr int AT_SELM = AT_IMP + AT_IMP_BYTES, AT_UNION = AT_SELM + 512, AT_SSQ = AT_UNION + 16;
static_assert(AT_SSQ + 1024 <= LDS_BYTES, "attention LDS map");
struct TileSrc { const bf16_t* k0; const bf16_t* k1; const bf16_t* v0; const bf16_t* v1; };
__device__ __forceinline__ void at_load(u32x4 (&st)[4], const TileSrc& s, int vpitch, int tid) {
    st[0] = *(const u32x4*)(s.k0 + tid * 8); st[1] = *(const u32x4*)(s.k1 + tid * 8);
    const int dim = tid >> 3, part = tid & 7;
    st[2] = *(const u32x4*)(s.v0 + (size_t)dim * vpitch + part * 8); st[3] = *(const u32x4*)(s.v1 + (size_t)dim * vpitch + part * 8);
}
__device__ __forceinline__ void at_store(LAS unsigned char* buf, const u32x4 (&st)[4], int tid) {
    const int key = tid >> 3, part = tid & 7;
    *(LAS u32x4*)(buf + key * 144 + part * 16) = st[0];
    *(LAS u32x4*)(buf + AT_K1 + key * 144 + part * 16) = st[1];
    LAS unsigned char* v0 = buf + AT_V0 + key * 136 + part * 16; LAS unsigned char* v1 = buf + AT_V1 + key * 136 + part * 16;
    *(LAS u32x2*)(v0) = (u32x2){st[2].x, st[2].y}; *(LAS u32x2*)(v0 + 8) = (u32x2){st[2].z, st[2].w};
    *(LAS u32x2*)(v1) = (u32x2){st[3].x, st[3].y}; *(LAS u32x2*)(v1 + 8) = (u32x2){st[3].z, st[3].w};
}
__device__ __forceinline__ void at_qk(f32x16 (&s)[2], const LAS unsigned char* kb, const bf16x8 (&qf)[4], int r32, int hi) {
#pragma unroll
    for (int kb2 = 0; kb2 < 2; ++kb2) { f32x16 a = {};
#pragma unroll
        for (int ks = 0; ks < 4; ++ks) { const bf16x8 kf = *(const LAS bf16x8*)(kb + (32 * kb2 + r32) * 144 + (16 * ks + 8 * hi) * 2); a = __builtin_amdgcn_mfma_f32_32x32x16_bf16(kf, qf[ks], a, 0, 0, 0); }
        s[kb2] = a; }
}
__device__ __forceinline__ void at_mask(f32x16 (&s)[2], int base_d, int step, int dmax, bool rowok, float slope2, int hi) {
#pragma unroll
    for (int kb2 = 0; kb2 < 2; ++kb2)
#pragma unroll
        for (int r = 0; r < 16; ++r) { const int key = 32 * kb2 + (r & 3) + 8 * (r >> 2) + 4 * hi; const int d = base_d - step * key;
            const bool ok = rowok && d >= 0 && d < dmax; s[kb2][r] = ok ? fmaf(s[kb2][r], LOG2E, -slope2 * (float)d) : NEGF; }
}
__device__ __forceinline__ float at_max(const f32x16 (&s)[2]) {
    float mx = s[0][0];
#pragma unroll
    for (int r = 1; r < 16; ++r) mx = fmaxf(mx, s[0][r]);
#pragma unroll
    for (int r = 0; r < 16; ++r) mx = fmaxf(mx, s[1][r]);
    return fmaxf(mx, __shfl_xor(mx, 32));
}
__device__ __forceinline__ void at_pv(f32x16 (&O)[2], const LAS unsigned char* vb, const f32x16 (&p)[2], int r32, int hi) {
#pragma unroll
    for (int kb2 = 0; kb2 < 2; ++kb2)
#pragma unroll
        for (int s2 = 0; s2 < 2; ++s2) {
            u32x4 pw; pw.x = pk2(p[kb2][8 * s2 + 0], p[kb2][8 * s2 + 1]); pw.y = pk2(p[kb2][8 * s2 + 2], p[kb2][8 * s2 + 3]); pw.z = pk2(p[kb2][8 * s2 + 4], p[kb2][8 * s2 + 5]); pw.w = pk2(p[kb2][8 * s2 + 6], p[kb2][8 * s2 + 7]);
            const bf16x8 pf = __builtin_bit_cast(bf16x8, pw);
#pragma unroll
            for (int db = 0; db < 2; ++db) { const LAS unsigned char* va = vb + (32 * db + r32) * 136 + (32 * kb2 + 16 * s2 + 4 * hi) * 2;
                const u32x2 lo = *(const LAS u32x2*)(va), hh = *(const LAS u32x2*)(va + 16);
                const bf16x8 vf = __builtin_bit_cast(bf16x8, (u32x4){lo.x, lo.y, hh.x, hh.y});
                O[db] = __builtin_amdgcn_mfma_f32_32x32x16_bf16(vf, pf, O[db], 0, 0, 0); } }
}
__device__ __forceinline__ void at_online(f32x16 (&s)[2], float& m, float& l, f32x16 (&O)[2], const LAS unsigned char* vb, int r32, int hi) {
    const float mn = fmaxf(m, at_max(s)); const float f = __builtin_amdgcn_exp2f(m - mn); m = mn; float ps = 0.f;
#pragma unroll
    for (int kb2 = 0; kb2 < 2; ++kb2)
#pragma unroll
        for (int r = 0; r < 16; ++r) { const float p = __builtin_amdgcn_exp2f(s[kb2][r] - mn); s[kb2][r] = p; ps += p; }
    l = l * f + ps;
#pragma unroll
    for (int db = 0; db < 2; ++db)
#pragma unroll
        for (int r = 0; r < 16; ++r) O[db][r] *= f;
    at_pv(O, vb, s, r32, hi);
}

__device__ __forceinline__ void attn_item(Frame& F, int b, int i) {
    const int tid = F.tid, lane = F.lane, h = F.wave, g = h >> 2, r32 = lane & 31, hi = lane >> 5;
    const int q0 = 32 * i, tq = q0 + r32; const size_t row = (size_t)b * SEQ + tq;
    LAS unsigned char* lds = F.lds;
    LAS float* IMP = (LAS float*)(lds + AT_IMP); LAS unsigned long long* SELM = (LAS unsigned long long*)(lds + AT_SELM);
    LAS unsigned* UNI = (LAS unsigned*)(lds + AT_UNION); LAS float* SSQ = (LAS float*)(lds + AT_SSQ);
    const bf16_t* Qp = (const bf16_t*)(F.ws + WS_Q) + row * 512 + h * 64 + 8 * hi;
    bf16x8 qf[4];
#pragma unroll
    for (int ks = 0; ks < 4; ++ks) qf[ks] = *(const bf16x8*)(Qp + 16 * ks);
    const float slope2 = __builtin_amdgcn_exp2f(-(float)(h + 1)) * LOG2E;
    const float* GT = (const float*)(F.ws + WS_GATE) + row * 24; const float gate_c = GT[h], gate_s = GT[8 + h], gate_w = GT[16 + h];
    f32x16 out[2]; out[0] = f32x16{}; out[1] = f32x16{};
    if (tid < 4) UNI[tid] = 0u;
    const int koff = g ? AT_K1 : 0, voff = g ? AT_V1 : AT_V0;
    const size_t bg0 = (size_t)b * 2;
    u32x4 st[4];
    const bf16_t* KC = (const bf16_t*)(F.ws + WS_KCMP); const bf16_t* VC = (const bf16_t*)(F.ws + WS_VCMPT);
    const int nc = (i >> 5) + 1;
#define CMP_SRC(jc) TileSrc{KC + ((bg0 + 0) * 256 + 64 * (jc)) * 64, KC + ((bg0 + 1) * 256 + 64 * (jc)) * 64, VC + (bg0 + 0) * 64 * 256 + 64 * (jc), VC + (bg0 + 1) * 64 * 256 + 64 * (jc)}
    float m = NEGF, l = 0.f;
    { at_load(st, CMP_SRC(0), 256, tid); at_store(lds, st, tid); __syncthreads(); }
    for (int jc = 0; jc < nc; ++jc) {
        LAS unsigned char* buf = lds + (jc & 1) * AT_BUF; const bool more = jc + 1 < nc;
        if (more) at_load(st, CMP_SRC(jc + 1), 256, tid);
        f32x16 s[2]; at_qk(s, buf + koff, qf, r32, hi); at_mask(s, tq - 31 - 1024 * jc, 16, 0x7fffffff, true, slope2, hi);
        const float mn = fmaxf(m, at_max(s)); float ps = 0.f;
#pragma unroll
        for (int kb2 = 0; kb2 < 2; ++kb2)
#pragma unroll
            for (int r = 0; r < 16; ++r) ps += __builtin_amdgcn_exp2f(s[kb2][r] - mn);
        l = l * __builtin_amdgcn_exp2f(m - mn) + ps; m = mn;
        if (more) at_store(lds + ((jc + 1) & 1) * AT_BUF, st, tid);
        __syncthreads();
    }
    {
        const float ltot = l + __shfl_xor(l, 32); const float inv = (tq >= 31) ? 1.0f / ltot : 0.f;
        f32x16 O[2]; O[0] = f32x16{}; O[1] = f32x16{}; float carry = 0.f;
        { at_load(st, CMP_SRC(0), 256, tid); at_store(lds, st, tid); __syncthreads(); }
        for (int jc = 0; jc < nc; ++jc) {
            LAS unsigned char* buf = lds + (jc & 1) * AT_BUF; const bool more = jc + 1 < nc;
            if (more) at_load(st, CMP_SRC(jc + 1), 256, tid);
            f32x16 s[2]; at_qk(s, buf + koff, qf, r32, hi); at_mask(s, tq - 31 - 1024 * jc, 16, 0x7fffffff, true, slope2, hi);
#pragma unroll
            for (int kb2 = 0; kb2 < 2; ++kb2)
#pragma unroll
                for (int r = 0; r < 16; ++r) s[kb2][r] = __builtin_amdgcn_exp2f(s[kb2][r] - m) * inv;
            float sum4[8], recv[8];
#pragma unroll
            for (int g8 = 0; g8 < 8; ++g8) { const int kb2 = g8 >> 2, qq = g8 & 3; sum4[g8] = (s[kb2][4 * qq] + s[kb2][4 * qq + 1]) + (s[kb2][4 * qq + 2] + s[kb2][4 * qq + 3]); recv[g8] = __shfl_xor(s[kb2][4 * qq + 3], 32); }
#pragma unroll
            for (int g8 = 0; g8 < 8; ++g8) { const float extra = hi ? recv[g8] : (g8 ? recv[g8 > 0 ? g8 - 1 : 0] : carry);
                IMP[(h * 32 + r32) * 65 + 16 * jc + 2 * g8 + hi] = sum4[g8] + extra; }
            carry = recv[7];
            at_pv(O, buf + voff, s, r32, hi);
            if (more) at_store(lds + ((jc + 1) & 1) * AT_BUF, st, tid);
            __syncthreads();
        }
#pragma unroll
        for (int db = 0; db < 2; ++db)
#pragma unroll
            for (int r = 0; r < 16; ++r) out[db][r] = gate_c * O[db][r];
    }
#undef CMP_SRC
    {
        unsigned long long un0 = 0ull, un1 = 0ull;
        for (int pp = 0; pp < 8; ++pp) { const int g2 = pp >> 2, q = 4 * h + (pp & 3), t = q0 + q, cur_t = t >> 6;
            float v = 0.f;
#pragma unroll
            for (int hh = 0; hh < 4; ++hh) v += IMP[((4 * g2 + hh) * 32 + q) * 65 + lane];
            const bool forced = (lane == 0) || (lane == cur_t) || (lane == cur_t - 1), vis = lane <= cur_t;
            const float val = forced ? 1e4f : (vis ? v : NEGF); int rank = 0;
#pragma unroll
            for (int jj = 0; jj < 64; ++jj) { const float o = __builtin_bit_cast(float, __builtin_amdgcn_readlane(__builtin_bit_cast(int, val), jj)); rank += ((o > val) || (o == val && jj < lane)) ? 1 : 0; }
            const unsigned long long mask = __ballot((rank < 16) && vis);
            if (lane == 0) SELM[g2 * 32 + q] = mask;
            if (g2) un1 |= mask; else un0 |= mask; }
        if (lane == 0) { atomicOr((unsigned*)&UNI[0], (unsigned)un0); atomicOr((unsigned*)&UNI[1], (unsigned)(un0 >> 32)); atomicOr((unsigned*)&UNI[2], (unsigned)un1); atomicOr((unsigned*)&UNI[3], (unsigned)(un1 >> 32)); }
        __syncthreads();
    }
    const bf16_t* KVb = (const bf16_t*)(F.ws + WS_KV);
#define KV_SRC(kidx, j) TileSrc{KVb + (size_t)(kidx) * (KV_STRIDE / 2) + ((bg0 + 0) * 4096 + 64 * (j)) * 64, KVb + (size_t)(kidx) * (KV_STRIDE / 2) + ((bg0 + 1) * 4096 + 64 * (j)) * 64, \
        KVb + (size_t)((kidx) + 1) * (KV_STRIDE / 2) + (bg0 + 0) * 64 * 4096 + 64 * (j), KVb + (size_t)((kidx) + 1) * (KV_STRIDE / 2) + (bg0 + 1) * 64 * 4096 + 64 * (j)}
    {
        const unsigned u0 = __builtin_amdgcn_readfirstlane(UNI[0]), u1 = __builtin_amdgcn_readfirstlane(UNI[1]), u2 = __builtin_amdgcn_readfirstlane(UNI[2]), u3 = __builtin_amdgcn_readfirstlane(UNI[3]);
        const unsigned long long U0 = ((unsigned long long)u1 << 32) | u0, U1 = ((unsigned long long)u3 << 32) | u2, Ug = g ? U1 : U0;
        unsigned long long rem = U0 | U1;
        const unsigned long long mysel = SELM[g * 32 + r32];
        m = NEGF; l = 0.f; f32x16 O[2]; O[0] = f32x16{}; O[1] = f32x16{};
        int j = __builtin_ctzll(rem); rem &= rem - 1;
        { at_load(st, KV_SRC(2, j), 4096, tid); at_store(lds, st, tid); __syncthreads(); }
        int par = 0;
        for (;;) {
            LAS unsigned char* buf = lds + par * AT_BUF; const bool more = rem != 0ull; const int jn = more ? __builtin_ctzll(rem) : 0; rem &= rem - 1;
            if (more) at_load(st, KV_SRC(2, jn), 4096, tid);
            if ((Ug >> j) & 1ull) { f32x16 s[2]; at_qk(s, buf + koff, qf, r32, hi); at_mask(s, tq - 64 * j, 1, 0x7fffffff, ((mysel >> j) & 1ull) != 0ull, slope2, hi);
                at_online(s, m, l, O, buf + voff, r32, hi); }
            if (more) at_store(lds + (par ^ 1) * AT_BUF, st, tid);
            __syncthreads();
            if (!more) break;
            j = jn; par ^= 1;
        }
        const float ltot = l + __shfl_xor(l, 32); const float sc = gate_s / ltot;
#pragma unroll
        for (int db = 0; db < 2; ++db)
#pragma unroll
            for (int r = 0; r < 16; ++r) out[db][r] += sc * O[db][r];
    }
    {
        const int jhi = q0 >> 6; int jlo = (q0 - 511) >> 6; if (jlo < 0) jlo = 0;
        m = NEGF; l = 0.f; f32x16 O[2]; O[0] = f32x16{}; O[1] = f32x16{};
        { at_load(st, KV_SRC(4, jlo), 4096, tid); at_store(lds, st, tid); __syncthreads(); }
        for (int j = jlo; j <= jhi; ++j) {
            LAS unsigned char* buf = lds + ((j - jlo) & 1) * AT_BUF; const bool more = j < jhi;
            if (more) at_load(st, KV_SRC(4, j + 1), 4096, tid);
            f32x16 s[2]; at_qk(s, buf + koff, qf, r32, hi); at_mask(s, tq - 64 * j, 1, 512, true, slope2, hi);
            at_online(s, m, l, O, buf + voff, r32, hi);
            if (more) at_store(lds + ((j - jlo + 1) & 1) * AT_BUF, st, tid);
            __syncthreads();
        }
        const float ltot = l + __shfl_xor(l, 32); const float sc = gate_w / ltot;
#pragma unroll
        for (int db = 0; db < 2; ++db)
#pragma unroll
            for (int r = 0; r < 16; ++r) out[db][r] += sc * O[db][r];
    }
#undef KV_SRC
    {
        float ss = 0.f;
#pragma unroll
        for (int db = 0; db < 2; ++db)
#pragma unroll
            for (int r = 0; r < 16; ++r) ss += out[db][r] * out[db][r];
        ss += __shfl_xor(ss, 32);
        if (hi == 0) SSQ[h * 32 + r32] = ss;
        __syncthreads();
        float tot = 0.f;
#pragma unroll
        for (int hh = 0; hh < 8; ++hh) tot += SSQ[hh * 32 + r32];
        const float rstd = rsqrtf(tot * (1.0f / 512.0f) + EPS);
        bf16_t* yp = (bf16_t*)(F.ws + WS_YCAT) + row * 1024 + 512 + h * 64 + 4 * hi;
#pragma unroll
        for (int db = 0; db < 2; ++db)
#pragma unroll
            for (int qq = 0; qq < 4; ++qq) { u32x2 w; w.x = pk2(out[db][4 * qq] * rstd, out[db][4 * qq + 1] * rstd); w.y = pk2(out[db][4 * qq + 2] * rstd, out[db][4 * qq + 3] * rstd);
                *(u32x2*)(yp + 32 * db + 8 * qq) = w; }
        __syncthreads();
    }
}

__global__ void __launch_bounds__(512) hybrid_fwd(Args args) {
    extern __shared__ __attribute__((aligned(16))) unsigned char lds_raw[];
    cg::grid_group grid = cg::this_grid();
    Frame F; F.lds = (LAS unsigned char*)lds_raw; F.tid = threadIdx.x; F.lane = F.tid & 63; F.wave = __builtin_amdgcn_readfirstlane(F.tid >> 6);
    F.G = gridDim.x; F.bid = blockIdx.x; F.ws = args.ws; F.in = args.in;
    unsigned char* ws = args.ws;
    volatile LAS unsigned* MISC = (volatile LAS unsigned*)(F.lds + LDS_MISC);
    if (F.tid < 2) MISC[F.tid] = 0u;
    __syncthreads();
    XcdBarrier xbar = xcd_barrier_post((unsigned*)ws, MISC);
#define REFRESH() do { F.tid = fresh_tid(); F.lane = F.tid & 63; F.wave = __builtin_amdgcn_readfirstlane(F.tid >> 6); } while (0)
#define GRID_BAR() do { xcd_barrier(xbar); REFRESH(); } while (0)
#define GRID_BAR_CG() do { grid.sync(); REFRESH(); } while (0)
    p0_prologue(F);
    GRID_BAR_CG();
    p1_rows(F);
    GRID_BAR();
    { pg8::Gemm g{(const bf16_t*)(ws + WS_H), (const bf16_t*)(ws + WS_WINT), M, NZ, DM, DM}; pg8::StaticOrder S; S.init(M, NZ, F.G, F.bid);
      EpiZ E{ws}; pg8::gemm_phase<EpiZ, pg8::StaticOrder>(F.lds, g, S, E); }
    GRID_BAR();
    { const float* cb1 = (const float*)(ws + WS_CB1);
      { pg8::Gemm g{(const bf16_t*)(ws + WS_KV), (const bf16_t*)(ws + WS_CW1KT), 4096, 256, 2048, 1024}; pg8::ColOrder S{16, F.G, F.bid};
        EpiBf16<2> E{(bf16_t*)(ws + WS_CHIDK), 256, cb1}; pg8::gemm_phase<EpiBf16<2>, pg8::ColOrder>(F.lds, g, S, E); }
      { pg8::Gemm g{(const bf16_t*)(ws + WS_KV + KV_STRIDE), (const bf16_t*)(ws + WS_CW1VT), 4096, 256, 2048, 1024}; pg8::ColOrder S{16, F.G, (F.bid + F.G - 16) % F.G};
        EpiBf16<2> E{(bf16_t*)(ws + WS_CHIDV), 256, cb1 + 256}; pg8::gemm_phase<EpiBf16<2>, pg8::ColOrder>(F.lds, g, S, E); }
      __syncthreads();
      for (int it = F.bid; it < 512; it += F.G) rnn_item<1>(F, it >> 6, it & 63); }
    GRID_BAR();
    { const int gw = F.bid * 8 + F.wave, NGW = F.G * 8; for (int it = gw; it < 512; it += NGW) cmp2_item(F, it); }
    GRID_BAR();
    { for (int n = F.bid; n < 1024; n += F.G) { const int k = n >> 8, c = n & 255, b = c >> 5, r = c & 31; const int i = (k == 0) ? r : (k == 1) ? 63 - r : (k == 2) ? 64 + r : 127 - r; attn_item(F, b, i); }
      __syncthreads();
      for (int it = F.bid; it < 512; it += F.G) rnn_item<2>(F, it >> 6, it & 63); }
    GRID_BAR();
    { pg8::Gemm g{(const bf16_t*)(ws + WS_YCAT), (const bf16_t*)(ws + WS_WOUTT), M, DM, DM, DM}; pg8::StaticOrder S; S.init(M, DM, F.G, F.bid);
      EpiF32 E{(float*)(ws + WS_Y), DM}; pg8::gemm_phase<EpiF32, pg8::StaticOrder>(F.lds, g, S, E); }
    GRID_BAR();
    p7_rows(F, args.out);
    GRID_BAR();
    { pg8::Gemm g{(const bf16_t*)(ws + WS_H), (const bf16_t*)(ws + WS_WFF1T), M, DFF, DM, DM}; pg8::StaticOrder S; S.init(M, DFF, F.G, F.bid);
      EpiBf16<1> E{(bf16_t*)(ws + WS_HID), DFF, nullptr}; pg8::gemm_phase<EpiBf16<1>, pg8::StaticOrder>(F.lds, g, S, E); }
    GRID_BAR();
    { pg8::Gemm g{(const bf16_t*)(ws + WS_HID), (const bf16_t*)(ws + WS_WFF2T), M, DM, DFF, DFF}; pg8::StaticOrder S; S.init(M, DM, F.G, F.bid);
      EpiF32 E{(float*)(ws + WS_Y2), DM}; pg8::gemm_phase<EpiF32, pg8::StaticOrder>(F.lds, g, S, E); }
    GRID_BAR();
    p10_rows(F, args.out);
}

extern "C" void kernel_launch(void* const* d_in, const int* in_sizes, int n_in, void* d_out, int out_size, void* d_ws, size_t ws_size, hipStream_t stream) {
    static int grid = 0;
    if (grid == 0) {
        if (n_in != 27 || out_size != M * DM || ws_size < WS_END) { fprintf(stderr, "kernel_launch: unexpected problem (n_in %d out %d ws %zu)\n", n_in, out_size, ws_size); grid = -1; return; }
        int dev = 0, cus = 0, per_cu = 0;
        (void)hipGetDevice(&dev); (void)hipDeviceGetAttribute(&cus, hipDeviceAttributeMultiprocessorCount, dev);
        (void)hipFuncSetAttribute((const void*)hybrid_fwd, hipFuncAttributeMaxDynamicSharedMemorySize, LDS_BYTES);
        if (hipOccupancyMaxActiveBlocksPerMultiprocessor(&per_cu, (const void*)hybrid_fwd, 512, LDS_BYTES) != hipSuccess || per_cu < 1) per_cu = 1;
        (void)hipGetLastError();
        grid = cus * 1;
        fprintf(stderr, "kernel_launch: grid %d (per_cu %d)\n", grid, per_cu);
    }
    if (grid < 0) return;
    (void)hipMemsetAsync(d_ws, 0, 16384, stream);
    Args a{};
    for (int i = 0; i < 27; ++i) a.in[i] = (const float*)d_in[i];
    a.out = (float*)d_out; a.ws = (unsigned char*)d_ws;
    void* kargs[] = {&a};
    hipError_t e = hipLaunchCooperativeKernel((const void*)hybrid_fwd, dim3(grid), dim3(512), kargs, LDS_BYTES, stream);
    if (e != hipSuccess) fprintf(stderr, "kernel_launch: cooperative launch failed: %s\n", hipGetErrorString(e));
}
```

```cpp
#include <hip/hip_runtime.h>
#include <hip/hip_cooperative_groups.h>
#include <cstdio>
#include <cstdint>
namespace cg = cooperative_groups;

#define LAS __attribute__((address_space(3)))
typedef unsigned short bf16_t;
typedef short bf16x8 __attribute__((ext_vector_type(8)));
typedef short s16x4 __attribute__((ext_vector_type(4)));
typedef float f32x4 __attribute__((ext_vector_type(4)));
typedef float f32x16 __attribute__((ext_vector_type(16)));
typedef unsigned u32x4 __attribute__((ext_vector_type(4)));
typedef unsigned u32x2 __attribute__((ext_vector_type(2)));
#define LOG2E_C 1.4426950408889634f

namespace pg8 {
constexpr int BM = 256, BK = 64, HALF = 128, HTB = HALF * BK * 2, STAGE_BYTES = 8 * HTB, NXCD = 8, WGM = 8;
__host__ __device__ __forceinline__ int lds_byte(int r, int c) { const int st = (r >> 4) * 2 + (c >> 5), rr = r & 15, cc = c & 31, ob = rr * 64 + cc * 2; return st * 1024 + (ob ^ (((ob >> 9) & 1) << 5)); }
__host__ __device__ __forceinline__ void stage_rc(int b, int& R, int& C) { const int st = b / 1024, sb = b % 1024, swz = sb ^ (((sb >> 9) & 1) << 5); R = (st >> 1) * 16 + swz / 64; C = (st & 1) * 32 + (swz % 64) / 2; }
__host__ __device__ __forceinline__ int perm32(int rho) { const int n = rho >> 4, i = rho & 15; return 8 * (i >> 2) + 4 * n + (i & 3); }

struct Unit { int pm, pn; };
struct Gemm { const bf16_t* A; const bf16_t* Bt; int M, N, K, lda, ldb; };

struct StaticOrder {
    int nM, nN, nwg, G, c;
    __device__ void init(int M, int N, int G_, int c_) { nM = M / BM; nN = N / BM; nwg = nM * nN; G = G_; c = c_; }
    __device__ bool next(int i, Unit& u) const {
        const long L = (long)i * G + c; if (L >= nwg) return false;
        int wgid = (int)L; { const int q = nwg / NXCD, r = nwg % NXCD, xcd = wgid % NXCD, off = wgid / NXCD; wgid = (xcd < r ? xcd * (q + 1) : r * (q + 1) + (xcd - r) * q) + off; }
        const int nig = WGM * nN, gid = wgid / nig, fm = gid * WGM, gsz = (nM - fm) < WGM ? (nM - fm) : WGM;
        u.pm = fm + ((wgid % nig) % gsz); u.pn = (wgid % nig) / gsz; return true;
    }
};
struct OneUnit { __device__ bool next(int i, Unit& u) const { if (i) return false; u.pm = 0; u.pn = 0; return true; } };
struct ColOrder {
    int nM, G, c;
    __device__ bool next(int i, Unit& u) const { const long L = (long)i * G + c; if (c < 0 || L >= nM) return false; u.pm = (int)L; u.pn = 0; return true; }
};

__device__ __forceinline__ unsigned cvt_pk_bf16(float lo, float hi) { unsigned r; asm volatile("v_cvt_pk_bf16_f32 %0, %1, %2" : "=v"(r) : "v"(lo), "v"(hi)); return r; }

template <class Epi, class Sched>
__device__ __forceinline__ void gemm_phase(LAS unsigned char* lds, const Gemm g, const Sched& S, const Epi& E, int tid) {
    const int wid = __builtin_amdgcn_readfirstlane(tid >> 6), lane = tid & 63, wr = wid >> 2, wc = wid & 3, fr = lane & 15, fq = lane >> 4;
    const int K = g.K, nt = K / BK, lda = g.lda, ldb = g.ldb;
    unsigned voffA[2], voffB[2];
#pragma unroll
    for (int i = 0; i < 2; ++i) { int R, C; stage_rc(tid * 16 + i * 8192, R, C); const int Rb = Epi::PERM ? ((R & ~31) + perm32(R & 31)) : R;
        voffA[i] = (unsigned)(R * lda + C) * 2u; voffB[i] = (unsigned)(Rb * ldb + C) * 2u; }
    const size_t kstep = (size_t)(BK * 2);
    const size_t hstepA = (size_t)HALF * lda * 2, hstepB = (size_t)HALF * ldb * 2;
    const size_t tstepA = 2 * hstepA, tstepB = 2 * hstepB;
    const unsigned ldsw = (unsigned)wid * 1024u;
    const int aoff = lds_byte(wr * 64 + fr, fq * 8), boff = lds_byte(wc * 32 + fr, fq * 8);
#define PG8_SA(b, h) (((b) * 2 + (h)) * HTB)
#define PG8_SB(b, h) ((4 + (b) * 2 + (h)) * HTB)
#define PG8_STAGE(bufoff, gbase, voff) do { _Pragma("unroll") for (int _i = 0; _i < 2; ++_i) \
        __builtin_amdgcn_global_load_lds((const unsigned*)((const char*)(gbase) + (voff)[_i]), (LAS unsigned*)(lds + (bufoff) + ldsw + _i * 8192), 16, 0, 0); } while (0)
#define PG8_LDA(dst, b, h) do { _Pragma("unroll") for (int m = 0; m < 4; ++m) _Pragma("unroll") for (int k = 0; k < 2; ++k) dst[m][k] = *(const LAS bf16x8*)(lds + PG8_SA(b, h) + aoff + m * 2048 + k * 1024); } while (0)
#define PG8_LDB(dst, b, h) do { _Pragma("unroll") for (int n = 0; n < 2; ++n) _Pragma("unroll") for (int k = 0; k < 2; ++k) dst[n][k] = *(const LAS bf16x8*)(lds + PG8_SB(b, h) + boff + n * 2048 + k * 1024); } while (0)
#define PG8_MMA(ai, bj, At, Bt) do { __builtin_amdgcn_s_setprio(1); _Pragma("unroll") for (int m = 0; m < 4; ++m) _Pragma("unroll") for (int n = 0; n < 2; ++n) _Pragma("unroll") for (int k = 0; k < 2; ++k) \
        acc[ai][bj][m][n] = __builtin_amdgcn_mfma_f32_16x16x32_bf16(Bt[n][k], At[m][k], acc[ai][bj][m][n], 0, 0, 0); __builtin_amdgcn_s_setprio(0); } while (0)
#define PG8_WAIT_V(n) asm volatile("s_waitcnt vmcnt(" #n ")" ::: "memory")
#define PG8_WAIT_L(n) asm volatile("s_waitcnt lgkmcnt(" #n ")" ::: "memory")
#define PG8_BAR __builtin_amdgcn_s_barrier()
#define PG8_SCHED __builtin_amdgcn_sched_barrier(0)
    Unit cur, nxt; int ui = 0;
    if (!S.next(0, cur)) return;
    f32x4 acc[2][2][4][2];
#pragma unroll
    for (int a = 0; a < 2; ++a)
#pragma unroll
        for (int b = 0; b < 2; ++b)
#pragma unroll
            for (int m = 0; m < 4; ++m)
#pragma unroll
                for (int n = 0; n < 2; ++n) acc[a][b][m][n] = (f32x4){0.f, 0.f, 0.f, 0.f};
    bf16x8 At[4][2], B0[2][2], B1[2][2];
    const char* cA = (const char*)g.A + (size_t)cur.pm * tstepA; const char* cB = (const char*)g.Bt + (size_t)cur.pn * tstepB;
    PG8_STAGE(PG8_SB(0, 0), cB, voffB); PG8_STAGE(PG8_SB(0, 1), cB + hstepB, voffB); PG8_STAGE(PG8_SA(0, 0), cA, voffA); PG8_STAGE(PG8_SA(0, 1), cA + hstepA, voffA);
    if (wr == 1) PG8_BAR;
    PG8_WAIT_V(2); PG8_BAR;
    PG8_STAGE(PG8_SB(1, 0), cB + kstep, voffB); PG8_STAGE(PG8_SA(1, 0), cA + kstep, voffA); PG8_STAGE(PG8_SB(1, 1), cB + hstepB + kstep, voffB);
    PG8_WAIT_V(6); PG8_BAR;
    for (;;) {
        const bool has_next = S.next(ui + 1, nxt);
        const char* nA = has_next ? (const char*)g.A + (size_t)nxt.pm * tstepA : cA; const char* nB = has_next ? (const char*)g.Bt + (size_t)nxt.pn * tstepB : cB;
        for (int t = 0; t < nt; t += 2) {
            const bool last = (t == nt - 2);
            const char* a1 = cA + (size_t)(t + 1) * kstep;
            const char* a2 = last ? nA : cA + (size_t)(t + 2) * kstep; const char* b2 = last ? nB : cB + (size_t)(t + 2) * kstep;
            const char* a3 = a2 + kstep; const char* b3 = b2 + kstep;
            PG8_LDB(B0, 0, 0); PG8_LDB(B1, 0, 1); PG8_SCHED; PG8_LDA(At, 0, 0); PG8_STAGE(PG8_SA(1, 1), a1 + hstepA, voffA);
            PG8_WAIT_V(8); PG8_WAIT_L(0); PG8_BAR; PG8_MMA(0, 0, At, B0); PG8_MMA(0, 1, At, B1); PG8_BAR; PG8_SCHED;
            PG8_LDA(At, 0, 1); PG8_STAGE(PG8_SB(0, 0), b2, voffB); PG8_STAGE(PG8_SB(0, 1), b2 + hstepB, voffB); PG8_STAGE(PG8_SA(0, 0), a2, voffA);
            PG8_WAIT_V(8); PG8_WAIT_L(0); PG8_BAR; PG8_MMA(1, 0, At, B0); PG8_MMA(1, 1, At, B1); PG8_BAR; PG8_SCHED;
            PG8_LDB(B0, 1, 0); PG8_LDB(B1, 1, 1); PG8_SCHED; PG8_LDA(At, 1, 0); PG8_STAGE(PG8_SA(0, 1), a2 + hstepA, voffA);
            PG8_WAIT_V(8); PG8_WAIT_L(0); PG8_BAR; PG8_MMA(0, 0, At, B0); PG8_MMA(0, 1, At, B1); PG8_BAR; PG8_SCHED;
            PG8_LDA(At, 1, 1); PG8_STAGE(PG8_SB(1, 0), b3, voffB); PG8_STAGE(PG8_SB(1, 1), b3 + hstepB, voffB); PG8_STAGE(PG8_SA(1, 0), a3, voffA);
            PG8_WAIT_V(8); PG8_WAIT_L(0); PG8_BAR; PG8_MMA(1, 0, At, B0); PG8_MMA(1, 1, At, B1); PG8_BAR; PG8_SCHED;
        }
        E(acc, cur, wr, wc, fr, fq);
        if (!has_next) break;
#pragma unroll
        for (int a = 0; a < 2; ++a)
#pragma unroll
            for (int b = 0; b < 2; ++b)
#pragma unroll
                for (int m = 0; m < 4; ++m)
#pragma unroll
                    for (int n = 0; n < 2; ++n) acc[a][b][m][n] = (f32x4){0.f, 0.f, 0.f, 0.f};
        cur = nxt; cA = nA; cB = nB; ++ui;
    }
    PG8_WAIT_V(0);
    if (wr == 0) PG8_BAR;
    PG8_BAR;
#undef PG8_SA
#undef PG8_SB
#undef PG8_STAGE
#undef PG8_LDA
#undef PG8_LDB
#undef PG8_MMA
#undef PG8_WAIT_V
#undef PG8_WAIT_L
#undef PG8_BAR
#undef PG8_SCHED
}
}

constexpr int BATCH = 8, SEQ = 4096, DM = 1024, M = BATCH * SEQ, NZ = 2560, DFF = 4096, NMOD = 6 * DM;
constexpr float EPS = 1e-6f, NEGF = -1e30f, LOG2E = 1.4426950408889634f;
constexpr size_t MiB = 1u << 20, KiB = 1024;
constexpr size_t WS_MOD = 64 * KiB;
constexpr size_t WS_CB1P = 320 * KiB;
constexpr size_t WS_CB1 = 384 * KiB;
constexpr size_t WS_LRUC = 400 * KiB;
constexpr size_t WS_WAT = 448 * KiB, WS_WXT = 512 * KiB;
constexpr size_t WS_CW2KT = 576 * KiB, WS_CW2VT = 640 * KiB;
constexpr size_t WS_WINT = 2 * MiB, WS_WOUTT = 8 * MiB, WS_WFF1T = 10 * MiB, WS_WFF2T = 18 * MiB, WS_CW1KT = 26 * MiB, WS_CW1VT = 27 * MiB;
constexpr size_t WS_CHIDK = 28 * MiB, WS_CHIDV = 30 * MiB;
constexpr size_t WS_H = 32 * MiB;
constexpr size_t WS_GRNN = 96 * MiB, WS_XRNN = 128 * MiB, WS_Q = 160 * MiB;
constexpr size_t WS_KV = 192 * MiB, KV_STRIDE = 8 * MiB;
constexpr size_t WS_GATE = 240 * MiB;
constexpr size_t WS_KCMP = 244 * MiB, WS_VCMPT = WS_KCMP + 512 * KiB;
constexpr size_t WS_RA = 246 * MiB, WS_RH = 247 * MiB, WS_RHIN = 248 * MiB;
constexpr size_t WS_YCAT = 256 * MiB;
constexpr size_t WS_Y = 416 * MiB;
constexpr size_t WS_HID = 96 * MiB;
constexpr size_t WS_Y2 = 352 * MiB;
constexpr size_t WS_RG = 416 * MiB;
constexpr size_t WS_CP = WS_Y2;
constexpr size_t WS_END = 480 * MiB;
constexpr int LDS_BYTES = 147456, LDS_MISC = 147200;

struct Args { const float* in[27]; float* out; unsigned char* ws; };

struct Frame {
    LAS unsigned char* lds; int tid, lane, wave, G, bid; unsigned char* ws; const float* const* in;
};

__device__ __forceinline__ unsigned f2bf(float f) { unsigned u = __builtin_bit_cast(unsigned, f); return (u + 0x7fffu + ((u >> 16) & 1u)) >> 16; }
typedef __bf16 bf16x2_t __attribute__((ext_vector_type(2)));
typedef float f32x2_t __attribute__((ext_vector_type(2)));
__device__ __forceinline__ unsigned pk2(float lo, float hi) { f32x2_t v = {lo, hi}; bf16x2_t b = __builtin_convertvector(v, bf16x2_t); return __builtin_bit_cast(unsigned, b); }
__device__ __forceinline__ float bf2f(bf16_t b) { return __builtin_bit_cast(float, (unsigned)b << 16); }
__device__ __forceinline__ float wave_sum(float v) {
#pragma unroll
    for (int o = 1; o < 64; o <<= 1) v += __shfl_xor(v, o);
    return v;
}
__device__ __forceinline__ float sigmoidf_(float x) { return __builtin_amdgcn_rcpf(1.0f + __builtin_amdgcn_exp2f(-LOG2E_C * x)); }
__device__ __forceinline__ float gelu_tanh(float v) { const float u = (-2.0f * 0.7978845608028654f * LOG2E_C) * (v + 0.044715f * v * v * v); return v * __builtin_amdgcn_rcpf(1.0f + __builtin_amdgcn_exp2f(u)); }
__device__ __forceinline__ float expm1_small(float x) { float p = 1.0f / 5040.0f; p = fmaf(p, x, 1.0f / 720.0f); p = fmaf(p, x, 1.0f / 120.0f); p = fmaf(p, x, 1.0f / 24.0f); p = fmaf(p, x, 1.0f / 6.0f); p = fmaf(p, x, 0.5f); p = fmaf(p, x, 1.0f); return p * x; }
#define LDS_FENCE() asm volatile("s_waitcnt lgkmcnt(0)" ::: "memory")
__device__ __forceinline__ int fresh_tid2(int wave_u) { int z = 0; asm volatile("" : "+v"(z)); int t = (wave_u << 6) | (int)__builtin_amdgcn_mbcnt_hi(~0u, __builtin_amdgcn_mbcnt_lo(~0u, (unsigned)z)); asm volatile("" : "+v"(t)); return t; }
__device__ __forceinline__ int fresh_tid() { int t = threadIdx.x; asm volatile("" : "+v"(t)); return t; }

struct EpiF32 {
    static constexpr bool PERM = false;
    float* O; int ldc;
    __device__ __forceinline__ void operator()(const f32x4 (&acc)[2][2][4][2], const pg8::Unit& u, int wr, int wc, int fr, int fq) const {
        const int row0 = u.pm * 256 + wr * 64 + fr, col0 = u.pn * 256 + wc * 32 + 4 * fq;
#pragma unroll
        for (int ai = 0; ai < 2; ++ai)
#pragma unroll
            for (int m = 0; m < 4; ++m) { float* rowp = O + (size_t)(row0 + ai * 128 + m * 16) * ldc + col0;
#pragma unroll
                for (int bj = 0; bj < 2; ++bj)
#pragma unroll
                    for (int n = 0; n < 2; ++n) *(f32x4*)(rowp + bj * 128 + n * 16) = acc[ai][bj][m][n]; }
    }
};
template <int ACT  > struct EpiBf16 {
    static constexpr bool PERM = true;
    bf16_t* O; int ldc; const float* bias;
    __device__ __forceinline__ void operator()(const f32x4 (&acc)[2][2][4][2], const pg8::Unit& u, int wr, int wc, int fr, int fq) const {
        const int row0 = u.pm * 256 + wr * 64 + fr, col0 = u.pn * 256 + wc * 32 + 8 * fq;
        f32x4 bv[2][2];
#pragma unroll
        for (int bj = 0; bj < 2; ++bj)
#pragma unroll
            for (int n = 0; n < 2; ++n) bv[bj][n] = (ACT == 2) ? *(const f32x4*)(bias + col0 + bj * 128 + 4 * n) : (f32x4){0.f, 0.f, 0.f, 0.f};
#pragma unroll
        for (int ai = 0; ai < 2; ++ai)
#pragma unroll
            for (int m = 0; m < 4; ++m) { bf16_t* rowp = O + (size_t)(row0 + ai * 128 + m * 16) * ldc + col0;
#pragma unroll
                for (int bj = 0; bj < 2; ++bj) { f32x4 v0 = acc[ai][bj][m][0] + bv[bj][0], v1 = acc[ai][bj][m][1] + bv[bj][1];
#pragma unroll
                    for (int e = 0; e < 4; ++e) {
                        if (ACT == 1) { const float a = fmaxf(v0[e], 0.f), b = fmaxf(v1[e], 0.f); v0[e] = a * a; v1[e] = b * b; }
                        if (ACT == 2) { v0[e] = gelu_tanh(v0[e]); v1[e] = gelu_tanh(v1[e]); } }
                    u32x4 w; w.x = pk2(v0[0], v0[1]); w.y = pk2(v0[2], v0[3]); w.z = pk2(v1[0], v1[1]); w.w = pk2(v1[2], v1[3]);
                    *(u32x4*)(rowp + bj * 128) = w; } }
    }
};
struct EpiZ {
    static constexpr bool PERM = true;
    unsigned char* ws; LAS unsigned char* lds;
    __device__ __forceinline__ void operator()(const f32x4 (&acc)[2][2][4][2], const pg8::Unit& u, int wr, int wc, int fr, int fq) const {
        const int row0 = u.pm * 256 + wr * 64 + fr, pn = u.pn;
        if (pn < 6) {
            bf16_t* base = (bf16_t*)(ws + (pn < 2 ? WS_GRNN : pn < 4 ? WS_XRNN : WS_Q)); const float sc = pn >= 4 ? 0.125f * LOG2E_C : 1.0f;
            const int col0 = (pn & 1) * 256 + wc * 32 + 8 * fq;
#pragma unroll
            for (int ai = 0; ai < 2; ++ai)
#pragma unroll
                for (int m = 0; m < 4; ++m) { bf16_t* rowp = base + (size_t)(row0 + ai * 128 + m * 16) * 512 + col0;
#pragma unroll
                    for (int bj = 0; bj < 2; ++bj) { const f32x4 v0 = acc[ai][bj][m][0] * sc, v1 = acc[ai][bj][m][1] * sc;
                        u32x4 w; w.x = pk2(v0[0], v0[1]); w.y = pk2(v0[2], v0[3]); w.z = pk2(v1[0], v1[1]); w.w = pk2(v1[2], v1[3]);
                        *(u32x4*)(rowp + bj * 128) = w; } }
        } else if (pn < 9) {
            const int p = pn - 6, g = wc >> 1, d0 = 32 * (wc & 1) + 8 * fq;
            bf16_t* Kb = (bf16_t*)(ws + WS_KV + (size_t)(2 * p) * KV_STRIDE); bf16_t* Vb = (bf16_t*)(ws + WS_KV + (size_t)(2 * p + 1) * KV_STRIDE);
#pragma unroll
            for (int ai = 0; ai < 2; ++ai)
#pragma unroll
                for (int m = 0; m < 4; ++m) { const int row = row0 + ai * 128 + m * 16, b = row >> 12, s = row & 4095;
                    { const f32x4 v0 = acc[ai][0][m][0], v1 = acc[ai][0][m][1];
                      u32x4 w; w.x = pk2(v0[0], v0[1]); w.y = pk2(v0[2], v0[3]); w.z = pk2(v1[0], v1[1]); w.w = pk2(v1[2], v1[3]);
                      *(u32x4*)(Kb + ((size_t)(b * 2 + g) * 4096 + s) * 64 + d0) = w; }
                    if (p == 0) { const f32x4 v0 = acc[ai][1][m][0], v1 = acc[ai][1][m][1];
                      u32x4 w; w.x = pk2(v0[0], v0[1]); w.y = pk2(v0[2], v0[3]); w.z = pk2(v1[0], v1[1]); w.w = pk2(v1[2], v1[3]);
                      *(u32x4*)(Vb + ((size_t)(b * 2 + g) * 4096 + s) * 64 + d0) = w; }
                    else {
                      LAS bf16_t* tl = (LAS bf16_t*)(lds + 131072 + (wr * 4 + wc) * 1536);
                      const int lane_ = fq * 16 + fr;
#pragma unroll
                      for (int n = 0; n < 2; ++n)
#pragma unroll
                          for (int e = 0; e < 4; ++e) tl[(8 * fq + 4 * n + e) * 24 + fr] = (bf16_t)f2bf(acc[ai][1][m][n][e]);
                      asm volatile("s_waitcnt lgkmcnt(0)" ::: "memory");
                      const int dd = lane_ >> 1, half = lane_ & 1;
                      const u32x4 w = *(const LAS u32x4*)(tl + dd * 24 + 8 * half);
                      *(u32x4*)(Vb + ((size_t)(b * 2 + g) * 64 + 32 * (wc & 1) + dd) * 4096 + (s - fr) + 8 * half) = w;
                      asm volatile("s_waitcnt lgkmcnt(0)" ::: "memory"); } }
        } else {
            if (wc == 0 && fq < 3) { float* G = (float*)(ws + WS_GATE);
#pragma unroll
                for (int ai = 0; ai < 2; ++ai)
#pragma unroll
                    for (int m = 0; m < 4; ++m) { float* gp = G + (size_t)(row0 + ai * 128 + m * 16) * 24 + 8 * fq;
#pragma unroll
                        for (int n = 0; n < 2; ++n) { f32x4 v = acc[ai][0][m][n];
#pragma unroll
                            for (int e = 0; e < 4; ++e) v[e] = sigmoidf_(v[e]);
                            *(f32x4*)(gp + 4 * n) = v; } } }
        }
    }
};

#define XB_TMO      128
#define XB_XCNT(j)  (256  + 64 * (j))
#define XB_XSUB(j)  (1280 + 64 * (j))
#define XB_XGEN(j)  (2304 + 64 * (j))
#define XB_TOP      3328
#define XB_TOPGEN   3392
#define XCD_BAR_WORDS 3456
#define XB_SPIN_CAP (1u << 18)

__device__ __forceinline__ unsigned xb_ld(unsigned* p)              { return __hip_atomic_load(p, __ATOMIC_RELAXED, __HIP_MEMORY_SCOPE_AGENT); }
__device__ __forceinline__ unsigned xb_add(unsigned* p, unsigned v) { return __hip_atomic_fetch_add(p, v, __ATOMIC_RELAXED, __HIP_MEMORY_SCOPE_AGENT); }
__device__ __forceinline__ unsigned xb_xcc_id() { return (unsigned)__builtin_amdgcn_s_getreg((3 << 11) | 20) & 0xFu; }
#define XB_SPIN(cond, bar) do { unsigned _sp = 0; while (cond) { __builtin_amdgcn_s_sleep(1); \
    if ((++_sp & 255u) == 0u) { if (xb_ld(&(bar)[XB_TMO])) break; if (_sp > XB_SPIN_CAP) { atomicAdd(&(bar)[XB_TMO], 1u); break; } } } } while (0)

struct XcdBarrier {
    unsigned* bar; unsigned x;
    volatile LAS unsigned* st;
};

__device__ __forceinline__ XcdBarrier xcd_barrier_post(unsigned* bar, volatile LAS unsigned* st) {
    XcdBarrier b; b.bar = bar; b.x = xb_xcc_id(); b.st = st;
    if (threadIdx.x == 0) (void)xb_add(&bar[XB_XCNT(b.x)], 1u);
    return b;
}
__device__ __forceinline__ void xcd_barrier_complete(unsigned* bar, unsigned x, unsigned& nloc, unsigned& nx) {
    const unsigned G = gridDim.x * gridDim.y * gridDim.z;
    unsigned sum, cnt, mine, sp = 0u;
    for (;;) {
        sum = 0u; cnt = 0u; mine = 0u;
#pragma unroll
        for (unsigned j = 0; j < 16; ++j) { const unsigned c = xb_ld(&bar[XB_XCNT(j)]); sum += c; cnt += (c > 0u) ? 1u : 0u; mine = (j == x) ? c : mine; }
        if (sum == G) break;
        __builtin_amdgcn_s_sleep(1);
        if ((++sp & 255u) == 0u) { if (xb_ld(&bar[XB_TMO])) break; if (sp > XB_SPIN_CAP) { atomicAdd(&bar[XB_TMO], 1u); break; } }
    }
    nloc = mine > 0u ? mine : 1u; nx = cnt > 0u ? cnt : 1u;
}

__device__ __forceinline__ void xcd_barrier(const XcdBarrier& b) {
    asm volatile("s_waitcnt vmcnt(0)" ::: "memory");
    __syncthreads();
    if (threadIdx.x == 0) {
        unsigned* bar = b.bar;
        __builtin_amdgcn_s_waitcnt(0);
        unsigned nloc = b.st[0], nx = b.st[1];
        if (nloc == 0u) { xcd_barrier_complete(bar, b.x, nloc, nx); b.st[0] = nloc; b.st[1] = nx; }
        const unsigned old = xb_add(&bar[XB_XSUB(b.x)], 1u);
        const unsigned gen = old / nloc;
        if (old + 1u == (gen + 1u) * nloc) {
            __builtin_amdgcn_fence(__ATOMIC_RELEASE, "agent");
            asm volatile("s_waitcnt vmcnt(0)" ::: "memory");
            const unsigned og = xb_add(&bar[XB_TOP], 1u);
            const unsigned tg = og / nx;
            if (og + 1u == (tg + 1u) * nx) xb_add(&bar[XB_TOPGEN], 1u);
            else XB_SPIN(xb_ld(&bar[XB_TOPGEN]) == tg, bar);
            __builtin_amdgcn_fence(__ATOMIC_ACQUIRE, "agent");
            xb_add(&bar[XB_XGEN(b.x)], 1u);
            asm volatile("s_waitcnt vmcnt(0)" ::: "memory");
        } else {
            XB_SPIN(xb_ld(&bar[XB_XGEN(b.x)]) == gen, bar);
            __builtin_amdgcn_fence(__ATOMIC_ACQUIRE, "agent");
            asm volatile("s_waitcnt vmcnt(0)" ::: "memory");
        }
    }
    __syncthreads();
}


__device__ __forceinline__ void tr_item(const float* W, int K, int N, bf16_t* WT, int NT, const float* gA, const float* gB, LAS float* scr, int item, int lane) {
    const int nblk = NT / 64, kb = item / nblk, nb = item % nblk, k0 = 64 * kb, n0 = 64 * nb;
    const int nn = n0 + 4 * (lane & 15);
#pragma unroll 8
    for (int i = 0; i < 16; ++i) { const int kk = 4 * i + (lane >> 4), k = k0 + kk;
        f32x4 v = (nn < N) ? *(const f32x4*)(W + (size_t)k * N + nn) : (f32x4){0.f, 0.f, 0.f, 0.f};
        if (gA) v = v * ((k < 512) ? gA[k] : gB[k - 512]);
        LAS float* d = scr + kk * 65 + 4 * (lane & 15); d[0] = v.x; d[1] = v.y; d[2] = v.z; d[3] = v.w; }
    LDS_FENCE();
    const int c = lane & 7;
#pragma unroll
    for (int j = 0; j < 8; ++j) { const int n = (lane >> 3) + 8 * j; const LAS float* s = scr + (8 * c) * 65 + n;
        u32x4 o; o.x = pk2(s[0 * 65], s[1 * 65]); o.y = pk2(s[2 * 65], s[3 * 65]); o.z = pk2(s[4 * 65], s[5 * 65]); o.w = pk2(s[6 * 65], s[7 * 65]);
        *(u32x4*)(WT + (size_t)(n0 + n) * K + k0 + 8 * c) = o; }
    LDS_FENCE();
}
__device__ __forceinline__ void p0_mod_item(Frame& F, int item) {
    LAS float* sc = (LAS float*)F.lds; LAS float* red = (LAS float*)(F.lds + 32768);
    const float* c = F.in[1]; const float* ada_w = F.in[2]; const float* ada_b = F.in[3];
    for (int idx = F.tid; idx < 8192; idx += 512) { const float v = c[idx]; sc[idx] = v / (1.0f + __expf(-v)); }
    __syncthreads();
    float acc[8];
#pragma unroll
    for (int b = 0; b < 8; ++b) acc[b] = 0.f;
    const int kbase = 128 * F.wave; const float* wp = ada_w + (size_t)kbase * NMOD + 64 * item + F.lane;
#pragma unroll 8
    for (int kk = 0; kk < 128; ++kk) { const float wv = wp[(size_t)kk * NMOD];
#pragma unroll
        for (int b = 0; b < 8; ++b) acc[b] += sc[b * 1024 + kbase + kk] * wv; }
#pragma unroll
    for (int b = 0; b < 8; ++b) red[(F.wave * 8 + b) * 64 + F.lane] = acc[b];
    __syncthreads();
    { const int b = F.tid >> 6, col = F.tid & 63; float s = ada_b[64 * item + col];
#pragma unroll
      for (int w = 0; w < 8; ++w) s += red[(w * 8 + b) * 64 + col];
      ((float*)(F.ws + WS_MOD))[b * NMOD + 64 * item + col] = s; }
    __syncthreads();
}
__device__ __forceinline__ void p0_prologue(Frame& F) {
    for (int it = F.bid; it < NMOD / 64; it += F.G) p0_mod_item(F, it);
    LAS float* scr = (LAS float*)(F.lds + F.wave * 16640);
    const int nmb = (NMOD / 64 < F.G) ? NMOD / 64 : 0;
    const int gw = ((F.bid + F.G - nmb) % F.G) * 8 + F.wave, NGW = F.G * 8;
    constexpr int I_IN = 16 * (NZ / 64), I_OUT = 16 * 16, I_F1 = 16 * 64, I_F2 = 64 * 16, I_C1 = 32 * 4, I_C2 = 4 * 1, I_L = 1;
    constexpr int NTR = I_IN + I_OUT + I_F1 + I_F2 + 2 * I_C1 + 2 * I_C2 + 16 * I_L;
    constexpr int NITEMS = NTR + 128 + 8;
    unsigned char* ws = F.ws;
    for (int it = gw; it < NITEMS; it += NGW) {
        int r = it;
        if (r < I_IN) { tr_item(F.in[5], DM, 2328, (bf16_t*)(ws + WS_WINT), NZ, nullptr, nullptr, scr, r, F.lane); continue; } r -= I_IN;
        if (r < I_OUT) { tr_item(F.in[21], DM, DM, (bf16_t*)(ws + WS_WOUTT), DM, F.in[19], F.in[20], scr, r, F.lane); continue; } r -= I_OUT;
        if (r < I_F1) { tr_item(F.in[24], DM, DFF, (bf16_t*)(ws + WS_WFF1T), DFF, nullptr, nullptr, scr, r, F.lane); continue; } r -= I_F1;
        if (r < I_F2) { tr_item(F.in[25], DFF, DM, (bf16_t*)(ws + WS_WFF2T), DM, nullptr, nullptr, scr, r, F.lane); continue; } r -= I_F2;
        if (r < I_C1) { tr_item(F.in[14], 2048, 256, (bf16_t*)(ws + WS_CW1KT), 256, nullptr, nullptr, scr, r, F.lane); continue; } r -= I_C1;
        if (r < I_C1) { tr_item(F.in[17], 2048, 256, (bf16_t*)(ws + WS_CW1VT), 256, nullptr, nullptr, scr, r, F.lane); continue; } r -= I_C1;
        if (r < I_C2) { tr_item(F.in[15], 256, 64, (bf16_t*)(ws + WS_CW2KT), 64, nullptr, nullptr, scr, r, F.lane); continue; } r -= I_C2;
        if (r < I_C2) { tr_item(F.in[18], 256, 64, (bf16_t*)(ws + WS_CW2VT), 64, nullptr, nullptr, scr, r, F.lane); continue; } r -= I_C2;
        if (r < 8 * I_L) { const int n = r / I_L; tr_item(F.in[8] + n * 4096, 64, 64, (bf16_t*)(ws + WS_WAT) + n * 4096, 64, nullptr, nullptr, scr, r % I_L, F.lane); continue; } r -= 8 * I_L;
        if (r < 8 * I_L) { const int n = r / I_L; tr_item(F.in[10] + n * 4096, 64, 64, (bf16_t*)(ws + WS_WXT) + n * 4096, 64, nullptr, nullptr, scr, r % I_L, F.lane); continue; } r -= 8 * I_L;
        if (r < 128) {
            const int mat = r >> 6, cgp = (r >> 4) & 3, ks = r & 15; const float* pos = F.in[mat ? 16 : 13]; const float* w1 = F.in[mat ? 17 : 14];
            float a = 0.f; const int col = 64 * cgp + F.lane;
#pragma unroll 8
            for (int kk = 0; kk < 128; ++kk) { const int k = 128 * ks + kk; a += pos[k] * w1[(size_t)k * 256 + col]; }
            ((float*)(ws + WS_CB1P))[(mat * 16 + ks) * 256 + col] = a; continue; } r -= 128;
        { const int ch = 64 * r + F.lane; const float lam = F.in[12][ch]; ((float*)(ws + WS_LRUC))[ch] = -8.0f * log1pf(expf(-lam)); }
    }
}

__device__ __forceinline__ void p1_rows(Frame& F) {
    if (F.bid == 0) { const int mat = F.tid >> 8, col = F.tid & 255; float s = 0.f; const float* P = (const float*)(F.ws + WS_CB1P);
#pragma unroll
        for (int ks = 0; ks < 16; ++ks) s += P[(mat * 16 + ks) * 256 + col];
        ((float*)(F.ws + WS_CB1))[mat * 256 + col] = s; }
    const float* x = F.in[0]; const float* g = F.in[4]; const float* mod = (const float*)(F.ws + WS_MOD); bf16_t* H = (bf16_t*)(F.ws + WS_H);
    const int gw = F.bid * 8 + F.wave, NGW = F.G * 8;
    for (int rb = gw; rb < M / 16; rb += NGW) {
        const int b = (rb * 16) >> 12; f32x4 Gk[4], Sh[4];
#pragma unroll
        for (int j = 0; j < 4; ++j) { const int k = 4 * F.lane + 256 * j; const f32x4 gg = *(const f32x4*)(g + k), sc = *(const f32x4*)(mod + b * NMOD + 1024 + k);
            Gk[j] = gg * (sc + 1.0f); Sh[j] = *(const f32x4*)(mod + b * NMOD + k); }
        for (int rr = 0; rr < 16; ++rr) { const size_t row = (size_t)rb * 16 + rr; const f32x4* xr = (const f32x4*)(x + row * DM) + F.lane;
            f32x4 v[4]; float s = 0.f;
#pragma unroll
            for (int j = 0; j < 4; ++j) { v[j] = xr[64 * j]; s += (v[j].x * v[j].x + v[j].y * v[j].y) + (v[j].z * v[j].z + v[j].w * v[j].w); }
            const float rstd = rsqrtf(wave_sum(s) * (1.0f / DM) + EPS);
            unsigned long long* o8 = (unsigned long long*)(H + row * DM) + F.lane;
#pragma unroll
            for (int j = 0; j < 4; ++j) { const f32x4 h = v[j] * rstd * Gk[j] + Sh[j]; o8[64 * j] = (unsigned long long)pk2(h.x, h.y) | ((unsigned long long)pk2(h.z, h.w) << 32); } }
    }
}
__device__ __forceinline__ f32x4 ld_bf16x4(const bf16_t* p) { const u32x2 w = *(const u32x2*)p; return (f32x4){__builtin_bit_cast(float, w.x << 16), __builtin_bit_cast(float, w.x & 0xffff0000u), __builtin_bit_cast(float, w.y << 16), __builtin_bit_cast(float, w.y & 0xffff0000u)}; }
__device__ __forceinline__ void p7_rows(Frame& F) {
    const float* x = F.in[0]; const float* pnm = F.in[22]; const float* pre = F.in[23]; const float* mod = (const float*)(F.ws + WS_MOD);
    const bf16_t* Y = (const bf16_t*)(F.ws + WS_Y); bf16_t* H = (bf16_t*)(F.ws + WS_H);
    const int gw = F.bid * 8 + F.wave, NGW = F.G * 8;
    for (int rb = gw; rb < M / 16; rb += NGW) {
        const int b = (rb * 16) >> 12; f32x4 A1[4], G2[4], S2[4];
#pragma unroll
        for (int j = 0; j < 4; ++j) { const int k = 4 * F.lane + 256 * j;
            A1[j] = *(const f32x4*)(pnm + k) * (*(const f32x4*)(mod + b * NMOD + 2048 + k) + 1.0f);
            G2[j] = *(const f32x4*)(pre + k) * (*(const f32x4*)(mod + b * NMOD + 4096 + k) + 1.0f);
            S2[j] = *(const f32x4*)(mod + b * NMOD + 3072 + k); }
#pragma unroll 2
        for (int rr = 0; rr < 16; ++rr) { const size_t row = (size_t)rb * 16 + rr;
            const f32x4* xr = (const f32x4*)(x + row * DM) + F.lane; const bf16_t* yr = Y + row * DM + 4 * F.lane;
            f32x4 xv[4], yv[4]; float s = 0.f;
#pragma unroll
            for (int j = 0; j < 4; ++j) { xv[j] = xr[64 * j]; yv[j] = ld_bf16x4(yr + 256 * j); s += (yv[j].x * yv[j].x + yv[j].y * yv[j].y) + (yv[j].z * yv[j].z + yv[j].w * yv[j].w); }
            const float rstd = rsqrtf(wave_sum(s) * (1.0f / DM) + EPS); float s2 = 0.f;
#pragma unroll
            for (int j = 0; j < 4; ++j) { xv[j] = xv[j] + A1[j] * (yv[j] * rstd); s2 += (xv[j].x * xv[j].x + xv[j].y * xv[j].y) + (xv[j].z * xv[j].z + xv[j].w * xv[j].w); }
            const float rstd2 = rsqrtf(wave_sum(s2) * (1.0f / DM) + EPS);
            unsigned long long* o8 = (unsigned long long*)(H + row * DM) + F.lane;
#pragma unroll
            for (int j = 0; j < 4; ++j) { const f32x4 h = xv[j] * rstd2 * G2[j] + S2[j]; o8[64 * j] = (unsigned long long)pk2(h.x, h.y) | ((unsigned long long)pk2(h.z, h.w) << 32); } }
    }
}
__device__ __forceinline__ void p10_rows(Frame& F, float* out) {
    const float* x = F.in[0]; const float* pnm1 = F.in[22]; const float* pnm2 = F.in[26]; const float* mod = (const float*)(F.ws + WS_MOD);
    const bf16_t* Y = (const bf16_t*)(F.ws + WS_Y); const bf16_t* Y2 = (const bf16_t*)(F.ws + WS_Y2);
    const int gw = F.bid * 8 + F.wave, NGW = F.G * 8;
    for (int rb = gw; rb < M / 16; rb += NGW) {
        const int b = (rb * 16) >> 12; f32x4 A1[4], A2[4];
#pragma unroll
        for (int j = 0; j < 4; ++j) { const int k = 4 * F.lane + 256 * j;
            A1[j] = *(const f32x4*)(pnm1 + k) * (*(const f32x4*)(mod + b * NMOD + 2048 + k) + 1.0f);
            A2[j] = *(const f32x4*)(pnm2 + k) * (*(const f32x4*)(mod + b * NMOD + 5120 + k) + 1.0f); }
#pragma unroll 2
        for (int rr = 0; rr < 16; ++rr) { const size_t row = (size_t)rb * 16 + rr;
            const f32x4* xr = (const f32x4*)(x + row * DM) + F.lane; const bf16_t* yr = Y + row * DM + 4 * F.lane; const bf16_t* y2r = Y2 + row * DM + 4 * F.lane;
            f32x4 xv[4], yv[4], zv[4]; float s = 0.f, s2 = 0.f;
#pragma unroll
            for (int j = 0; j < 4; ++j) { xv[j] = xr[64 * j]; yv[j] = ld_bf16x4(yr + 256 * j); zv[j] = ld_bf16x4(y2r + 256 * j);
                s += (yv[j].x * yv[j].x + yv[j].y * yv[j].y) + (yv[j].z * yv[j].z + yv[j].w * yv[j].w); s2 += (zv[j].x * zv[j].x + zv[j].y * zv[j].y) + (zv[j].z * zv[j].z + zv[j].w * zv[j].w); }
            const float rstd = rsqrtf(wave_sum(s) * (1.0f / DM) + EPS), rstd2 = rsqrtf(wave_sum(s2) * (1.0f / DM) + EPS);
            f32x4* orow = (f32x4*)(out + row * DM) + F.lane;
#pragma unroll
            for (int j = 0; j < 4; ++j) orow[64 * j] = (xv[j] + A1[j] * (yv[j] * rstd)) + A2[j] * (zv[j] * rstd2); }
    }
}

constexpr int RNN_WL = 11264, RNN_PART_OFF = 8 * RNN_WL;
template <int PASS> __device__ __forceinline__ void rnn_item(Frame& F, int b, int chunk) {
    const int n = F.wave, lane = F.lane, ch = 64 * n + lane, fr = lane & 15, fq = lane >> 4;
    LAS unsigned char* wl = F.lds + n * RNN_WL;
    LAS bf16_t* xcb = (LAS bf16_t*)wl; LAS float* Ab = (LAS float*)(wl + 2304); LAS float* Gb = (LAS float*)(wl + 6656);
    LAS float* part = (LAS float*)(F.lds + RNN_PART_OFF);
    const float* conv_w = F.in[6]; const float cw0 = conv_w[ch], cw1 = conv_w[512 + ch], cw2 = conv_w[1024 + ch], cw3 = conv_w[1536 + ch], cb = F.in[7][ch];
    const bf16_t* WA = (const bf16_t*)(F.ws + WS_WAT) + n * 4096; const bf16_t* WX = (const bf16_t*)(F.ws + WS_WXT) + n * 4096;
    bf16x8 waf[4][2], wxf[4][2];
    if (PASS == 1) {
#pragma unroll
        for (int nb = 0; nb < 4; ++nb) {
#pragma unroll
            for (int ks = 0; ks < 2; ++ks) { waf[nb][ks] = *(const bf16x8*)(WA + (16 * nb + fr) * 64 + 32 * ks + 8 * fq); wxf[nb][ks] = *(const bf16x8*)(WX + (16 * nb + fr) * 64 + 32 * ks + 8 * fq); } } }
    const float* pba = F.in[9] + 64 * n + 4 * fq; const float* pbx = F.in[11] + 64 * n + 4 * fq; const float* plc = (const float*)(F.ws + WS_LRUC) + 64 * n + 4 * fq;
    const bf16_t* XR = (const bf16_t*)(F.ws + WS_XRNN); const bf16_t* GR = (const bf16_t*)(F.ws + WS_GRNN); bf16_t* YC = (bf16_t*)(F.ws + WS_YCAT);
    unsigned* RG = (unsigned*)(F.ws + WS_RG);
    const int t0 = chunk * 64; const size_t rowbase = (size_t)b * SEQ;
    float xm3 = 0.f, xm2 = 0.f, xm1 = 0.f;
    if (chunk > 0) { xm3 = bf2f(XR[(rowbase + t0 - 3) * 512 + ch]); xm2 = bf2f(XR[(rowbase + t0 - 2) * 512 + ch]); xm1 = bf2f(XR[(rowbase + t0 - 1) * 512 + ch]); }
    float h = 0.f, ap = 1.f;
    float* RA = (float*)(F.ws + WS_RA); float* RH = (float*)(F.ws + WS_RH);
    if (PASS == 2) h = ((const float*)(F.ws + WS_RHIN))[(size_t)(b * 64 + chunk) * 512 + ch];
    bf16_t xnext[16], gnext[16]; unsigned rgnext[16];
#pragma unroll
    for (int tt = 0; tt < 16; ++tt) { xnext[tt] = XR[(rowbase + t0 + tt) * 512 + ch];
        gnext[tt] = (PASS == 2) ? GR[(rowbase + t0 + tt) * 512 + ch] : (bf16_t)0; rgnext[tt] = (PASS == 2) ? RG[(rowbase + t0 + tt) * 512 + ch] : 0u; }
    for (int sub = 0; sub < 4; ++sub) {
        float xc[16]; const size_t r0 = rowbase + t0 + 16 * sub;
        bf16_t xcur[16], gcur[16]; unsigned rgcur[16];
#pragma unroll
        for (int tt = 0; tt < 16; ++tt) { xcur[tt] = xnext[tt]; gcur[tt] = gnext[tt]; rgcur[tt] = rgnext[tt]; }
        if (sub < 3) {
#pragma unroll
            for (int tt = 0; tt < 16; ++tt) { xnext[tt] = XR[(r0 + 16 + tt) * 512 + ch]; if (PASS == 2) { gnext[tt] = GR[(r0 + 16 + tt) * 512 + ch]; rgnext[tt] = RG[(r0 + 16 + tt) * 512 + ch]; } } }
#pragma unroll
        for (int tt = 0; tt < 16; ++tt) { const float xv = bf2f(xcur[tt]); xc[tt] = cb + cw0 * xm3 + cw1 * xm2 + cw2 * xm1 + cw3 * xv; xm3 = xm2; xm2 = xm1; xm1 = xv;
            if (PASS == 1) xcb[tt * 72 + lane] = (bf16_t)f2bf(xc[tt]); }
        float y[16];
        if (PASS == 1) {
            LDS_FENCE();
            bf16x8 xb[2];
#pragma unroll
            for (int ks = 0; ks < 2; ++ks) xb[ks] = *(const LAS bf16x8*)(xcb + fr * 72 + 32 * ks + 8 * fq);
            asm volatile("" : "+v"(pba), "+v"(pbx), "+v"(plc));
#pragma unroll
            for (int nb = 0; nb < 4; ++nb) { f32x4 aA = {0.f, 0.f, 0.f, 0.f}, aX = {0.f, 0.f, 0.f, 0.f};
                const f32x4 ba4n = *(const f32x4*)(pba + 16 * nb), bx4n = *(const f32x4*)(pbx + 16 * nb), lc4n = *(const f32x4*)(plc + 16 * nb);
#pragma unroll
                for (int ks = 0; ks < 2; ++ks) { aA = __builtin_amdgcn_mfma_f32_16x16x32_bf16(waf[nb][ks], xb[ks], aA, 0, 0, 0); aX = __builtin_amdgcn_mfma_f32_16x16x32_bf16(wxf[nb][ks], xb[ks], aX, 0, 0, 0); }
                f32x4 av, gv; u32x4 pk;
#pragma unroll
                for (int e = 0; e < 4; ++e) { const float rr = sigmoidf_(aA[e] + ba4n[e]), ii = sigmoidf_(aX[e] + bx4n[e]); const float la = lc4n[e] * rr;
                    const float em1 = expm1_small(la); av[e] = 1.0f + em1; gv[e] = __builtin_amdgcn_sqrtf(fmaxf(-em1 * (2.0f + em1), 0.f)) * ii; pk[e] = pk2(la, gv[e]); }
                *(LAS f32x4*)(Ab + fr * 68 + 16 * nb + 4 * fq) = av; *(LAS f32x4*)(Gb + fr * 68 + 16 * nb + 4 * fq) = gv;
                *(u32x4*)(RG + (r0 + fr) * 512 + 64 * n + 16 * nb + 4 * fq) = pk; }
            LDS_FENCE();
#pragma unroll
            for (int tt = 0; tt < 16; ++tt) { const float a = Ab[tt * 68 + lane], gg = Gb[tt * 68 + lane]; h = a * h + gg * xc[tt]; ap *= a; }
            LDS_FENCE();
        } else {
#pragma unroll
            for (int tt = 0; tt < 16; ++tt) { const float la = __builtin_bit_cast(float, rgcur[tt] << 16), gg = __builtin_bit_cast(float, rgcur[tt] & 0xffff0000u);
                const float a = 1.0f + expm1_small(la); h = a * h + gg * xc[tt]; y[tt] = h * gelu_tanh(bf2f(gcur[tt])); }
#pragma unroll
            for (int tt = 0; tt < 16; ++tt) Ab[tt * 68 + lane] = y[tt] * y[tt];
            LDS_FENCE();
            { const LAS float* rp = Ab + fr * 68 + 16 * fq; const f32x4 a0 = *(const LAS f32x4*)(rp), a1 = *(const LAS f32x4*)(rp + 4), a2 = *(const LAS f32x4*)(rp + 8), a3 = *(const LAS f32x4*)(rp + 12);
              float v = ((a0.x + a0.y) + (a0.z + a0.w)) + ((a1.x + a1.y) + (a1.z + a1.w)) + ((a2.x + a2.y) + (a2.z + a2.w)) + ((a3.x + a3.y) + (a3.z + a3.w));
              v += __shfl_xor(v, 16); v += __shfl_xor(v, 32);
              if (lane < 16) part[((sub & 1) * 8 + n) * 16 + lane] = v; }
            __syncthreads();
#pragma unroll
            for (int tt = 0; tt < 16; ++tt) { float tot = 0.f;
#pragma unroll
                for (int w = 0; w < 8; ++w) tot += part[((sub & 1) * 8 + w) * 16 + tt];
                const float rstd = rsqrtf(tot * (1.0f / 512.0f) + EPS);
                YC[(r0 + tt) * 1024 + ch] = (bf16_t)f2bf(y[tt] * rstd); }
        }
    }
    if (PASS == 1) { const size_t o = (size_t)(b * 64 + chunk) * 512 + ch; RA[o] = ap; RH[o] = h; }
    if (PASS == 2) __syncthreads();
}

__device__ __forceinline__ void cmp2_item(Frame& F, int item) {
    const int mat = item >> 8, rb = item & 255, lane = F.lane, fr = lane & 15, fq = lane >> 4;
    const int R0 = 16 * rb + fr, R1 = ((R0 & 255) < 255) ? R0 + 1 : R0;
    const bf16_t* P = (const bf16_t*)(F.ws + WS_CP) + (size_t)mat * 4 * 4096 * 512; const float* cb = (const float*)(F.ws + WS_CB1) + mat * 256;
    const bf16_t* W2 = (const bf16_t*)(F.ws + (mat ? WS_CW2VT : WS_CW2KT)) + (size_t)fr * 256 + 8 * fq;
    f32x4 acc[4];
#pragma unroll
    for (int nb = 0; nb < 4; ++nb) acc[nb] = (f32x4){0.f, 0.f, 0.f, 0.f};
#pragma unroll 4
    for (int ks = 0; ks < 8; ++ks) { const int n0 = 32 * ks + 8 * fq;
        f32x4 h0 = *(const f32x4*)(cb + n0), h1 = *(const f32x4*)(cb + n0 + 4);
#pragma unroll
        for (int k4 = 0; k4 < 4; ++k4) { const u32x4 a = *(const u32x4*)(P + ((size_t)k4 * 4096 + R0) * 512 + n0), c = *(const u32x4*)(P + ((size_t)k4 * 4096 + R1) * 512 + 256 + n0);
            h0 += (f32x4){__builtin_bit_cast(float, a.x << 16), __builtin_bit_cast(float, a.x & 0xffff0000u), __builtin_bit_cast(float, a.y << 16), __builtin_bit_cast(float, a.y & 0xffff0000u)}
                + (f32x4){__builtin_bit_cast(float, c.x << 16), __builtin_bit_cast(float, c.x & 0xffff0000u), __builtin_bit_cast(float, c.y << 16), __builtin_bit_cast(float, c.y & 0xffff0000u)};
            h1 += (f32x4){__builtin_bit_cast(float, a.z << 16), __builtin_bit_cast(float, a.z & 0xffff0000u), __builtin_bit_cast(float, a.w << 16), __builtin_bit_cast(float, a.w & 0xffff0000u)}
                + (f32x4){__builtin_bit_cast(float, c.z << 16), __builtin_bit_cast(float, c.z & 0xffff0000u), __builtin_bit_cast(float, c.w << 16), __builtin_bit_cast(float, c.w & 0xffff0000u)}; }
        u32x4 hw; hw.x = pk2(gelu_tanh(h0[0]), gelu_tanh(h0[1])); hw.y = pk2(gelu_tanh(h0[2]), gelu_tanh(h0[3])); hw.z = pk2(gelu_tanh(h1[0]), gelu_tanh(h1[1])); hw.w = pk2(gelu_tanh(h1[2]), gelu_tanh(h1[3]));
        const bf16x8 hb = __builtin_bit_cast(bf16x8, hw);
#pragma unroll
        for (int nb = 0; nb < 4; ++nb) { const bf16x8 wf = *(const bf16x8*)(W2 + (size_t)(16 * nb) * 256 + 32 * ks); acc[nb] = __builtin_amdgcn_mfma_f32_16x16x32_bf16(wf, hb, acc[nb], 0, 0, 0); } }
    const int R = 16 * rb + fr;
    if (mat == 0) { bf16_t* O = (bf16_t*)(F.ws + WS_KCMP) + (size_t)R * 64 + 4 * fq;
#pragma unroll
        for (int nb = 0; nb < 4; ++nb) { u32x2 w; w.x = pk2(acc[nb][0], acc[nb][1]); w.y = pk2(acc[nb][2], acc[nb][3]); *(u32x2*)(O + 16 * nb) = w; }
    } else { const int bg = R >> 8, c = R & 255; bf16_t* O = (bf16_t*)(F.ws + WS_VCMPT) + (size_t)bg * 64 * 256 + c;
#pragma unroll
        for (int nb = 0; nb < 4; ++nb)
#pragma unroll
            for (int e = 0; e < 4; ++e) O[(size_t)(16 * nb + 4 * fq + e) * 256] = (bf16_t)f2bf(acc[nb][e]); }
}

constexpr int AT_BUF = 35840, AT_K1 = 9216, AT_V0 = 18432, AT_V1 = 27136, AT_IMP = 2 * AT_BUF, AT_IMP_BYTES = 8 * 32 * 65 * 4;
constexpr int AT_SELM = AT_IMP + AT_IMP_BYTES, AT_UNION = AT_SELM + 512, AT_SSQ = AT_UNION + 16, AT_SC = AT_SSQ + 1024;
static_assert(AT_SC + 4096 <= LDS_MISC, "attention LDS map");
__device__ __forceinline__ unsigned cvtpk(float lo, float hi) { f32x2_t v = {lo, hi}; bf16x2_t b = __builtin_convertvector(v, bf16x2_t); return __builtin_bit_cast(unsigned, b); }
__device__ __forceinline__ float xor32(float x, int hi) { auto rr = __builtin_amdgcn_permlane32_swap(__builtin_bit_cast(unsigned, x), __builtin_bit_cast(unsigned, x), false, false);
    return __builtin_bit_cast(float, hi ? rr[0] : rr[1]); }
struct TileSrc { const bf16_t* k0; const bf16_t* k1; const bf16_t* v0; const bf16_t* v1; };
__device__ __forceinline__ void at_load(u32x4 (&st)[4], const TileSrc& s, int vpitch, int tid) {
    st[0] = *(const u32x4*)(s.k0 + tid * 8); st[1] = *(const u32x4*)(s.k1 + tid * 8);
    const int dim = tid >> 3, part = tid & 7;
    st[2] = *(const u32x4*)(s.v0 + (size_t)dim * vpitch + part * 8); st[3] = *(const u32x4*)(s.v1 + (size_t)dim * vpitch + part * 8);
}
__device__ __forceinline__ void at_store(LAS unsigned char* buf, const u32x4 (&st)[4], int tid) {
    const int key = tid >> 3, part = tid & 7;
    *(LAS u32x4*)(buf + key * 144 + part * 16) = st[0];
    *(LAS u32x4*)(buf + AT_K1 + key * 144 + part * 16) = st[1];
    LAS unsigned char* v0 = buf + AT_V0 + key * 136 + part * 16; LAS unsigned char* v1 = buf + AT_V1 + key * 136 + part * 16;
    *(LAS u32x2*)(v0) = (u32x2){st[2].x, st[2].y}; *(LAS u32x2*)(v0 + 8) = (u32x2){st[2].z, st[2].w};
    *(LAS u32x2*)(v1) = (u32x2){st[3].x, st[3].y}; *(LAS u32x2*)(v1 + 8) = (u32x2){st[3].z, st[3].w};
}
__device__ __forceinline__ void at_qk(f32x16 (&s)[2], const LAS unsigned char* kb, const bf16x8 (&qf)[4], const bf16x8 qx, const bf16x8 (&kx)[2], int r32, int hi) {
#pragma unroll
    for (int kb2 = 0; kb2 < 2; ++kb2) { f32x16 a = {};
        a = __builtin_amdgcn_mfma_f32_32x32x16_bf16(kx[kb2], qx, a, 0, 0, 0);
#pragma unroll
        for (int ks = 0; ks < 4; ++ks) { const bf16x8 kf = *(const LAS bf16x8*)(kb + (32 * kb2 + r32) * 144 + (16 * ks + 8 * hi) * 2); a = __builtin_amdgcn_mfma_f32_32x32x16_bf16(kf, qf[ks], a, 0, 0, 0); }
        s[kb2] = a; }
}
template <int MASK  >
__device__ __forceinline__ void at_keymask(f32x16 (&s)[2], int lim, int hi) {
    if (MASK) { const int limh = lim - 4 * hi;
#pragma unroll
        for (int kb2 = 0; kb2 < 2; ++kb2)
#pragma unroll
            for (int r = 0; r < 16; ++r) { const int kc = 32 * kb2 + (r & 3) + 8 * (r >> 2); const bool ok = (MASK == 1) ? (kc <= limh) : (kc >= limh); s[kb2][r] = ok ? s[kb2][r] : NEGF; } }
}
__device__ __forceinline__ float at_max(const f32x16 (&s)[2], int hi) {
    float mx = fmaxf(s[0][0], s[1][0]);
#pragma unroll
    for (int r = 1; r < 16; ++r) mx = fmaxf(fmaxf(mx, s[0][r]), s[1][r]);
    return fmaxf(mx, xor32(mx, hi));
}
__device__ __forceinline__ void at_pv(f32x16 (&O)[2], const LAS unsigned char* vb, const f32x16 (&p)[2], int r32, int hi) {
#pragma unroll
    for (int kb2 = 0; kb2 < 2; ++kb2)
#pragma unroll
        for (int s2 = 0; s2 < 2; ++s2) {
            u32x4 pw; pw.x = cvtpk(p[kb2][8 * s2 + 0], p[kb2][8 * s2 + 1]); pw.y = cvtpk(p[kb2][8 * s2 + 2], p[kb2][8 * s2 + 3]); pw.z = cvtpk(p[kb2][8 * s2 + 4], p[kb2][8 * s2 + 5]); pw.w = cvtpk(p[kb2][8 * s2 + 6], p[kb2][8 * s2 + 7]);
            const bf16x8 pf = __builtin_bit_cast(bf16x8, pw);
#pragma unroll
            for (int db = 0; db < 2; ++db) { const LAS unsigned char* va = vb + (32 * db + r32) * 136 + (32 * kb2 + 16 * s2 + 4 * hi) * 2;
                const u32x2 lo = *(const LAS u32x2*)(va), hh = *(const LAS u32x2*)(va + 16);
                const bf16x8 vf = __builtin_bit_cast(bf16x8, (u32x4){lo.x, lo.y, hh.x, hh.y});
                O[db] = __builtin_amdgcn_mfma_f32_32x32x16_bf16(vf, pf, O[db], 0, 0, 0); } }
}
__device__ __forceinline__ void at_online(int mode, f32x16 (&s)[2], float& m, float& l, f32x16 (&O)[2], const LAS unsigned char* vb, float ctile, bool rowok, int lim, int r32, int hi) {
    if (mode == 1) at_keymask<1>(s, lim, hi); else if (mode == 2) at_keymask<2>(s, lim, hi);
    const float tmx = at_max(s, hi); const float mt = rowok ? tmx + ctile : NEGF; const float mn = fmaxf(m, mt);
    if (__any(mn > m)) { const float f = __builtin_amdgcn_exp2f(m - mn); l *= f;
#pragma unroll
        for (int db = 0; db < 2; ++db)
#pragma unroll
            for (int r = 0; r < 16; ++r) O[db][r] *= f; }
    m = mn;
    const float shift = rowok ? mn - ctile : __builtin_inff(); float ps = 0.f;
#pragma unroll
    for (int kb2 = 0; kb2 < 2; ++kb2)
#pragma unroll
        for (int r = 0; r < 16; ++r) { const float p = __builtin_amdgcn_exp2f(s[kb2][r] - shift); s[kb2][r] = p; ps += p; }
    l += ps;
    at_pv(O, vb, s, r32, hi);
}

__device__ __forceinline__ void attn_item(Frame& F, int b, int i) {
    const int tid = F.tid, lane = F.lane, h = F.wave, g = h >> 2, r32 = lane & 31, hi = lane >> 5;
    const int q0 = 32 * i, tq = q0 + r32; const size_t row = (size_t)b * SEQ + tq;
    LAS unsigned char* lds = F.lds;
    LAS float* IMP = (LAS float*)(lds + AT_IMP); LAS unsigned long long* SELM = (LAS unsigned long long*)(lds + AT_SELM);
    LAS unsigned* UNI = (LAS unsigned*)(lds + AT_UNION); LAS float* SSQ = (LAS float*)(lds + AT_SSQ); LAS float* SC = (LAS float*)(lds + AT_SC);
    const bf16_t* Qp = (const bf16_t*)(F.ws + WS_Q) + row * 512 + h * 64 + 8 * hi;
    bf16x8 qf[4];
#pragma unroll
    for (int ks = 0; ks < 4; ++ks) qf[ks] = *(const bf16x8*)(Qp + 16 * ks);
    const float slope2 = __builtin_amdgcn_exp2f(-(float)(h + 1)) * LOG2E;
    bf16x8 qx, qx16, kx[2];
    { const unsigned s_hi = f2bf(slope2); const float rem = slope2 - __builtin_bit_cast(float, s_hi << 16); const unsigned w1 = hi ? 0u : (s_hi | (f2bf(rem) << 16));
      const float sl16 = 16.0f * slope2; const unsigned t_hi = f2bf(sl16); const float rem16 = sl16 - __builtin_bit_cast(float, t_hi << 16); const unsigned w16 = hi ? 0u : (t_hi | (f2bf(rem16) << 16));
      qx = __builtin_bit_cast(bf16x8, (u32x4){w1, 0u, 0u, 0u}); qx16 = __builtin_bit_cast(bf16x8, (u32x4){w16, 0u, 0u, 0u});
#pragma unroll
      for (int kb2 = 0; kb2 < 2; ++kb2) { const unsigned kk = f2bf((float)(32 * kb2 + r32)); kx[kb2] = __builtin_bit_cast(bf16x8, (u32x4){hi ? 0u : (kk | (kk << 16)), 0u, 0u, 0u}); } }
    const float* GT = (const float*)(F.ws + WS_GATE) + row * 24; const float gate_c = GT[h], gate_s = GT[8 + h], gate_w = GT[16 + h];
    f32x16 out[2]; out[0] = f32x16{}; out[1] = f32x16{};
    if (tid < 4) UNI[tid] = 0u;
    const int koff = g ? AT_K1 : 0, voff = g ? AT_V1 : AT_V0;
    const size_t bg0 = (size_t)b * 2;
    u32x4 st[4];
    const bf16_t* KVb = (const bf16_t*)(F.ws + WS_KV);
    const int jhi = q0 >> 6, dlim = tq - 64 * jhi;
#define KV_SRC(kidx, j) TileSrc{KVb + (size_t)(kidx) * (KV_STRIDE / 2) + ((bg0 + 0) * 4096 + 64 * (j)) * 64, KVb + (size_t)(kidx) * (KV_STRIDE / 2) + ((bg0 + 1) * 4096 + 64 * (j)) * 64, \
        KVb + (size_t)((kidx) + 1) * (KV_STRIDE / 2) + (bg0 + 0) * 64 * 4096 + 64 * (j), KVb + (size_t)((kidx) + 1) * (KV_STRIDE / 2) + (bg0 + 1) * 64 * 4096 + 64 * (j)}
    const bf16_t* KC = (const bf16_t*)(F.ws + WS_KCMP); const bf16_t* VC = (const bf16_t*)(F.ws + WS_VCMPT);
    const int nc = (i >> 5) + 1;
#define CMP_SRC(jc) TileSrc{KC + ((bg0 + 0) * 256 + 64 * (jc)) * 64, KC + ((bg0 + 1) * 256 + 64 * (jc)) * 64, VC + (bg0 + 0) * 64 * 256 + 64 * (jc), VC + (bg0 + 1) * 64 * 256 + 64 * (jc)}
    float m = NEGF, l = 0.f;
    {
        f32x16 O[2]; O[0] = f32x16{}; O[1] = f32x16{}; float carry = 0.f; float mref[4] = {0.f, 0.f, 0.f, 0.f};
        { at_load(st, CMP_SRC(0), 256, tid); at_store(lds, st, tid); __syncthreads(); }
#pragma unroll
        for (int jc = 0; jc < 4; ++jc) { if (jc < nc) {
            LAS unsigned char* buf = lds + (jc & 1) * AT_BUF; const bool more = jc + 1 < nc;
            if (more) at_load(st, CMP_SRC(jc + 1), 256, tid); else at_load(st, KV_SRC(2, jhi), 4096, tid);
            f32x16 s[2]; at_qk(s, buf + koff, qf, qx16, kx, r32, hi);
            const float mprev = m;
            at_online((jc + 2 >= nc) ? 1 : 0, s, m, l, O, buf + voff, slope2 * (float)(1024 * jc + 31 - tq), true, ((tq - 31) >> 4) - 64 * jc, r32, hi);
            mref[jc] = m; carry *= __builtin_amdgcn_exp2f(mprev - m);
            float sum4[8], recv[8];
#pragma unroll
            for (int g8 = 0; g8 < 8; ++g8) { const int kb2 = g8 >> 2, qq = g8 & 3; sum4[g8] = (s[kb2][4 * qq] + s[kb2][4 * qq + 1]) + (s[kb2][4 * qq + 2] + s[kb2][4 * qq + 3]); recv[g8] = xor32(s[kb2][4 * qq + 3], hi); }
#pragma unroll
            for (int g8 = 0; g8 < 8; ++g8) { const float extra = hi ? recv[g8] : (g8 ? recv[g8 > 0 ? g8 - 1 : 0] : carry);
                IMP[(h * 32 + r32) * 65 + 16 * jc + 2 * g8 + hi] = sum4[g8] + extra; }
            carry = recv[7];
            if (more) at_store(lds + ((jc + 1) & 1) * AT_BUF, st, tid);
            __syncthreads();
        } }
        const float ltot = l + xor32(l, hi); const float inv = (tq >= 31) ? __builtin_amdgcn_rcpf(ltot) : 0.f;
        if (hi == 0) {
#pragma unroll
            for (int jc = 0; jc < 4; ++jc) SC[(h * 32 + r32) * 4 + jc] = (jc < nc) ? __builtin_amdgcn_exp2f(mref[jc] - m) * inv : 0.f; }
        const float oc = gate_c * inv;
#pragma unroll
        for (int db = 0; db < 2; ++db)
#pragma unroll
            for (int r = 0; r < 16; ++r) out[db][r] = oc * O[db][r];
        __syncthreads();
    }
#undef CMP_SRC
    LAS float* PARK = (LAS float*)(lds + AT_IMP) + (size_t)h * 2048 + lane;
    {
        unsigned long long un0 = 0ull, un1 = 0ull;
        for (int pp = 0; pp < 8; ++pp) { const int g2 = pp >> 2, q = 4 * h + (pp & 3), t = q0 + q, cur_t = t >> 6;
            float v = 0.f;
#pragma unroll
            for (int hh = 0; hh < 4; ++hh) v += IMP[((4 * g2 + hh) * 32 + q) * 65 + lane] * SC[((4 * g2 + hh) * 32 + q) * 4 + (lane >> 4)];
            const bool forced = (lane == 0) || (lane == cur_t) || (lane == cur_t - 1), vis = lane <= cur_t;
            const unsigned key = forced ? (0x7f000000u | (unsigned)(63 - lane)) : (vis ? ((__builtin_bit_cast(unsigned, v) & ~63u) | (unsigned)(63 - lane)) : 0u);
            int rank = 0;
            if (cur_t >= 16) {
#pragma unroll
                for (int jj = 0; jj < 64; ++jj) { const unsigned o = (unsigned)__builtin_amdgcn_readlane((int)key, jj); rank += (o > key) ? 1 : 0; } }
            const unsigned long long mask = __ballot((rank < 16) && vis);
            if (lane == 0) SELM[g2 * 32 + q] = mask;
            if (g2) un1 |= mask; else un0 |= mask; }
        if (lane == 0) { atomicOr((unsigned*)&UNI[0], (unsigned)un0); atomicOr((unsigned*)&UNI[1], (unsigned)(un0 >> 32)); atomicOr((unsigned*)&UNI[2], (unsigned)un1); atomicOr((unsigned*)&UNI[3], (unsigned)(un1 >> 32)); }
        __syncthreads();
    }
#pragma unroll
    for (int db = 0; db < 2; ++db)
#pragma unroll
        for (int r = 0; r < 16; ++r) PARK[(db * 16 + r) * 64] = out[db][r];
    {
        const unsigned u0 = __builtin_amdgcn_readfirstlane(UNI[0]), u1 = __builtin_amdgcn_readfirstlane(UNI[1]), u2 = __builtin_amdgcn_readfirstlane(UNI[2]), u3 = __builtin_amdgcn_readfirstlane(UNI[3]);
        const unsigned long long U0 = ((unsigned long long)u1 << 32) | u0, U1 = ((unsigned long long)u3 << 32) | u2, Ug = g ? U1 : U0;
        unsigned long long rem = U0 | U1;
        const unsigned long long mysel = SELM[g * 32 + r32];
        m = NEGF; l = 0.f; f32x16 O[2]; O[0] = f32x16{}; O[1] = f32x16{};
        int j = 63 - __builtin_clzll(rem); rem &= ~(1ull << j);
        { at_store(lds, st, tid); __syncthreads(); }
        int par = 0;
        for (;;) {
            LAS unsigned char* buf = lds + par * AT_BUF; const bool more = rem != 0ull; const int jn = more ? 63 - __builtin_clzll(rem) : 0; rem &= ~(1ull << jn);
            if (more) at_load(st, KV_SRC(2, jn), 4096, tid); else at_load(st, KV_SRC(4, jhi), 4096, tid);
            if ((Ug >> j) & 1ull) { f32x16 s[2]; at_qk(s, buf + koff, qf, qx, kx, r32, hi);
                const float ctile = slope2 * (float)(64 * j - tq); const bool rowok = ((mysel >> j) & 1ull) != 0ull;
                at_online(j == jhi ? 1 : 0, s, m, l, O, buf + voff, ctile, rowok, dlim, r32, hi); }
            if (more) at_store(lds + (par ^ 1) * AT_BUF, st, tid);
            __syncthreads();
            if (!more) break;
            j = jn; par ^= 1;
        }
        const float ltot = l + xor32(l, hi); const float sc = gate_s * __builtin_amdgcn_rcpf(ltot);
#pragma unroll
        for (int db = 0; db < 2; ++db)
#pragma unroll
            for (int r = 0; r < 16; ++r) PARK[(db * 16 + r) * 64] += sc * O[db][r];
    }
    {
        int jlo = (q0 - 511) >> 6; if (jlo < 0) jlo = 0;
        const int llim = tq - 511 - 64 * jlo;
        m = NEGF; l = 0.f; f32x16 O[2]; O[0] = f32x16{}; O[1] = f32x16{};
        { at_store(lds, st, tid); __syncthreads(); }
        for (int j = jhi; j >= jlo; --j) {
            LAS unsigned char* buf = lds + ((jhi - j) & 1) * AT_BUF; const bool more = j > jlo;
            if (more) at_load(st, KV_SRC(4, j - 1), 4096, tid);
            f32x16 s[2]; at_qk(s, buf + koff, qf, qx, kx, r32, hi);
            const float ctile = slope2 * (float)(64 * j - tq);
            at_online(j == jhi ? 1 : (j == jlo ? 2 : 0), s, m, l, O, buf + voff, ctile, true, j == jhi ? dlim : llim, r32, hi);
            if (more) at_store(lds + ((jhi - j + 1) & 1) * AT_BUF, st, tid);
            __syncthreads();
        }
        const float ltot = l + xor32(l, hi); const float sc = gate_w * __builtin_amdgcn_rcpf(ltot);
#pragma unroll
        for (int db = 0; db < 2; ++db)
#pragma unroll
            for (int r = 0; r < 16; ++r) out[db][r] = PARK[(db * 16 + r) * 64] + sc * O[db][r];
    }
#undef KV_SRC
    {
        float ss = 0.f;
#pragma unroll
        for (int db = 0; db < 2; ++db)
#pragma unroll
            for (int r = 0; r < 16; ++r) ss += out[db][r] * out[db][r];
        ss += xor32(ss, hi);
        if (hi == 0) SSQ[h * 32 + r32] = ss;
        __syncthreads();
        float tot = 0.f;
#pragma unroll
        for (int hh = 0; hh < 8; ++hh) tot += SSQ[hh * 32 + r32];
        const float rstd = rsqrtf(tot * (1.0f / 512.0f) + EPS);
        bf16_t* yp = (bf16_t*)(F.ws + WS_YCAT) + row * 1024 + 512 + h * 64 + 4 * hi;
#pragma unroll
        for (int db = 0; db < 2; ++db)
#pragma unroll
            for (int qq = 0; qq < 4; ++qq) { u32x2 w; w.x = cvtpk(out[db][4 * qq] * rstd, out[db][4 * qq + 1] * rstd); w.y = cvtpk(out[db][4 * qq + 2] * rstd, out[db][4 * qq + 3] * rstd);
                *(u32x2*)(yp + 32 * db + 8 * qq) = w; }
        __syncthreads();
    }
}

__global__ void __launch_bounds__(512) hybrid_fwd(Args args) {
    extern __shared__ __attribute__((aligned(16))) unsigned char lds_raw[];
    cg::grid_group grid = cg::this_grid();
    Frame F; F.lds = (LAS unsigned char*)lds_raw; F.tid = threadIdx.x; F.lane = F.tid & 63; F.wave = __builtin_amdgcn_readfirstlane(F.tid >> 6);
    F.G = gridDim.x; F.bid = blockIdx.x; F.ws = args.ws; F.in = args.in;
    unsigned char* ws = args.ws;
    volatile LAS unsigned* MISC = (volatile LAS unsigned*)(F.lds + LDS_MISC);
    if (F.tid < 2) MISC[F.tid] = 0u;
    __syncthreads();
    XcdBarrier xbar = xcd_barrier_post((unsigned*)ws, MISC);
    const int wave_u = __builtin_amdgcn_readfirstlane((int)threadIdx.x >> 6);
#define FRESH_TID() fresh_tid2(wave_u)
#define REFRESH() do { F.tid = FRESH_TID(); F.lane = F.tid & 63; F.wave = wave_u; } while (0)
#ifdef PROBE_A
    int nst_ = 0; unsigned long long* tsb_ = (unsigned long long*)(ws + 32768);
#define STAMP() do { if (blockIdx.x == 0 && threadIdx.x == 0) tsb_[nst_] = __builtin_amdgcn_s_memrealtime(); ++nst_; } while (0)
#else
#define STAMP() do {} while (0)
#endif
    STAMP();
#define GRID_BAR() do { xcd_barrier(xbar); REFRESH(); STAMP(); } while (0)
#define GRID_BAR_CG() do { grid.sync(); REFRESH(); STAMP(); } while (0)
    p0_prologue(F);
#ifdef DUP_P0
    __syncthreads(); REFRESH(); p0_prologue(F);
#endif
    if (args.ws == nullptr) grid.sync();
    GRID_BAR();
#ifdef DUP_BAR
    GRID_BAR(); GRID_BAR(); GRID_BAR(); GRID_BAR(); GRID_BAR(); GRID_BAR(); GRID_BAR(); GRID_BAR(); GRID_BAR(); GRID_BAR();
#endif
    p1_rows(F);
#ifdef DUP_P1
    __syncthreads(); REFRESH(); p1_rows(F);
#endif
    GRID_BAR();
    { pg8::Gemm g{(const bf16_t*)(ws + WS_H), (const bf16_t*)(ws + WS_WINT), M, NZ, DM, DM, DM}; pg8::StaticOrder S; S.init(M, NZ, F.G, F.bid);
      EpiZ E{ws, F.lds}; pg8::gemm_phase<EpiZ, pg8::StaticOrder>(F.lds, g, S, E, FRESH_TID()); }
#ifdef DUP_P2
    __syncthreads(); REFRESH();
    { pg8::Gemm g{(const bf16_t*)(ws + WS_H), (const bf16_t*)(ws + WS_WINT), M, NZ, DM, DM, DM}; pg8::StaticOrder S; S.init(M, NZ, F.G, F.bid);
      EpiZ E{ws, F.lds}; pg8::gemm_phase<EpiZ, pg8::StaticOrder>(F.lds, g, S, E, FRESH_TID()); }
#endif
    GRID_BAR();
    { for (int n = F.bid; n < 256; n += F.G) { const int mat = n >> 7, pm = (n >> 3) & 15, pn = (n >> 2) & 1, ks = n & 3;
        pg8::Gemm g{(const bf16_t*)(ws + WS_KV + (size_t)mat * KV_STRIDE) + (size_t)pm * 256 * 1024 + ks * 256,
                    (const bf16_t*)(ws + (mat ? WS_CW1VT : WS_CW1KT)) + pn * 1024 + ks * 256, 256, 256, 256, 1024, 2048};
        EpiBf16<0> E{(bf16_t*)(ws + WS_CP) + ((size_t)(mat * 4 + ks) * 4096 + pm * 256) * 512 + pn * 256, 512, nullptr};
        pg8::gemm_phase<EpiBf16<0>, pg8::OneUnit>(F.lds, g, pg8::OneUnit{}, E, FRESH_TID()); }
      __syncthreads(); REFRESH();
      for (int it = F.bid; it < 512; it += F.G) rnn_item<1>(F, it >> 6, it & 63); }
#ifdef DUP_P3
    __syncthreads(); REFRESH();
    { for (int n = F.bid; n < 256; n += F.G) { const int mat = n >> 7, pm = (n >> 3) & 15, pn = (n >> 2) & 1, ks = n & 3;
        pg8::Gemm g{(const bf16_t*)(ws + WS_KV + (size_t)mat * KV_STRIDE) + (size_t)pm * 256 * 1024 + ks * 256,
                    (const bf16_t*)(ws + (mat ? WS_CW1VT : WS_CW1KT)) + pn * 1024 + ks * 256, 256, 256, 256, 1024, 2048};
        EpiBf16<0> E{(bf16_t*)(ws + WS_CP) + ((size_t)(mat * 4 + ks) * 4096 + pm * 256) * 512 + pn * 256, 512, nullptr};
        pg8::gemm_phase<EpiBf16<0>, pg8::OneUnit>(F.lds, g, pg8::OneUnit{}, E, FRESH_TID()); }
      __syncthreads(); REFRESH();
      for (int it = F.bid; it < 512; it += F.G) rnn_item<1>(F, it >> 6, it & 63); }
#endif
    GRID_BAR();
    { const int gw = F.bid * 8 + F.wave, NGW = F.G * 8;
      for (int it = gw; it < 512 + 64; it += NGW) {
          if (it < 512) { cmp2_item(F, it); continue; }
          const int r = it - 512, b = r >> 3, ch = 64 * (r & 7) + F.lane; const float* RA = (const float*)(ws + WS_RA); const float* RH = (const float*)(ws + WS_RH); float* HIN = (float*)(ws + WS_RHIN);
          float h = 0.f;
#pragma unroll 32
          for (int c = 0; c < 64; ++c) { const size_t o = (size_t)(b * 64 + c) * 512 + ch; const float a = RA[o], hh = RH[o]; HIN[o] = h; h = a * h + hh; } } }
#ifdef DUP_P4
    __syncthreads(); REFRESH();
    { const int gw = F.bid * 8 + F.wave, NGW = F.G * 8;
      for (int it = gw; it < 512 + 64; it += NGW) {
          if (it < 512) { cmp2_item(F, it); continue; }
          const int r = it - 512, b = r >> 3, ch = 64 * (r & 7) + F.lane; const float* RA = (const float*)(ws + WS_RA); const float* RH = (const float*)(ws + WS_RH); float* HIN = (float*)(ws + WS_RHIN);
          float h = 0.f;
#pragma unroll 32
          for (int c = 0; c < 64; ++c) { const size_t o = (size_t)(b * 64 + c) * 512 + ch; const float a = RA[o], hh = RH[o]; HIN[o] = h; h = a * h + hh; } } }
#endif
    GRID_BAR();
    { for (int n = F.bid; n < 1024; n += F.G) { const int k = n >> 8, c = n & 255, b = c & 7, r = c >> 3;     const int i = (k == 0) ? r : (k == 1) ? 63 - r : (k == 2) ? 64 + r : 127 - r; attn_item(F, b, i); }
#ifdef DUP_ATT
      __syncthreads(); REFRESH();
      for (int n = F.bid; n < 1024; n += F.G) { const int k = n >> 8, c = n & 255, b = c & 7, r = c >> 3; const int i = (k == 0) ? r : (k == 1) ? 63 - r : (k == 2) ? 64 + r : 127 - r; attn_item(F, b, i); }
#endif
      __syncthreads();
      for (int it = F.bid; it < 512; it += F.G) rnn_item<2>(F, it >> 6, it & 63);
#ifdef DUP_RNN2
      __syncthreads(); REFRESH();
      for (int it = F.bid; it < 512; it += F.G) rnn_item<2>(F, it >> 6, it & 63);
#endif
    }
#ifdef DUP_P5
    __syncthreads(); REFRESH();
    { for (int n = F.bid; n < 1024; n += F.G) { const int k = n >> 8, c = n & 255, b = c & 7, r = c >> 3;     const int i = (k == 0) ? r : (k == 1) ? 63 - r : (k == 2) ? 64 + r : 127 - r; attn_item(F, b, i); }
      __syncthreads();
      for (int it = F.bid; it < 512; it += F.G) rnn_item<2>(F, it >> 6, it & 63);
#endif
    GRID_BAR();
    { pg8::Gemm g{(const bf16_t*)(ws + WS_YCAT), (const bf16_t*)(ws + WS_WOUTT), M, DM, DM, DM, DM}; pg8::StaticOrder S; S.init(M, DM, F.G, F.bid);
      EpiBf16<0> E{(bf16_t*)(ws + WS_Y), DM, nullptr}; pg8::gemm_phase<EpiBf16<0>, pg8::StaticOrder>(F.lds, g, S, E, FRESH_TID()); }
#ifdef DUP_P6
    __syncthreads(); REFRESH();
    { pg8::Gemm g{(const bf16_t*)(ws + WS_YCAT), (const bf16_t*)(ws + WS_WOUTT), M, DM, DM, DM, DM}; pg8::StaticOrder S; S.init(M, DM, F.G, F.bid);
      EpiBf16<0> E{(bf16_t*)(ws + WS_Y), DM, nullptr}; pg8::gemm_phase<EpiBf16<0>, pg8::StaticOrder>(F.lds, g, S, E, FRESH_TID()); }
#endif
    GRID_BAR();
    p7_rows(F);
#ifdef DUP_P7
    __syncthreads(); REFRESH(); p7_rows(F);
#endif
    GRID_BAR();
    { pg8::Gemm g{(const bf16_t*)(ws + WS_H), (const bf16_t*)(ws + WS_WFF1T), M, DFF, DM, DM, DM}; pg8::StaticOrder S; S.init(M, DFF, F.G, F.bid);
      EpiBf16<1> E{(bf16_t*)(ws + WS_HID), DFF, nullptr}; pg8::gemm_phase<EpiBf16<1>, pg8::StaticOrder>(F.lds, g, S, E, FRESH_TID()); }
#ifdef DUP_P8
    __syncthreads(); REFRESH();
    { pg8::Gemm g{(const bf16_t*)(ws + WS_H), (const bf16_t*)(ws + WS_WFF1T), M, DFF, DM, DM, DM}; pg8::StaticOrder S; S.init(M, DFF, F.G, F.bid);
      EpiBf16<1> E{(bf16_t*)(ws + WS_HID), DFF, nullptr}; pg8::gemm_phase<EpiBf16<1>, pg8::StaticOrder>(F.lds, g, S, E, FRESH_TID()); }
#endif
    GRID_BAR();
    { pg8::Gemm g{(const bf16_t*)(ws + WS_HID), (const bf16_t*)(ws + WS_WFF2T), M, DM, DFF, DFF, DFF}; pg8::StaticOrder S; S.init(M, DM, F.G, F.bid);
      EpiBf16<0> E{(bf16_t*)(ws + WS_Y2), DM, nullptr}; pg8::gemm_phase<EpiBf16<0>, pg8::StaticOrder>(F.lds, g, S, E, FRESH_TID()); }
#ifdef DUP_P9
    __syncthreads(); REFRESH();
    { pg8::Gemm g{(const bf16_t*)(ws + WS_HID), (const bf16_t*)(ws + WS_WFF2T), M, DM, DFF, DFF, DFF}; pg8::StaticOrder S; S.init(M, DM, F.G, F.bid);
      EpiBf16<0> E{(bf16_t*)(ws + WS_Y2), DM, nullptr}; pg8::gemm_phase<EpiBf16<0>, pg8::StaticOrder>(F.lds, g, S, E, FRESH_TID()); }
#endif
    GRID_BAR();
    p10_rows(F, args.out);
#ifdef DUP_P10
    __syncthreads(); REFRESH(); p10_rows(F, args.out);
#endif
#ifdef PROBE_A
    GRID_BAR();
    { const float Ta = (float)(tsb_[PROBE_A + 1] - tsb_[PROBE_A]) * 0.01f, Tb = (float)(tsb_[PROBE_B + 1] - tsb_[PROBE_B]) * 0.01f;
      if (blockIdx.x == 0 && threadIdx.x == 0) args.out[0] += Ta;
      for (int idx = 1024 + blockIdx.x * 512 + threadIdx.x; idx < 1024 + (1 << 20); idx += gridDim.x * 512) args.out[idx] += Tb * 0.01f; }
#endif
}

extern "C" void kernel_launch(void* const* d_in, const int* in_sizes, int n_in, void* d_out, int out_size, void* d_ws, size_t ws_size, hipStream_t stream) {
    static int grid = 0;
    if (grid == 0) {
        if (n_in != 27 || out_size != M * DM || ws_size < WS_END) { fprintf(stderr, "kernel_launch: unexpected problem (n_in %d out %d ws %zu)\n", n_in, out_size, ws_size); grid = -1; return; }
        int dev = 0, cus = 0, per_cu = 0;
        (void)hipGetDevice(&dev); (void)hipDeviceGetAttribute(&cus, hipDeviceAttributeMultiprocessorCount, dev);
        (void)hipFuncSetAttribute((const void*)hybrid_fwd, hipFuncAttributeMaxDynamicSharedMemorySize, LDS_BYTES);
        if (hipOccupancyMaxActiveBlocksPerMultiprocessor(&per_cu, (const void*)hybrid_fwd, 512, LDS_BYTES) != hipSuccess || per_cu < 1) per_cu = 1;
        (void)hipGetLastError();
        grid = cus * 1;
        fprintf(stderr, "kernel_launch: grid %d (per_cu %d)\n", grid, per_cu);
    }
    if (grid < 0) return;
    (void)hipMemsetAsync(d_ws, 0, 16384, stream);
    Args a{};
    for (int i = 0; i < 27; ++i) a.in[i] = (const float*)d_in[i];
    a.out = (float*)d_out; a.ws = (unsigned char*)d_ws;
    void* kargs[] = {&a};
    hipError_t e = hipLaunchCooperativeKernel((const void*)hybrid_fwd, dim3(grid), dim3(512), kargs, LDS_BYTES, stream);
    if (e != hipSuccess) fprintf(stderr, "kernel_launch: cooperative launch failed: %s\n", hipGetErrorString(e));
}
```

```cpp
#include <hip/hip_runtime.h>
#include <hip/hip_cooperative_groups.h>
#include <cstdio>
#include <cstdint>
namespace cg = cooperative_groups;

#define LAS __attribute__((address_space(3)))
typedef unsigned short bf16_t;
typedef short bf16x8 __attribute__((ext_vector_type(8)));
typedef short s16x4 __attribute__((ext_vector_type(4)));
typedef float f32x4 __attribute__((ext_vector_type(4)));
typedef float f32x16 __attribute__((ext_vector_type(16)));
typedef unsigned u32x4 __attribute__((ext_vector_type(4)));
typedef unsigned u32x2 __attribute__((ext_vector_type(2)));
#define LOG2E_C 1.4426950408889634f

namespace pg8 {
constexpr int BM = 256, BK = 64, HALF = 128, HTB = HALF * BK * 2, STAGE_BYTES = 8 * HTB, NXCD = 8, WGM = 8;
__host__ __device__ __forceinline__ int lds_byte(int r, int c) { const int st = (r >> 4) * 2 + (c >> 5), rr = r & 15, cc = c & 31, ob = rr * 64 + cc * 2; return st * 1024 + (ob ^ (((ob >> 9) & 1) << 5)); }
__host__ __device__ __forceinline__ void stage_rc(int b, int& R, int& C) { const int st = b / 1024, sb = b % 1024, swz = sb ^ (((sb >> 9) & 1) << 5); R = (st >> 1) * 16 + swz / 64; C = (st & 1) * 32 + (swz % 64) / 2; }
__host__ __device__ __forceinline__ int perm32(int rho) { const int n = rho >> 4, i = rho & 15; return 8 * (i >> 2) + 4 * n + (i & 3); }

struct Unit { int pm, pn; };
struct Gemm { const bf16_t* A; const bf16_t* Bt; int M, N, K, lda, ldb; };

struct StaticOrder {
    int nM, nN, nwg, G, c;
    __device__ void init(int M, int N, int G_, int c_) { nM = M / BM; nN = N / BM; nwg = nM * nN; G = G_; c = c_; }
    __device__ bool next(int i, Unit& u) const {
        const long L = (long)i * G + c; if (L >= nwg) return false;
        int wgid = (int)L; { const int q = nwg / NXCD, r = nwg % NXCD, xcd = wgid % NXCD, off = wgid / NXCD; wgid = (xcd < r ? xcd * (q + 1) : r * (q + 1) + (xcd - r) * q) + off; }
        const int nig = WGM * nN, gid = wgid / nig, fm = gid * WGM, gsz = (nM - fm) < WGM ? (nM - fm) : WGM;
        u.pm = fm + ((wgid % nig) % gsz); u.pn = (wgid % nig) / gsz; return true;
    }
};
struct OneUnit { __device__ bool next(int i, Unit& u) const { if (i) return false; u.pm = 0; u.pn = 0; return true; } };
struct ColOrder {
    int nM, G, c;
    __device__ bool next(int i, Unit& u) const { const long L = (long)i * G + c; if (c < 0 || L >= nM) return false; u.pm = (int)L; u.pn = 0; return true; }
};

__device__ __forceinline__ unsigned cvt_pk_bf16(float lo, float hi) { unsigned r; asm volatile("v_cvt_pk_bf16_f32 %0, %1, %2" : "=v"(r) : "v"(lo), "v"(hi)); return r; }

template <class Epi, class Sched>
__device__ __forceinline__ void gemm_phase(LAS unsigned char* lds, const Gemm g, const Sched& S, const Epi& E, int tid) {
    const int wid = __builtin_amdgcn_readfirstlane(tid >> 6), lane = tid & 63, wr = wid >> 2, wc = wid & 3, fr = lane & 15, fq = lane >> 4;
    const int K = g.K, nt = K / BK, lda = g.lda, ldb = g.ldb;
    unsigned voffA[2], voffB[2];
#pragma unroll
    for (int i = 0; i < 2; ++i) { int R, C; stage_rc(tid * 16 + i * 8192, R, C); const int Rb = Epi::PERM ? ((R & ~31) + perm32(R & 31)) : R;
        voffA[i] = (unsigned)(R * lda + C) * 2u; voffB[i] = (unsigned)(Rb * ldb + C) * 2u; }
    const size_t kstep = (size_t)(BK * 2);
    const size_t hstepA = (size_t)HALF * lda * 2, hstepB = (size_t)HALF * ldb * 2;
    const size_t tstepA = 2 * hstepA, tstepB = 2 * hstepB;
    const unsigned ldsw = (unsigned)wid * 1024u;
    const int aoff = lds_byte(wr * 64 + fr, fq * 8), boff = lds_byte(wc * 32 + fr, fq * 8);
#define PG8_SA(b, h) (((b) * 2 + (h)) * HTB)
#define PG8_SB(b, h) ((4 + (b) * 2 + (h)) * HTB)
#define PG8_STAGE(bufoff, gbase, voff) do { _Pragma("unroll") for (int _i = 0; _i < 2; ++_i) \
        __builtin_amdgcn_global_load_lds((const unsigned*)((const char*)(gbase) + (voff)[_i]), (LAS unsigned*)(lds + (bufoff) + ldsw + _i * 8192), 16, 0, 0); } while (0)
#define PG8_LDA(dst, b, h) do { _Pragma("unroll") for (int m = 0; m < 4; ++m) _Pragma("unroll") for (int k = 0; k < 2; ++k) dst[m][k] = *(const LAS bf16x8*)(lds + PG8_SA(b, h) + aoff + m * 2048 + k * 1024); } while (0)
#define PG8_LDB(dst, b, h) do { _Pragma("unroll") for (int n = 0; n < 2; ++n) _Pragma("unroll") for (int k = 0; k < 2; ++k) dst[n][k] = *(const LAS bf16x8*)(lds + PG8_SB(b, h) + boff + n * 2048 + k * 1024); } while (0)
#define PG8_MMA(ai, bj, At, Bt) do { __builtin_amdgcn_s_setprio(1); _Pragma("unroll") for (int m = 0; m < 4; ++m) _Pragma("unroll") for (int n = 0; n < 2; ++n) _Pragma("unroll") for (int k = 0; k < 2; ++k) \
        acc[ai][bj][m][n] = __builtin_amdgcn_mfma_f32_16x16x32_bf16(Bt[n][k], At[m][k], acc[ai][bj][m][n], 0, 0, 0); __builtin_amdgcn_s_setprio(0); } while (0)
#define PG8_WAIT_V(n) asm volatile("s_waitcnt vmcnt(" #n ")" ::: "memory")
#define PG8_WAIT_L(n) asm volatile("s_waitcnt lgkmcnt(" #n ")" ::: "memory")
#define PG8_BAR __builtin_amdgcn_s_barrier()
#define PG8_SCHED __builtin_amdgcn_sched_barrier(0)
    Unit cur, nxt; int ui = 0;
    if (!S.next(0, cur)) return;
    f32x4 acc[2][2][4][2];
#pragma unroll
    for (int a = 0; a < 2; ++a)
#pragma unroll
        for (int b = 0; b < 2; ++b)
#pragma unroll
            for (int m = 0; m < 4; ++m)
#pragma unroll
                for (int n = 0; n < 2; ++n) acc[a][b][m][n] = (f32x4){0.f, 0.f, 0.f, 0.f};
    bf16x8 At[4][2], B0[2][2], B1[2][2];
    const char* cA = (const char*)g.A + (size_t)cur.pm * tstepA; const char* cB = (const char*)g.Bt + (size_t)cur.pn * tstepB;
    PG8_STAGE(PG8_SB(0, 0), cB, voffB); PG8_STAGE(PG8_SB(0, 1), cB + hstepB, voffB); PG8_STAGE(PG8_SA(0, 0), cA, voffA); PG8_STAGE(PG8_SA(0, 1), cA + hstepA, voffA);
    if (wr == 1) PG8_BAR;
    PG8_WAIT_V(2); PG8_BAR;
    PG8_STAGE(PG8_SB(1, 0), cB + kstep, voffB); PG8_STAGE(PG8_SA(1, 0), cA + kstep, voffA); PG8_STAGE(PG8_SB(1, 1), cB + hstepB + kstep, voffB);
    PG8_WAIT_V(6); PG8_BAR;
    for (;;) {
        const bool has_next = S.next(ui + 1, nxt);
        const char* nA = has_next ? (const char*)g.A + (size_t)nxt.pm * tstepA : cA; const char* nB = has_next ? (const char*)g.Bt + (size_t)nxt.pn * tstepB : cB;
        for (int t = 0; t < nt; t += 2) {
            const bool last = (t == nt - 2);
            const char* a1 = cA + (size_t)(t + 1) * kstep;
            const char* a2 = last ? nA : cA + (size_t)(t + 2) * kstep; const char* b2 = last ? nB : cB + (size_t)(t + 2) * kstep;
            const char* a3 = a2 + kstep; const char* b3 = b2 + kstep;
            PG8_LDB(B0, 0, 0); PG8_LDB(B1, 0, 1); PG8_SCHED; PG8_LDA(At, 0, 0); PG8_STAGE(PG8_SA(1, 1), a1 + hstepA, voffA);
            PG8_WAIT_V(8); PG8_WAIT_L(0); PG8_BAR; PG8_MMA(0, 0, At, B0); PG8_MMA(0, 1, At, B1); PG8_BAR; PG8_SCHED;
            PG8_LDA(At, 0, 1); PG8_STAGE(PG8_SB(0, 0), b2, voffB); PG8_STAGE(PG8_SB(0, 1), b2 + hstepB, voffB); PG8_STAGE(PG8_SA(0, 0), a2, voffA);
            PG8_WAIT_V(8); PG8_WAIT_L(0); PG8_BAR; PG8_MMA(1, 0, At, B0); PG8_MMA(1, 1, At, B1); PG8_BAR; PG8_SCHED;
            PG8_LDB(B0, 1, 0); PG8_LDB(B1, 1, 1); PG8_SCHED; PG8_LDA(At, 1, 0); PG8_STAGE(PG8_SA(0, 1), a2 + hstepA, voffA);
            PG8_WAIT_V(8); PG8_WAIT_L(0); PG8_BAR; PG8_MMA(0, 0, At, B0); PG8_MMA(0, 1, At, B1); PG8_BAR; PG8_SCHED;
            PG8_LDA(At, 1, 1); PG8_STAGE(PG8_SB(1, 0), b3, voffB); PG8_STAGE(PG8_SB(1, 1), b3 + hstepB, voffB); PG8_STAGE(PG8_SA(1, 0), a3, voffA);
            PG8_WAIT_V(8); PG8_WAIT_L(0); PG8_BAR; PG8_MMA(1, 0, At, B0); PG8_MMA(1, 1, At, B1); PG8_BAR; PG8_SCHED;
        }
        E(acc, cur, wr, wc, fr, fq);
        if (!has_next) break;
#pragma unroll
        for (int a = 0; a < 2; ++a)
#pragma unroll
            for (int b = 0; b < 2; ++b)
#pragma unroll
                for (int m = 0; m < 4; ++m)
#pragma unroll
                    for (int n = 0; n < 2; ++n) acc[a][b][m][n] = (f32x4){0.f, 0.f, 0.f, 0.f};
        cur = nxt; cA = nA; cB = nB; ++ui;
    }
    PG8_WAIT_V(0);
    if (wr == 0) PG8_BAR;
    PG8_BAR;
#undef PG8_SA
#undef PG8_SB
#undef PG8_STAGE
#undef PG8_LDA
#undef PG8_LDB
#undef PG8_MMA
#undef PG8_WAIT_V
#undef PG8_WAIT_L
#undef PG8_BAR
#undef PG8_SCHED
}
}

constexpr int BATCH = 8, SEQ = 4096, DM = 1024, M = BATCH * SEQ, NZ = 2560, DFF = 4096, NMOD = 6 * DM;
constexpr float EPS = 1e-6f, NEGF = -1e30f, LOG2E = 1.4426950408889634f;
constexpr size_t MiB = 1u << 20, KiB = 1024;
constexpr size_t WS_MOD = 64 * KiB;
constexpr size_t WS_CB1P = 320 * KiB;
constexpr size_t WS_CB1 = 384 * KiB;
constexpr size_t WS_LRUC = 400 * KiB;
constexpr size_t WS_WAT = 448 * KiB, WS_WXT = 512 * KiB;
constexpr size_t WS_CW2KT = 576 * KiB, WS_CW2VT = 640 * KiB;
constexpr size_t WS_WINT = 2 * MiB, WS_WOUTT = 8 * MiB, WS_WFF1T = 10 * MiB, WS_WFF2T = 18 * MiB, WS_CW1KT = 26 * MiB, WS_CW1VT = 27 * MiB;
constexpr size_t WS_CHIDK = 28 * MiB, WS_CHIDV = 30 * MiB;
constexpr size_t WS_H = 32 * MiB;
constexpr size_t WS_GRNN = 96 * MiB, WS_XRNN = 128 * MiB, WS_Q = 160 * MiB;
constexpr size_t WS_KV = 192 * MiB, KV_STRIDE = 8 * MiB;
constexpr size_t WS_GATE = 240 * MiB;
constexpr size_t WS_KCMP = 244 * MiB, WS_VCMPT = WS_KCMP + 512 * KiB;
constexpr size_t WS_RA = 246 * MiB, WS_RH = 247 * MiB, WS_RHIN = 248 * MiB;
constexpr size_t WS_YCAT = 256 * MiB;
constexpr size_t WS_Y = 416 * MiB;
constexpr size_t WS_HID = 96 * MiB;
constexpr size_t WS_Y2 = 352 * MiB;
constexpr size_t WS_RG = 416 * MiB;
constexpr size_t WS_CP = WS_Y2;
constexpr size_t WS_END = 480 * MiB;
constexpr int LDS_BYTES = 147456, LDS_MISC = 147200;

struct Args { const float* in[27]; float* out; unsigned char* ws; };

struct Frame {
    LAS unsigned char* lds; int tid, lane, wave, G, bid; unsigned char* ws; const float* const* in;
};

__device__ __forceinline__ unsigned f2bf(float f) { unsigned u = __builtin_bit_cast(unsigned, f); return (u + 0x7fffu + ((u >> 16) & 1u)) >> 16; }
typedef __bf16 bf16x2_t __attribute__((ext_vector_type(2)));
typedef float f32x2_t __attribute__((ext_vector_type(2)));
__device__ __forceinline__ unsigned pk2(float lo, float hi) { f32x2_t v = {lo, hi}; bf16x2_t b = __builtin_convertvector(v, bf16x2_t); return __builtin_bit_cast(unsigned, b); }
__device__ __forceinline__ float bf2f(bf16_t b) { return __builtin_bit_cast(float, (unsigned)b << 16); }
__device__ __forceinline__ float wave_sum(float v) {
#pragma unroll
    for (int o = 1; o < 64; o <<= 1) v += __shfl_xor(v, o);
    return v;
}
__device__ __forceinline__ float sigmoidf_(float x) { return __builtin_amdgcn_rcpf(1.0f + __builtin_amdgcn_exp2f(-LOG2E_C * x)); }
__device__ __forceinline__ float gelu_tanh(float v) { const float u = (-2.0f * 0.7978845608028654f * LOG2E_C) * (v + 0.044715f * v * v * v); return v * __builtin_amdgcn_rcpf(1.0f + __builtin_amdgcn_exp2f(u)); }
__device__ __forceinline__ float expm1_small(float x) { float p = 1.0f / 5040.0f; p = fmaf(p, x, 1.0f / 720.0f); p = fmaf(p, x, 1.0f / 120.0f); p = fmaf(p, x, 1.0f / 24.0f); p = fmaf(p, x, 1.0f / 6.0f); p = fmaf(p, x, 0.5f); p = fmaf(p, x, 1.0f); return p * x; }
#define LDS_FENCE() asm volatile("s_waitcnt lgkmcnt(0)" ::: "memory")
__device__ __forceinline__ int fresh_tid2(int wave_u) { int z = 0; asm volatile("" : "+v"(z)); int t = (wave_u << 6) | (int)__builtin_amdgcn_mbcnt_hi(~0u, __builtin_amdgcn_mbcnt_lo(~0u, (unsigned)z)); asm volatile("" : "+v"(t)); return t; }
__device__ __forceinline__ int fresh_tid() { int t = threadIdx.x; asm volatile("" : "+v"(t)); return t; }

struct EpiF32 {
    static constexpr bool PERM = false;
    float* O; int ldc;
    __device__ __forceinline__ void operator()(const f32x4 (&acc)[2][2][4][2], const pg8::Unit& u, int wr, int wc, int fr, int fq) const {
        const int row0 = u.pm * 256 + wr * 64 + fr, col0 = u.pn * 256 + wc * 32 + 4 * fq;
#pragma unroll
        for (int ai = 0; ai < 2; ++ai)
#pragma unroll
            for (int m = 0; m < 4; ++m) { float* rowp = O + (size_t)(row0 + ai * 128 + m * 16) * ldc + col0;
#pragma unroll
                for (int bj = 0; bj < 2; ++bj)
#pragma unroll
                    for (int n = 0; n < 2; ++n) *(f32x4*)(rowp + bj * 128 + n * 16) = acc[ai][bj][m][n]; }
    }
};
template <int ACT  > struct EpiBf16 {
    static constexpr bool PERM = true;
    bf16_t* O; int ldc; const float* bias;
    __device__ __forceinline__ void operator()(const f32x4 (&acc)[2][2][4][2], const pg8::Unit& u, int wr, int wc, int fr, int fq) const {
        const int row0 = u.pm * 256 + wr * 64 + fr, col0 = u.pn * 256 + wc * 32 + 8 * fq;
        f32x4 bv[2][2];
#pragma unroll
        for (int bj = 0; bj < 2; ++bj)
#pragma unroll
            for (int n = 0; n < 2; ++n) bv[bj][n] = (ACT == 2) ? *(const f32x4*)(bias + col0 + bj * 128 + 4 * n) : (f32x4){0.f, 0.f, 0.f, 0.f};
#pragma unroll
        for (int ai = 0; ai < 2; ++ai)
#pragma unroll
            for (int m = 0; m < 4; ++m) { bf16_t* rowp = O + (size_t)(row0 + ai * 128 + m * 16) * ldc + col0;
#pragma unroll
                for (int bj = 0; bj < 2; ++bj) { f32x4 v0 = acc[ai][bj][m][0] + bv[bj][0], v1 = acc[ai][bj][m][1] + bv[bj][1];
#pragma unroll
                    for (int e = 0; e < 4; ++e) {
                        if (ACT == 1) { const float a = fmaxf(v0[e], 0.f), b = fmaxf(v1[e], 0.f); v0[e] = a * a; v1[e] = b * b; }
                        if (ACT == 2) { v0[e] = gelu_tanh(v0[e]); v1[e] = gelu_tanh(v1[e]); } }
                    u32x4 w; w.x = pk2(v0[0], v0[1]); w.y = pk2(v0[2], v0[3]); w.z = pk2(v1[0], v1[1]); w.w = pk2(v1[2], v1[3]);
                    *(u32x4*)(rowp + bj * 128) = w; } }
    }
};
struct EpiZ {
    static constexpr bool PERM = true;
    unsigned char* ws;
    __device__ __forceinline__ void operator()(const f32x4 (&acc)[2][2][4][2], const pg8::Unit& u, int wr, int wc, int fr, int fq) const {
        const int row0 = u.pm * 256 + wr * 64 + fr, pn = u.pn;
        if (pn < 6) {
            bf16_t* base = (bf16_t*)(ws + (pn < 2 ? WS_GRNN : pn < 4 ? WS_XRNN : WS_Q)); const float sc = pn >= 4 ? 0.125f * LOG2E_C : 1.0f;
            const int col0 = (pn & 1) * 256 + wc * 32 + 8 * fq;
#pragma unroll
            for (int ai = 0; ai < 2; ++ai)
#pragma unroll
                for (int m = 0; m < 4; ++m) { bf16_t* rowp = base + (size_t)(row0 + ai * 128 + m * 16) * 512 + col0;
#pragma unroll
                    for (int bj = 0; bj < 2; ++bj) { const f32x4 v0 = acc[ai][bj][m][0] * sc, v1 = acc[ai][bj][m][1] * sc;
                        u32x4 w; w.x = pk2(v0[0], v0[1]); w.y = pk2(v0[2], v0[3]); w.z = pk2(v1[0], v1[1]); w.w = pk2(v1[2], v1[3]);
                        *(u32x4*)(rowp + bj * 128) = w; } }
        } else if (pn < 9) {
            const int p = pn - 6, g = wc >> 1, d0 = 32 * (wc & 1) + 8 * fq;
            bf16_t* Kb = (bf16_t*)(ws + WS_KV + (size_t)(2 * p) * KV_STRIDE); bf16_t* Vb = (bf16_t*)(ws + WS_KV + (size_t)(2 * p + 1) * KV_STRIDE);
#pragma unroll
            for (int ai = 0; ai < 2; ++ai)
#pragma unroll
                for (int m = 0; m < 4; ++m) { const int row = row0 + ai * 128 + m * 16, b = row >> 12, s = row & 4095;
                    { const f32x4 v0 = acc[ai][0][m][0], v1 = acc[ai][0][m][1];
                      u32x4 w; w.x = pk2(v0[0], v0[1]); w.y = pk2(v0[2], v0[3]); w.z = pk2(v1[0], v1[1]); w.w = pk2(v1[2], v1[3]);
                      *(u32x4*)(Kb + ((size_t)(b * 2 + g) * 4096 + s) * 64 + d0) = w; }
                    if (p == 0) { const f32x4 v0 = acc[ai][1][m][0], v1 = acc[ai][1][m][1];
                      u32x4 w; w.x = pk2(v0[0], v0[1]); w.y = pk2(v0[2], v0[3]); w.z = pk2(v1[0], v1[1]); w.w = pk2(v1[2], v1[3]);
                      *(u32x4*)(Vb + ((size_t)(b * 2 + g) * 4096 + s) * 64 + d0) = w; }
                    else { bf16_t* vp = Vb + ((size_t)(b * 2 + g) * 64 + d0) * 4096 + s;
#pragma unroll
                      for (int n = 0; n < 2; ++n)
#pragma unroll
                          for (int e = 0; e < 4; ++e) vp[(size_t)(4 * n + e) * 4096] = (bf16_t)f2bf(acc[ai][1][m][n][e]); } }
        } else {
            if (wc == 0 && fq < 3) { float* G = (float*)(ws + WS_GATE);
#pragma unroll
                for (int ai = 0; ai < 2; ++ai)
#pragma unroll
                    for (int m = 0; m < 4; ++m) { float* gp = G + (size_t)(row0 + ai * 128 + m * 16) * 24 + 8 * fq;
#pragma unroll
                        for (int n = 0; n < 2; ++n) { f32x4 v = acc[ai][0][m][n];
#pragma unroll
                            for (int e = 0; e < 4; ++e) v[e] = sigmoidf_(v[e]);
                            *(f32x4*)(gp + 4 * n) = v; } } }
        }
    }
};

#define XB_TMO      128
#define XB_XCNT(j)  (256  + 64 * (j))
#define XB_XSUB(j)  (1280 + 64 * (j))
#define XB_XGEN(j)  (2304 + 64 * (j))
#define XB_TOP      3328
#define XB_TOPGEN   3392
#define XCD_BAR_WORDS 3456
#define XB_SPIN_CAP (1u << 18)

__device__ __forceinline__ unsigned xb_ld(unsigned* p)              { return __hip_atomic_load(p, __ATOMIC_RELAXED, __HIP_MEMORY_SCOPE_AGENT); }
__device__ __forceinline__ unsigned xb_add(unsigned* p, unsigned v) { return __hip_atomic_fetch_add(p, v, __ATOMIC_RELAXED, __HIP_MEMORY_SCOPE_AGENT); }
__device__ __forceinline__ unsigned xb_xcc_id() { return (unsigned)__builtin_amdgcn_s_getreg((3 << 11) | 20) & 0xFu; }
#define XB_SPIN(cond, bar) do { unsigned _sp = 0; while (cond) { __builtin_amdgcn_s_sleep(1); \
    if ((++_sp & 255u) == 0u) { if (xb_ld(&(bar)[XB_TMO])) break; if (_sp > XB_SPIN_CAP) { atomicAdd(&(bar)[XB_TMO], 1u); break; } } } } while (0)

struct XcdBarrier {
    unsigned* bar; unsigned x;
    volatile LAS unsigned* st;
};

__device__ __forceinline__ XcdBarrier xcd_barrier_post(unsigned* bar, volatile LAS unsigned* st) {
    XcdBarrier b; b.bar = bar; b.x = xb_xcc_id(); b.st = st;
    if (threadIdx.x == 0) (void)xb_add(&bar[XB_XCNT(b.x)], 1u);
    return b;
}
__device__ __forceinline__ void xcd_barrier_complete(unsigned* bar, unsigned x, unsigned& nloc, unsigned& nx) {
    const unsigned G = gridDim.x * gridDim.y * gridDim.z;
    unsigned sum, cnt, mine, sp = 0u;
    for (;;) {
        sum = 0u; cnt = 0u; mine = 0u;
#pragma unroll
        for (unsigned j = 0; j < 16; ++j) { const unsigned c = xb_ld(&bar[XB_XCNT(j)]); sum += c; cnt += (c > 0u) ? 1u : 0u; mine = (j == x) ? c : mine; }
        if (sum == G) break;
        __builtin_amdgcn_s_sleep(1);
        if ((++sp & 255u) == 0u) { if (xb_ld(&bar[XB_TMO])) break; if (sp > XB_SPIN_CAP) { atomicAdd(&bar[XB_TMO], 1u); break; } }
    }
    nloc = mine > 0u ? mine : 1u; nx = cnt > 0u ? cnt : 1u;
}

__device__ __forceinline__ void xcd_barrier(const XcdBarrier& b) {
    asm volatile("s_waitcnt vmcnt(0)" ::: "memory");
    __syncthreads();
    if (threadIdx.x == 0) {
        unsigned* bar = b.bar;
        __builtin_amdgcn_s_waitcnt(0);
        unsigned nloc = b.st[0], nx = b.st[1];
        if (nloc == 0u) { xcd_barrier_complete(bar, b.x, nloc, nx); b.st[0] = nloc; b.st[1] = nx; }
        const unsigned old = xb_add(&bar[XB_XSUB(b.x)], 1u);
        const unsigned gen = old / nloc;
        if (old + 1u == (gen + 1u) * nloc) {
            __builtin_amdgcn_fence(__ATOMIC_RELEASE, "agent");
            asm volatile("s_waitcnt vmcnt(0)" ::: "memory");
            const unsigned og = xb_add(&bar[XB_TOP], 1u);
            const unsigned tg = og / nx;
            if (og + 1u == (tg + 1u) * nx) xb_add(&bar[XB_TOPGEN], 1u);
            else XB_SPIN(xb_ld(&bar[XB_TOPGEN]) == tg, bar);
            __builtin_amdgcn_fence(__ATOMIC_ACQUIRE, "agent");
            xb_add(&bar[XB_XGEN(b.x)], 1u);
            asm volatile("s_waitcnt vmcnt(0)" ::: "memory");
        } else {
            XB_SPIN(xb_ld(&bar[XB_XGEN(b.x)]) == gen, bar);
            __builtin_amdgcn_fence(__ATOMIC_ACQUIRE, "agent");
            asm volatile("s_waitcnt vmcnt(0)" ::: "memory");
        }
    }
    __syncthreads();
}


__device__ __forceinline__ void tr_item(const float* W, int K, int N, bf16_t* WT, int NT, const float* gA, const float* gB, LAS float* scr, int item, int lane) {
    const int nblk = NT / 64, kb = item / nblk, nb = item % nblk, k0 = 64 * kb, n0 = 64 * nb;
    const int nn = n0 + 4 * (lane & 15);
#pragma unroll 8
    for (int i = 0; i < 16; ++i) { const int kk = 4 * i + (lane >> 4), k = k0 + kk;
        f32x4 v = (nn < N) ? *(const f32x4*)(W + (size_t)k * N + nn) : (f32x4){0.f, 0.f, 0.f, 0.f};
        if (gA) v = v * ((k < 512) ? gA[k] : gB[k - 512]);
        LAS float* d = scr + kk * 65 + 4 * (lane & 15); d[0] = v.x; d[1] = v.y; d[2] = v.z; d[3] = v.w; }
    LDS_FENCE();
    const int c = lane & 7;
#pragma unroll
    for (int j = 0; j < 8; ++j) { const int n = (lane >> 3) + 8 * j; const LAS float* s = scr + (8 * c) * 65 + n;
        u32x4 o; o.x = pk2(s[0 * 65], s[1 * 65]); o.y = pk2(s[2 * 65], s[3 * 65]); o.z = pk2(s[4 * 65], s[5 * 65]); o.w = pk2(s[6 * 65], s[7 * 65]);
        *(u32x4*)(WT + (size_t)(n0 + n) * K + k0 + 8 * c) = o; }
    LDS_FENCE();
}
__device__ __forceinline__ void p0_mod_item(Frame& F, int item) {
    LAS float* sc = (LAS float*)F.lds; LAS float* red = (LAS float*)(F.lds + 32768);
    const float* c = F.in[1]; const float* ada_w = F.in[2]; const float* ada_b = F.in[3];
    for (int idx = F.tid; idx < 8192; idx += 512) { const float v = c[idx]; sc[idx] = v / (1.0f + __expf(-v)); }
    __syncthreads();
    float acc[8];
#pragma unroll
    for (int b = 0; b < 8; ++b) acc[b] = 0.f;
    const int kbase = 128 * F.wave; const float* wp = ada_w + (size_t)kbase * NMOD + 64 * item + F.lane;
#pragma unroll 8
    for (int kk = 0; kk < 128; ++kk) { const float wv = wp[(size_t)kk * NMOD];
#pragma unroll
        for (int b = 0; b < 8; ++b) acc[b] += sc[b * 1024 + kbase + kk] * wv; }
#pragma unroll
    for (int b = 0; b < 8; ++b) red[(F.wave * 8 + b) * 64 + F.lane] = acc[b];
    __syncthreads();
    { const int b = F.tid >> 6, col = F.tid & 63; float s = ada_b[64 * item + col];
#pragma unroll
      for (int w = 0; w < 8; ++w) s += red[(w * 8 + b) * 64 + col];
      ((float*)(F.ws + WS_MOD))[b * NMOD + 64 * item + col] = s; }
    __syncthreads();
}
__device__ __forceinline__ void p0_prologue(Frame& F) {
    for (int it = F.bid; it < NMOD / 64; it += F.G) p0_mod_item(F, it);
    LAS float* scr = (LAS float*)(F.lds + F.wave * 16640);
    const int nmb = (NMOD / 64 < F.G) ? NMOD / 64 : 0;
    const int gw = ((F.bid + F.G - nmb) % F.G) * 8 + F.wave, NGW = F.G * 8;
    constexpr int I_IN = 16 * (NZ / 64), I_OUT = 16 * 16, I_F1 = 16 * 64, I_F2 = 64 * 16, I_C1 = 32 * 4, I_C2 = 4 * 1, I_L = 1;
    constexpr int NTR = I_IN + I_OUT + I_F1 + I_F2 + 2 * I_C1 + 2 * I_C2 + 16 * I_L;
    constexpr int NITEMS = NTR + 128 + 8;
    unsigned char* ws = F.ws;
    for (int it = gw; it < NITEMS; it += NGW) {
        int r = it;
        if (r < I_IN) { tr_item(F.in[5], DM, 2328, (bf16_t*)(ws + WS_WINT), NZ, nullptr, nullptr, scr, r, F.lane); continue; } r -= I_IN;
        if (r < I_OUT) { tr_item(F.in[21], DM, DM, (bf16_t*)(ws + WS_WOUTT), DM, F.in[19], F.in[20], scr, r, F.lane); continue; } r -= I_OUT;
        if (r < I_F1) { tr_item(F.in[24], DM, DFF, (bf16_t*)(ws + WS_WFF1T), DFF, nullptr, nullptr, scr, r, F.lane); continue; } r -= I_F1;
        if (r < I_F2) { tr_item(F.in[25], DFF, DM, (bf16_t*)(ws + WS_WFF2T), DM, nullptr, nullptr, scr, r, F.lane); continue; } r -= I_F2;
        if (r < I_C1) { tr_item(F.in[14], 2048, 256, (bf16_t*)(ws + WS_CW1KT), 256, nullptr, nullptr, scr, r, F.lane); continue; } r -= I_C1;
        if (r < I_C1) { tr_item(F.in[17], 2048, 256, (bf16_t*)(ws + WS_CW1VT), 256, nullptr, nullptr, scr, r, F.lane); continue; } r -= I_C1;
        if (r < I_C2) { tr_item(F.in[15], 256, 64, (bf16_t*)(ws + WS_CW2KT), 64, nullptr, nullptr, scr, r, F.lane); continue; } r -= I_C2;
        if (r < I_C2) { tr_item(F.in[18], 256, 64, (bf16_t*)(ws + WS_CW2VT), 64, nullptr, nullptr, scr, r, F.lane); continue; } r -= I_C2;
        if (r < 8 * I_L) { const int n = r / I_L; tr_item(F.in[8] + n * 4096, 64, 64, (bf16_t*)(ws + WS_WAT) + n * 4096, 64, nullptr, nullptr, scr, r % I_L, F.lane); continue; } r -= 8 * I_L;
        if (r < 8 * I_L) { const int n = r / I_L; tr_item(F.in[10] + n * 4096, 64, 64, (bf16_t*)(ws + WS_WXT) + n * 4096, 64, nullptr, nullptr, scr, r % I_L, F.lane); continue; } r -= 8 * I_L;
        if (r < 128) {
            const int mat = r >> 6, cgp = (r >> 4) & 3, ks = r & 15; const float* pos = F.in[mat ? 16 : 13]; const float* w1 = F.in[mat ? 17 : 14];
            float a = 0.f; const int col = 64 * cgp + F.lane;
#pragma unroll 8
            for (int kk = 0; kk < 128; ++kk) { const int k = 128 * ks + kk; a += pos[k] * w1[(size_t)k * 256 + col]; }
            ((float*)(ws + WS_CB1P))[(mat * 16 + ks) * 256 + col] = a; continue; } r -= 128;
        { const int ch = 64 * r + F.lane; const float lam = F.in[12][ch]; ((float*)(ws + WS_LRUC))[ch] = -8.0f * log1pf(expf(-lam)); }
    }
}

__device__ __forceinline__ void p1_rows(Frame& F) {
    if (F.bid == 0) { const int mat = F.tid >> 8, col = F.tid & 255; float s = 0.f; const float* P = (const float*)(F.ws + WS_CB1P);
#pragma unroll
        for (int ks = 0; ks < 16; ++ks) s += P[(mat * 16 + ks) * 256 + col];
        ((float*)(F.ws + WS_CB1))[mat * 256 + col] = s; }
    const float* x = F.in[0]; const float* g = F.in[4]; const float* mod = (const float*)(F.ws + WS_MOD); bf16_t* H = (bf16_t*)(F.ws + WS_H);
    const int gw = F.bid * 8 + F.wave, NGW = F.G * 8;
    for (int rb = gw; rb < M / 16; rb += NGW) {
        const int b = (rb * 16) >> 12; f32x4 Gk[4], Sh[4];
#pragma unroll
        for (int j = 0; j < 4; ++j) { const int k = 4 * F.lane + 256 * j; const f32x4 gg = *(const f32x4*)(g + k), sc = *(const f32x4*)(mod + b * NMOD + 1024 + k);
            Gk[j] = gg * (sc + 1.0f); Sh[j] = *(const f32x4*)(mod + b * NMOD + k); }
        for (int rr = 0; rr < 16; ++rr) { const size_t row = (size_t)rb * 16 + rr; const f32x4* xr = (const f32x4*)(x + row * DM) + F.lane;
            f32x4 v[4]; float s = 0.f;
#pragma unroll
            for (int j = 0; j < 4; ++j) { v[j] = xr[64 * j]; s += (v[j].x * v[j].x + v[j].y * v[j].y) + (v[j].z * v[j].z + v[j].w * v[j].w); }
            const float rstd = rsqrtf(wave_sum(s) * (1.0f / DM) + EPS);
            unsigned long long* o8 = (unsigned long long*)(H + row * DM) + F.lane;
#pragma unroll
            for (int j = 0; j < 4; ++j) { const f32x4 h = v[j] * rstd * Gk[j] + Sh[j]; o8[64 * j] = (unsigned long long)pk2(h.x, h.y) | ((unsigned long long)pk2(h.z, h.w) << 32); } }
    }
}
__device__ __forceinline__ f32x4 ld_bf16x4(const bf16_t* p) { const u32x2 w = *(const u32x2*)p; return (f32x4){__builtin_bit_cast(float, w.x << 16), __builtin_bit_cast(float, w.x & 0xffff0000u), __builtin_bit_cast(float, w.y << 16), __builtin_bit_cast(float, w.y & 0xffff0000u)}; }
__device__ __forceinline__ void p7_rows(Frame& F) {
    const float* x = F.in[0]; const float* pnm = F.in[22]; const float* pre = F.in[23]; const float* mod = (const float*)(F.ws + WS_MOD);
    const bf16_t* Y = (const bf16_t*)(F.ws + WS_Y); bf16_t* H = (bf16_t*)(F.ws + WS_H);
    const int gw = F.bid * 8 + F.wave, NGW = F.G * 8;
    for (int rb = gw; rb < M / 16; rb += NGW) {
        const int b = (rb * 16) >> 12; f32x4 A1[4], G2[4], S2[4];
#pragma unroll
        for (int j = 0; j < 4; ++j) { const int k = 4 * F.lane + 256 * j;
            A1[j] = *(const f32x4*)(pnm + k) * (*(const f32x4*)(mod + b * NMOD + 2048 + k) + 1.0f);
            G2[j] = *(const f32x4*)(pre + k) * (*(const f32x4*)(mod + b * NMOD + 4096 + k) + 1.0f);
            S2[j] = *(const f32x4*)(mod + b * NMOD + 3072 + k); }
#pragma unroll 2
        for (int rr = 0; rr < 16; ++rr) { const size_t row = (size_t)rb * 16 + rr;
            const f32x4* xr = (const f32x4*)(x + row * DM) + F.lane; const bf16_t* yr = Y + row * DM + 4 * F.lane;
            f32x4 xv[4], yv[4]; float s = 0.f;
#pragma unroll
            for (int j = 0; j < 4; ++j) { xv[j] = xr[64 * j]; yv[j] = ld_bf16x4(yr + 256 * j); s += (yv[j].x * yv[j].x + yv[j].y * yv[j].y) + (yv[j].z * yv[j].z + yv[j].w * yv[j].w); }
            const float rstd = rsqrtf(wave_sum(s) * (1.0f / DM) + EPS); float s2 = 0.f;
#pragma unroll
            for (int j = 0; j < 4; ++j) { xv[j] = xv[j] + A1[j] * (yv[j] * rstd); s2 += (xv[j].x * xv[j].x + xv[j].y * xv[j].y) + (xv[j].z * xv[j].z + xv[j].w * xv[j].w); }
            const float rstd2 = rsqrtf(wave_sum(s2) * (1.0f / DM) + EPS);
            unsigned long long* o8 = (unsigned long long*)(H + row * DM) + F.lane;
#pragma unroll
            for (int j = 0; j < 4; ++j) { const f32x4 h = xv[j] * rstd2 * G2[j] + S2[j]; o8[64 * j] = (unsigned long long)pk2(h.x, h.y) | ((unsigned long long)pk2(h.z, h.w) << 32); } }
    }
}
__device__ __forceinline__ void p10_rows(Frame& F, float* out) {
    const float* x = F.in[0]; const float* pnm1 = F.in[22]; const float* pnm2 = F.in[26]; const float* mod = (const float*)(F.ws + WS_MOD);
    const bf16_t* Y = (const bf16_t*)(F.ws + WS_Y); const bf16_t* Y2 = (const bf16_t*)(F.ws + WS_Y2);
    const int gw = F.bid * 8 + F.wave, NGW = F.G * 8;
    for (int rb = gw; rb < M / 16; rb += NGW) {
        const int b = (rb * 16) >> 12; f32x4 A1[4], A2[4];
#pragma unroll
        for (int j = 0; j < 4; ++j) { const int k = 4 * F.lane + 256 * j;
            A1[j] = *(const f32x4*)(pnm1 + k) * (*(const f32x4*)(mod + b * NMOD + 2048 + k) + 1.0f);
            A2[j] = *(const f32x4*)(pnm2 + k) * (*(const f32x4*)(mod + b * NMOD + 5120 + k) + 1.0f); }
#pragma unroll 2
        for (int rr = 0; rr < 16; ++rr) { const size_t row = (size_t)rb * 16 + rr;
            const f32x4* xr = (const f32x4*)(x + row * DM) + F.lane; const bf16_t* yr = Y + row * DM + 4 * F.lane; const bf16_t* y2r = Y2 + row * DM + 4 * F.lane;
            f32x4 xv[4], yv[4], zv[4]; float s = 0.f, s2 = 0.f;
#pragma unroll
            for (int j = 0; j < 4; ++j) { xv[j] = xr[64 * j]; yv[j] = ld_bf16x4(yr + 256 * j); zv[j] = ld_bf16x4(y2r + 256 * j);
                s += (yv[j].x * yv[j].x + yv[j].y * yv[j].y) + (yv[j].z * yv[j].z + yv[j].w * yv[j].w); s2 += (zv[j].x * zv[j].x + zv[j].y * zv[j].y) + (zv[j].z * zv[j].z + zv[j].w * zv[j].w); }
            const float rstd = rsqrtf(wave_sum(s) * (1.0f / DM) + EPS), rstd2 = rsqrtf(wave_sum(s2) * (1.0f / DM) + EPS);
            f32x4* orow = (f32x4*)(out + row * DM) + F.lane;
#pragma unroll
            for (int j = 0; j < 4; ++j) orow[64 * j] = (xv[j] + A1[j] * (yv[j] * rstd)) + A2[j] * (zv[j] * rstd2); }
    }
}

constexpr int RNN_WL = 11264, RNN_PART_OFF = 8 * RNN_WL;
template <int PASS> __device__ __forceinline__ void rnn_item(Frame& F, int b, int chunk) {
    const int n = F.wave, lane = F.lane, ch = 64 * n + lane, fr = lane & 15, fq = lane >> 4;
    LAS unsigned char* wl = F.lds + n * RNN_WL;
    LAS bf16_t* xcb = (LAS bf16_t*)wl; LAS float* Ab = (LAS float*)(wl + 2304); LAS float* Gb = (LAS float*)(wl + 6656);
    LAS float* part = (LAS float*)(F.lds + RNN_PART_OFF);
    const float* conv_w = F.in[6]; const float cw0 = conv_w[ch], cw1 = conv_w[512 + ch], cw2 = conv_w[1024 + ch], cw3 = conv_w[1536 + ch], cb = F.in[7][ch];
    const bf16_t* WA = (const bf16_t*)(F.ws + WS_WAT) + n * 4096; const bf16_t* WX = (const bf16_t*)(F.ws + WS_WXT) + n * 4096;
    bf16x8 waf[4][2], wxf[4][2];
    if (PASS == 1) {
#pragma unroll
        for (int nb = 0; nb < 4; ++nb) {
#pragma unroll
            for (int ks = 0; ks < 2; ++ks) { waf[nb][ks] = *(const bf16x8*)(WA + (16 * nb + fr) * 64 + 32 * ks + 8 * fq); wxf[nb][ks] = *(const bf16x8*)(WX + (16 * nb + fr) * 64 + 32 * ks + 8 * fq); } } }
    const float* pba = F.in[9] + 64 * n + 4 * fq; const float* pbx = F.in[11] + 64 * n + 4 * fq; const float* plc = (const float*)(F.ws + WS_LRUC) + 64 * n + 4 * fq;
    const bf16_t* XR = (const bf16_t*)(F.ws + WS_XRNN); const bf16_t* GR = (const bf16_t*)(F.ws + WS_GRNN); bf16_t* YC = (bf16_t*)(F.ws + WS_YCAT);
    unsigned* RG = (unsigned*)(F.ws + WS_RG);
    const int t0 = chunk * 64; const size_t rowbase = (size_t)b * SEQ;
    float xm3 = 0.f, xm2 = 0.f, xm1 = 0.f;
    if (chunk > 0) { xm3 = bf2f(XR[(rowbase + t0 - 3) * 512 + ch]); xm2 = bf2f(XR[(rowbase + t0 - 2) * 512 + ch]); xm1 = bf2f(XR[(rowbase + t0 - 1) * 512 + ch]); }
    float h = 0.f, ap = 1.f;
    float* RA = (float*)(F.ws + WS_RA); float* RH = (float*)(F.ws + WS_RH);
    if (PASS == 2) h = ((const float*)(F.ws + WS_RHIN))[(size_t)(b * 64 + chunk) * 512 + ch];
    bf16_t xnext[16], gnext[16]; unsigned rgnext[16];
#pragma unroll
    for (int tt = 0; tt < 16; ++tt) { xnext[tt] = XR[(rowbase + t0 + tt) * 512 + ch];
        gnext[tt] = (PASS == 2) ? GR[(rowbase + t0 + tt) * 512 + ch] : (bf16_t)0; rgnext[tt] = (PASS == 2) ? RG[(rowbase + t0 + tt) * 512 + ch] : 0u; }
    for (int sub = 0; sub < 4; ++sub) {
        float xc[16]; const size_t r0 = rowbase + t0 + 16 * sub;
        bf16_t xcur[16], gcur[16]; unsigned rgcur[16];
#pragma unroll
        for (int tt = 0; tt < 16; ++tt) { xcur[tt] = xnext[tt]; gcur[tt] = gnext[tt]; rgcur[tt] = rgnext[tt]; }
        if (sub < 3) {
#pragma unroll
            for (int tt = 0; tt < 16; ++tt) { xnext[tt] = XR[(r0 + 16 + tt) * 512 + ch]; if (PASS == 2) { gnext[tt] = GR[(r0 + 16 + tt) * 512 + ch]; rgnext[tt] = RG[(r0 + 16 + tt) * 512 + ch]; } } }
#pragma unroll
        for (int tt = 0; tt < 16; ++tt) { const float xv = bf2f(xcur[tt]); xc[tt] = cb + cw0 * xm3 + cw1 * xm2 + cw2 * xm1 + cw3 * xv; xm3 = xm2; xm2 = xm1; xm1 = xv;
            if (PASS == 1) xcb[tt * 72 + lane] = (bf16_t)f2bf(xc[tt]); }
        float y[16];
        if (PASS == 1) {
            LDS_FENCE();
            bf16x8 xb[2];
#pragma unroll
            for (int ks = 0; ks < 2; ++ks) xb[ks] = *(const LAS bf16x8*)(xcb + fr * 72 + 32 * ks + 8 * fq);
            asm volatile("" : "+v"(pba), "+v"(pbx), "+v"(plc));
#pragma unroll
            for (int nb = 0; nb < 4; ++nb) { f32x4 aA = {0.f, 0.f, 0.f, 0.f}, aX = {0.f, 0.f, 0.f, 0.f};
                const f32x4 ba4n = *(const f32x4*)(pba + 16 * nb), bx4n = *(const f32x4*)(pbx + 16 * nb), lc4n = *(const f32x4*)(plc + 16 * nb);
#pragma unroll
                for (int ks = 0; ks < 2; ++ks) { aA = __builtin_amdgcn_mfma_f32_16x16x32_bf16(waf[nb][ks], xb[ks], aA, 0, 0, 0); aX = __builtin_amdgcn_mfma_f32_16x16x32_bf16(wxf[nb][ks], xb[ks], aX, 0, 0, 0); }
                f32x4 av, gv; u32x4 pk;
#pragma unroll
                for (int e = 0; e < 4; ++e) { const float rr = sigmoidf_(aA[e] + ba4n[e]), ii = sigmoidf_(aX[e] + bx4n[e]); const float la = lc4n[e] * rr;
                    const float em1 = expm1_small(la); av[e] = 1.0f + em1; gv[e] = __builtin_amdgcn_sqrtf(fmaxf(-em1 * (2.0f + em1), 0.f)) * ii; pk[e] = pk2(la, gv[e]); }
                *(LAS f32x4*)(Ab + fr * 68 + 16 * nb + 4 * fq) = av; *(LAS f32x4*)(Gb + fr * 68 + 16 * nb + 4 * fq) = gv;
                *(u32x4*)(RG + (r0 + fr) * 512 + 64 * n + 16 * nb + 4 * fq) = pk; }
            LDS_FENCE();
#pragma unroll
            for (int tt = 0; tt < 16; ++tt) { const float a = Ab[tt * 68 + lane], gg = Gb[tt * 68 + lane]; h = a * h + gg * xc[tt]; ap *= a; }
            LDS_FENCE();
        } else {
#pragma unroll
            for (int tt = 0; tt < 16; ++tt) { const float la = __builtin_bit_cast(float, rgcur[tt] << 16), gg = __builtin_bit_cast(float, rgcur[tt] & 0xffff0000u);
                const float a = 1.0f + expm1_small(la); h = a * h + gg * xc[tt]; y[tt] = h * gelu_tanh(bf2f(gcur[tt])); }
#pragma unroll
            for (int tt = 0; tt < 16; ++tt) Ab[tt * 68 + lane] = y[tt] * y[tt];
            LDS_FENCE();
            { const LAS float* rp = Ab + fr * 68 + 16 * fq; const f32x4 a0 = *(const LAS f32x4*)(rp), a1 = *(const LAS f32x4*)(rp + 4), a2 = *(const LAS f32x4*)(rp + 8), a3 = *(const LAS f32x4*)(rp + 12);
              float v = ((a0.x + a0.y) + (a0.z + a0.w)) + ((a1.x + a1.y) + (a1.z + a1.w)) + ((a2.x + a2.y) + (a2.z + a2.w)) + ((a3.x + a3.y) + (a3.z + a3.w));
              v += __shfl_xor(v, 16); v += __shfl_xor(v, 32);
              if (lane < 16) part[((sub & 1) * 8 + n) * 16 + lane] = v; }
            __syncthreads();
#pragma unroll
            for (int tt = 0; tt < 16; ++tt) { float tot = 0.f;
#pragma unroll
                for (int w = 0; w < 8; ++w) tot += part[((sub & 1) * 8 + w) * 16 + tt];
                const float rstd = rsqrtf(tot * (1.0f / 512.0f) + EPS);
                YC[(r0 + tt) * 1024 + ch] = (bf16_t)f2bf(y[tt] * rstd); }
        }
    }
    if (PASS == 1) { const size_t o = (size_t)(b * 64 + chunk) * 512 + ch; RA[o] = ap; RH[o] = h; }
    if (PASS == 2) __syncthreads();
}

__device__ __forceinline__ void cmp2_item(Frame& F, int item) {
    const int mat = item >> 8, rb = item & 255, lane = F.lane, fr = lane & 15, fq = lane >> 4;
    const int R0 = 16 * rb + fr, R1 = ((R0 & 255) < 255) ? R0 + 1 : R0;
    const bf16_t* P = (const bf16_t*)(F.ws + WS_CP) + (size_t)mat * 4 * 4096 * 512; const float* cb = (const float*)(F.ws + WS_CB1) + mat * 256;
    const bf16_t* W2 = (const bf16_t*)(F.ws + (mat ? WS_CW2VT : WS_CW2KT)) + (size_t)fr * 256 + 8 * fq;
    f32x4 acc[4];
#pragma unroll
    for (int nb = 0; nb < 4; ++nb) acc[nb] = (f32x4){0.f, 0.f, 0.f, 0.f};
#pragma unroll 4
    for (int ks = 0; ks < 8; ++ks) { const int n0 = 32 * ks + 8 * fq;
        f32x4 h0 = *(const f32x4*)(cb + n0), h1 = *(const f32x4*)(cb + n0 + 4);
#pragma unroll
        for (int k4 = 0; k4 < 4; ++k4) { const u32x4 a = *(const u32x4*)(P + ((size_t)k4 * 4096 + R0) * 512 + n0), c = *(const u32x4*)(P + ((size_t)k4 * 4096 + R1) * 512 + 256 + n0);
            h0 += (f32x4){__builtin_bit_cast(float, a.x << 16), __builtin_bit_cast(float, a.x & 0xffff0000u), __builtin_bit_cast(float, a.y << 16), __builtin_bit_cast(float, a.y & 0xffff0000u)}
                + (f32x4){__builtin_bit_cast(float, c.x << 16), __builtin_bit_cast(float, c.x & 0xffff0000u), __builtin_bit_cast(float, c.y << 16), __builtin_bit_cast(float, c.y & 0xffff0000u)};
            h1 += (f32x4){__builtin_bit_cast(float, a.z << 16), __builtin_bit_cast(float, a.z & 0xffff0000u), __builtin_bit_cast(float, a.w << 16), __builtin_bit_cast(float, a.w & 0xffff0000u)}
                + (f32x4){__builtin_bit_cast(float, c.z << 16), __builtin_bit_cast(float, c.z & 0xffff0000u), __builtin_bit_cast(float, c.w << 16), __builtin_bit_cast(float, c.w & 0xffff0000u)}; }
        u32x4 hw; hw.x = pk2(gelu_tanh(h0[0]), gelu_tanh(h0[1])); hw.y = pk2(gelu_tanh(h0[2]), gelu_tanh(h0[3])); hw.z = pk2(gelu_tanh(h1[0]), gelu_tanh(h1[1])); hw.w = pk2(gelu_tanh(h1[2]), gelu_tanh(h1[3]));
        const bf16x8 hb = __builtin_bit_cast(bf16x8, hw);
#pragma unroll
        for (int nb = 0; nb < 4; ++nb) { const bf16x8 wf = *(const bf16x8*)(W2 + (size_t)(16 * nb) * 256 + 32 * ks); acc[nb] = __builtin_amdgcn_mfma_f32_16x16x32_bf16(wf, hb, acc[nb], 0, 0, 0); } }
    const int R = 16 * rb + fr;
    if (mat == 0) { bf16_t* O = (bf16_t*)(F.ws + WS_KCMP) + (size_t)R * 64 + 4 * fq;
#pragma unroll
        for (int nb = 0; nb < 4; ++nb) { u32x2 w; w.x = pk2(acc[nb][0], acc[nb][1]); w.y = pk2(acc[nb][2], acc[nb][3]); *(u32x2*)(O + 16 * nb) = w; }
    } else { const int bg = R >> 8, c = R & 255; bf16_t* O = (bf16_t*)(F.ws + WS_VCMPT) + (size_t)bg * 64 * 256 + c;
#pragma unroll
        for (int nb = 0; nb < 4; ++nb)
#pragma unroll
            for (int e = 0; e < 4; ++e) O[(size_t)(16 * nb + 4 * fq + e) * 256] = (bf16_t)f2bf(acc[nb][e]); }
}

constexpr int AT_BUF = 35840, AT_K1 = 9216, AT_V0 = 18432, AT_V1 = 27136, AT_IMP = 2 * AT_BUF, AT_IMP_BYTES = 8 * 32 * 65 * 4;
constexpr int AT_SELM = AT_IMP + AT_IMP_BYTES, AT_UNION = AT_SELM + 512, AT_SSQ = AT_UNION + 16, AT_SC = AT_SSQ + 1024;
static_assert(AT_SC + 4096 <= LDS_MISC, "attention LDS map");
__device__ __forceinline__ unsigned cvtpk(float lo, float hi) { f32x2_t v = {lo, hi}; bf16x2_t b = __builtin_convertvector(v, bf16x2_t); return __builtin_bit_cast(unsigned, b); }
__device__ __forceinline__ float xor32(float x, int hi) { auto rr = __builtin_amdgcn_permlane32_swap(__builtin_bit_cast(unsigned, x), __builtin_bit_cast(unsigned, x), false, false);
    return __builtin_bit_cast(float, hi ? rr[0] : rr[1]); }
struct TileSrc { const bf16_t* k0; const bf16_t* k1; const bf16_t* v0; const bf16_t* v1; };
__device__ __forceinline__ void at_load(u32x4 (&st)[4], const TileSrc& s, int vpitch, int tid) {
    st[0] = *(const u32x4*)(s.k0 + tid * 8); st[1] = *(const u32x4*)(s.k1 + tid * 8);
    const int dim = tid >> 3, part = tid & 7;
    st[2] = *(const u32x4*)(s.v0 + (size_t)dim * vpitch + part * 8); st[3] = *(const u32x4*)(s.v1 + (size_t)dim * vpitch + part * 8);
}
__device__ __forceinline__ void at_store(LAS unsigned char* buf, const u32x4 (&st)[4], int tid) {
    const int key = tid >> 3, part = tid & 7;
    *(LAS u32x4*)(buf + key * 144 + part * 16) = st[0];
    *(LAS u32x4*)(buf + AT_K1 + key * 144 + part * 16) = st[1];
    LAS unsigned char* v0 = buf + AT_V0 + key * 136 + part * 16; LAS unsigned char* v1 = buf + AT_V1 + key * 136 + part * 16;
    *(LAS u32x2*)(v0) = (u32x2){st[2].x, st[2].y}; *(LAS u32x2*)(v0 + 8) = (u32x2){st[2].z, st[2].w};
    *(LAS u32x2*)(v1) = (u32x2){st[3].x, st[3].y}; *(LAS u32x2*)(v1 + 8) = (u32x2){st[3].z, st[3].w};
}
__device__ __forceinline__ void at_qk(f32x16 (&s)[2], const LAS unsigned char* kb, const bf16x8 (&qf)[4], const bf16x8 qx, const bf16x8 (&kx)[2], int r32, int hi) {
    bf16x8 kf[2][4];
#pragma unroll
    for (int kb2 = 0; kb2 < 2; ++kb2)
#pragma unroll
        for (int ks = 0; ks < 4; ++ks) kf[kb2][ks] = *(const LAS bf16x8*)(kb + (32 * kb2 + r32) * 144 + (16 * ks + 8 * hi) * 2);
    __builtin_amdgcn_sched_barrier(0);
    f32x16 a0 = {}, a1 = {};
    a0 = __builtin_amdgcn_mfma_f32_32x32x16_bf16(kx[0], qx, a0, 0, 0, 0);
    a1 = __builtin_amdgcn_mfma_f32_32x32x16_bf16(kx[1], qx, a1, 0, 0, 0);
#pragma unroll
    for (int ks = 0; ks < 4; ++ks) { a0 = __builtin_amdgcn_mfma_f32_32x32x16_bf16(kf[0][ks], qf[ks], a0, 0, 0, 0); a1 = __builtin_amdgcn_mfma_f32_32x32x16_bf16(kf[1][ks], qf[ks], a1, 0, 0, 0); }
    s[0] = a0; s[1] = a1;
    __builtin_amdgcn_sched_barrier(0);
}
template <int MASK  >
__device__ __forceinline__ void at_keymask(f32x16 (&s)[2], int lim, int hi) {
    if (MASK) { const int limh = lim - 4 * hi;
#pragma unroll
        for (int kb2 = 0; kb2 < 2; ++kb2)
#pragma unroll
            for (int r = 0; r < 16; ++r) { const int kc = 32 * kb2 + (r & 3) + 8 * (r >> 2); const bool ok = (MASK == 1) ? (kc <= limh) : (kc >= limh); s[kb2][r] = ok ? s[kb2][r] : NEGF; } }
}
__device__ __forceinline__ float at_max(const f32x16 (&s)[2], int hi) {
    float mx = fmaxf(s[0][0], s[1][0]);
#pragma unroll
    for (int r = 1; r < 16; ++r) mx = fmaxf(fmaxf(mx, s[0][r]), s[1][r]);
    return fmaxf(mx, xor32(mx, hi));
}
__device__ __forceinline__ void at_pv(f32x16 (&O)[2], const LAS unsigned char* vb, const f32x16 (&p)[2], int r32, int hi) {
    u32x2 vlo[2][2][2], vhi[2][2][2];
#pragma unroll
    for (int kb2 = 0; kb2 < 2; ++kb2)
#pragma unroll
        for (int s2 = 0; s2 < 2; ++s2)
#pragma unroll
            for (int db = 0; db < 2; ++db) { const LAS unsigned char* va = vb + (32 * db + r32) * 136 + (32 * kb2 + 16 * s2 + 4 * hi) * 2;
                vlo[kb2][s2][db] = *(const LAS u32x2*)(va); vhi[kb2][s2][db] = *(const LAS u32x2*)(va + 16); }
    bf16x8 pf[2][2];
#pragma unroll
    for (int kb2 = 0; kb2 < 2; ++kb2)
#pragma unroll
        for (int s2 = 0; s2 < 2; ++s2) { u32x4 pw; pw.x = cvtpk(p[kb2][8 * s2 + 0], p[kb2][8 * s2 + 1]); pw.y = cvtpk(p[kb2][8 * s2 + 2], p[kb2][8 * s2 + 3]); pw.z = cvtpk(p[kb2][8 * s2 + 4], p[kb2][8 * s2 + 5]); pw.w = cvtpk(p[kb2][8 * s2 + 6], p[kb2][8 * s2 + 7]);
            pf[kb2][s2] = __builtin_bit_cast(bf16x8, pw); }
    __builtin_amdgcn_sched_barrier(0);
#pragma unroll
    for (int kb2 = 0; kb2 < 2; ++kb2)
#pragma unroll
        for (int s2 = 0; s2 < 2; ++s2)
#pragma unroll
            for (int db = 0; db < 2; ++db) { const bf16x8 vf = __builtin_bit_cast(bf16x8, (u32x4){vlo[kb2][s2][db].x, vlo[kb2][s2][db].y, vhi[kb2][s2][db].x, vhi[kb2][s2][db].y});
                O[db] = __builtin_amdgcn_mfma_f32_32x32x16_bf16(vf, pf[kb2][s2], O[db], 0, 0, 0); }
    __builtin_amdgcn_sched_barrier(0);
}
__device__ __forceinline__ void at_online(int mode, f32x16 (&s)[2], float& m, float& l, f32x16 (&O)[2], const LAS unsigned char* vb, float ctile, bool rowok, int lim, int r32, int hi) {
    if (mode == 1) at_keymask<1>(s, lim, hi); else if (mode == 2) at_keymask<2>(s, lim, hi);
    const float tmx = at_max(s, hi); const float mt = rowok ? tmx + ctile : NEGF; const float mn = fmaxf(m, mt);
    if (__any(mn > m)) { const float f = __builtin_amdgcn_exp2f(m - mn); l *= f;
#pragma unroll
        for (int db = 0; db < 2; ++db)
#pragma unroll
            for (int r = 0; r < 16; ++r) O[db][r] *= f; }
    m = mn;
    const float shift = rowok ? mn - ctile : __builtin_inff(); float ps = 0.f;
#pragma unroll
    for (int kb2 = 0; kb2 < 2; ++kb2)
#pragma unroll
        for (int r = 0; r < 16; ++r) { const float p = __builtin_amdgcn_exp2f(s[kb2][r] - shift); s[kb2][r] = p; ps += p; }
    l += ps;
    at_pv(O, vb, s, r32, hi);
}

__device__ __forceinline__ void attn_item(Frame& F, int b, int i) {
    const int tid = F.tid, lane = F.lane, h = F.wave, g = h >> 2, r32 = lane & 31, hi = lane >> 5;
    const int q0 = 32 * i, tq = q0 + r32; const size_t row = (size_t)b * SEQ + tq;
    LAS unsigned char* lds = F.lds;
    LAS float* IMP = (LAS float*)(lds + AT_IMP); LAS unsigned long long* SELM = (LAS unsigned long long*)(lds + AT_SELM);
    LAS unsigned* UNI = (LAS unsigned*)(lds + AT_UNION); LAS float* SSQ = (LAS float*)(lds + AT_SSQ); LAS float* SC = (LAS float*)(lds + AT_SC);
    const bf16_t* Qp = (const bf16_t*)(F.ws + WS_Q) + row * 512 + h * 64 + 8 * hi;
    bf16x8 qf[4];
#pragma unroll
    for (int ks = 0; ks < 4; ++ks) qf[ks] = *(const bf16x8*)(Qp + 16 * ks);
    const float slope2 = __builtin_amdgcn_exp2f(-(float)(h + 1)) * LOG2E;
    bf16x8 qx, qx16, kx[2];
    { const unsigned s_hi = f2bf(slope2); const float rem = slope2 - __builtin_bit_cast(float, s_hi << 16); const unsigned w1 = hi ? 0u : (s_hi | (f2bf(rem) << 16));
      const float sl16 = 16.0f * slope2; const unsigned t_hi = f2bf(sl16); const float rem16 = sl16 - __builtin_bit_cast(float, t_hi << 16); const unsigned w16 = hi ? 0u : (t_hi | (f2bf(rem16) << 16));
      qx = __builtin_bit_cast(bf16x8, (u32x4){w1, 0u, 0u, 0u}); qx16 = __builtin_bit_cast(bf16x8, (u32x4){w16, 0u, 0u, 0u});
#pragma unroll
      for (int kb2 = 0; kb2 < 2; ++kb2) { const unsigned kk = f2bf((float)(32 * kb2 + r32)); kx[kb2] = __builtin_bit_cast(bf16x8, (u32x4){hi ? 0u : (kk | (kk << 16)), 0u, 0u, 0u}); } }
    const float* GT = (const float*)(F.ws + WS_GATE) + row * 24; const float gate_c = GT[h], gate_s = GT[8 + h], gate_w = GT[16 + h];
    f32x16 out[2]; out[0] = f32x16{}; out[1] = f32x16{};
    if (tid < 4) UNI[tid] = 0u;
    const int koff = g ? AT_K1 : 0, voff = g ? AT_V1 : AT_V0;
    const size_t bg0 = (size_t)b * 2;
    u32x4 st[4];
    const bf16_t* KVb = (const bf16_t*)(F.ws + WS_KV);
    const int jhi = q0 >> 6, dlim = tq - 64 * jhi;
#define KV_SRC(kidx, j) TileSrc{KVb + (size_t)(kidx) * (KV_STRIDE / 2) + ((bg0 + 0) * 4096 + 64 * (j)) * 64, KVb + (size_t)(kidx) * (KV_STRIDE / 2) + ((bg0 + 1) * 4096 + 64 * (j)) * 64, \
        KVb + (size_t)((kidx) + 1) * (KV_STRIDE / 2) + (bg0 + 0) * 64 * 4096 + 64 * (j), KVb + (size_t)((kidx) + 1) * (KV_STRIDE / 2) + (bg0 + 1) * 64 * 4096 + 64 * (j)}
    const bf16_t* KC = (const bf16_t*)(F.ws + WS_KCMP); const bf16_t* VC = (const bf16_t*)(F.ws + WS_VCMPT);
    const int nc = (i >> 5) + 1;
#define CMP_SRC(jc) TileSrc{KC + ((bg0 + 0) * 256 + 64 * (jc)) * 64, KC + ((bg0 + 1) * 256 + 64 * (jc)) * 64, VC + (bg0 + 0) * 64 * 256 + 64 * (jc), VC + (bg0 + 1) * 64 * 256 + 64 * (jc)}
    float m = NEGF, l = 0.f;
    {
        f32x16 O[2]; O[0] = f32x16{}; O[1] = f32x16{}; float carry = 0.f; float mref[4] = {0.f, 0.f, 0.f, 0.f};
        { at_load(st, CMP_SRC(0), 256, tid); at_store(lds, st, tid); __syncthreads(); }
#pragma unroll
        for (int jc = 0; jc < 4; ++jc) { if (jc < nc) {
            LAS unsigned char* buf = lds + (jc & 1) * AT_BUF; const bool more = jc + 1 < nc;
            if (more) at_load(st, CMP_SRC(jc + 1), 256, tid); else at_load(st, KV_SRC(2, jhi), 4096, tid);
            f32x16 s[2]; at_qk(s, buf + koff, qf, qx16, kx, r32, hi);
            const float mprev = m;
            at_online((jc + 2 >= nc) ? 1 : 0, s, m, l, O, buf + voff, slope2 * (float)(1024 * jc + 31 - tq), true, ((tq - 31) >> 4) - 64 * jc, r32, hi);
            mref[jc] = m; carry *= __builtin_amdgcn_exp2f(mprev - m);
            float sum4[8], recv[8];
#pragma unroll
            for (int g8 = 0; g8 < 8; ++g8) { const int kb2 = g8 >> 2, qq = g8 & 3; sum4[g8] = (s[kb2][4 * qq] + s[kb2][4 * qq + 1]) + (s[kb2][4 * qq + 2] + s[kb2][4 * qq + 3]); recv[g8] = xor32(s[kb2][4 * qq + 3], hi); }
#pragma unroll
            for (int g8 = 0; g8 < 8; ++g8) { const float extra = hi ? recv[g8] : (g8 ? recv[g8 > 0 ? g8 - 1 : 0] : carry);
                IMP[(h * 32 + r32) * 65 + 16 * jc + 2 * g8 + hi] = sum4[g8] + extra; }
            carry = recv[7];
            if (more) at_store(lds + ((jc + 1) & 1) * AT_BUF, st, tid);
            __syncthreads();
        } }
        const float ltot = l + xor32(l, hi); const float inv = (tq >= 31) ? __builtin_amdgcn_rcpf(ltot) : 0.f;
        if (hi == 0) {
#pragma unroll
            for (int jc = 0; jc < 4; ++jc) SC[(h * 32 + r32) * 4 + jc] = (jc < nc) ? __builtin_amdgcn_exp2f(mref[jc] - m) * inv : 0.f; }
        const float oc = gate_c * inv;
#pragma unroll
        for (int db = 0; db < 2; ++db)
#pragma unroll
            for (int r = 0; r < 16; ++r) out[db][r] = oc * O[db][r];
        __syncthreads();
    }
#undef CMP_SRC
    LAS float* PARK = (LAS float*)(lds + AT_IMP) + (size_t)h * 2048 + lane;
    {
        unsigned long long un0 = 0ull, un1 = 0ull;
        for (int pp = 0; pp < 8; ++pp) { const int g2 = pp >> 2, q = 4 * h + (pp & 3), t = q0 + q, cur_t = t >> 6;
            float v = 0.f;
#pragma unroll
            for (int hh = 0; hh < 4; ++hh) v += IMP[((4 * g2 + hh) * 32 + q) * 65 + lane] * SC[((4 * g2 + hh) * 32 + q) * 4 + (lane >> 4)];
            const bool forced = (lane == 0) || (lane == cur_t) || (lane == cur_t - 1), vis = lane <= cur_t;
            const unsigned key = forced ? (0x7f000000u | (unsigned)(63 - lane)) : (vis ? ((__builtin_bit_cast(unsigned, v) & ~63u) | (unsigned)(63 - lane)) : 0u);
            int rank = 0;
            if (cur_t >= 16) {
#pragma unroll
                for (int jj = 0; jj < 64; ++jj) { const unsigned o = (unsigned)__builtin_amdgcn_readlane((int)key, jj); rank += (o > key) ? 1 : 0; } }
            const unsigned long long mask = __ballot((rank < 16) && vis);
            if (lane == 0) SELM[g2 * 32 + q] = mask;
            if (g2) un1 |= mask; else un0 |= mask; }
        if (lane == 0) { atomicOr((unsigned*)&UNI[0], (unsigned)un0); atomicOr((unsigned*)&UNI[1], (unsigned)(un0 >> 32)); atomicOr((unsigned*)&UNI[2], (unsigned)un1); atomicOr((unsigned*)&UNI[3], (unsigned)(un1 >> 32)); }
        __syncthreads();
    }
#pragma unroll
    for (int db = 0; db < 2; ++db)
#pragma unroll
        for (int r = 0; r < 16; ++r) PARK[(db * 16 + r) * 64] = out[db][r];
    {
        const unsigned u0 = __builtin_amdgcn_readfirstlane(UNI[0]), u1 = __builtin_amdgcn_readfirstlane(UNI[1]), u2 = __builtin_amdgcn_readfirstlane(UNI[2]), u3 = __builtin_amdgcn_readfirstlane(UNI[3]);
        const unsigned long long U0 = ((unsigned long long)u1 << 32) | u0, U1 = ((unsigned long long)u3 << 32) | u2, Ug = g ? U1 : U0;
        unsigned long long rem = U0 | U1;
        const unsigned long long mysel = SELM[g * 32 + r32];
        m = NEGF; l = 0.f; f32x16 O[2]; O[0] = f32x16{}; O[1] = f32x16{};
        int j = 63 - __builtin_clzll(rem); rem &= ~(1ull << j);
        { at_store(lds, st, tid); __syncthreads(); }
        int par = 0;
        for (;;) {
            LAS unsigned char* buf = lds + par * AT_BUF; const bool more = rem != 0ull; const int jn = more ? 63 - __builtin_clzll(rem) : 0; rem &= ~(1ull << jn);
            if (more) at_load(st, KV_SRC(2, jn), 4096, tid); else at_load(st, KV_SRC(4, jhi), 4096, tid);
            if ((Ug >> j) & 1ull) { f32x16 s[2]; at_qk(s, buf + koff, qf, qx, kx, r32, hi);
                const float ctile = slope2 * (float)(64 * j - tq); const bool rowok = ((mysel >> j) & 1ull) != 0ull;
                at_online(j == jhi ? 1 : 0, s, m, l, O, buf + voff, ctile, rowok, dlim, r32, hi); }
            if (more) at_store(lds + (par ^ 1) * AT_BUF, st, tid);
            __syncthreads();
            if (!more) break;
            j = jn; par ^= 1;
        }
        const float ltot = l + xor32(l, hi); const float sc = gate_s * __builtin_amdgcn_rcpf(ltot);
#pragma unroll
        for (int db = 0; db < 2; ++db)
#pragma unroll
            for (int r = 0; r < 16; ++r) PARK[(db * 16 + r) * 64] += sc * O[db][r];
    }
    {
        int jlo = (q0 - 511) >> 6; if (jlo < 0) jlo = 0;
        const int llim = tq - 511 - 64 * jlo;
        m = NEGF; l = 0.f; f32x16 O[2]; O[0] = f32x16{}; O[1] = f32x16{};
        { at_store(lds, st, tid); __syncthreads(); }
        for (int j = jhi; j >= jlo; --j) {
            LAS unsigned char* buf = lds + ((jhi - j) & 1) * AT_BUF; const bool more = j > jlo;
            if (more) at_load(st, KV_SRC(4, j - 1), 4096, tid);
            f32x16 s[2]; at_qk(s, buf + koff, qf, qx, kx, r32, hi);
            const float ctile = slope2 * (float)(64 * j - tq);
            at_online(j == jhi ? 1 : (j == jlo ? 2 : 0), s, m, l, O, buf + voff, ctile, true, j == jhi ? dlim : llim, r32, hi);
            if (more) at_store(lds + ((jhi - j + 1) & 1) * AT_BUF, st, tid);
            __syncthreads();
        }
        const float ltot = l + xor32(l, hi); const float sc = gate_w * __builtin_amdgcn_rcpf(ltot);
#pragma unroll
        for (int db = 0; db < 2; ++db)
#pragma unroll
            for (int r = 0; r < 16; ++r) out[db][r] = PARK[(db * 16 + r) * 64] + sc * O[db][r];
    }
#undef KV_SRC
    {
        float ss = 0.f;
#pragma unroll
        for (int db = 0; db < 2; ++db)
#pragma unroll
            for (int r = 0; r < 16; ++r) ss += out[db][r] * out[db][r];
        ss += xor32(ss, hi);
        if (hi == 0) SSQ[h * 32 + r32] = ss;
        __syncthreads();
        float tot = 0.f;
#pragma unroll
        for (int hh = 0; hh < 8; ++hh) tot += SSQ[hh * 32 + r32];
        const float rstd = rsqrtf(tot * (1.0f / 512.0f) + EPS);
        bf16_t* yp = (bf16_t*)(F.ws + WS_YCAT) + row * 1024 + 512 + h * 64 + 4 * hi;
#pragma unroll
        for (int db = 0; db < 2; ++db)
#pragma unroll
            for (int qq = 0; qq < 4; ++qq) { u32x2 w; w.x = cvtpk(out[db][4 * qq] * rstd, out[db][4 * qq + 1] * rstd); w.y = cvtpk(out[db][4 * qq + 2] * rstd, out[db][4 * qq + 3] * rstd);
                *(u32x2*)(yp + 32 * db + 8 * qq) = w; }
        __syncthreads();
    }
}

__global__ void __launch_bounds__(512) hybrid_fwd(Args args) {
    extern __shared__ __attribute__((aligned(16))) unsigned char lds_raw[];
    cg::grid_group grid = cg::this_grid();
    Frame F; F.lds = (LAS unsigned char*)lds_raw; F.tid = threadIdx.x; F.lane = F.tid & 63; F.wave = __builtin_amdgcn_readfirstlane(F.tid >> 6);
    F.G = gridDim.x; F.bid = blockIdx.x; F.ws = args.ws; F.in = args.in;
    unsigned char* ws = args.ws;
    volatile LAS unsigned* MISC = (volatile LAS unsigned*)(F.lds + LDS_MISC);
    if (F.tid < 2) MISC[F.tid] = 0u;
    __syncthreads();
    XcdBarrier xbar = xcd_barrier_post((unsigned*)ws, MISC);
    const int wave_u = __builtin_amdgcn_readfirstlane((int)threadIdx.x >> 6);
#define FRESH_TID() fresh_tid2(wave_u)
#define REFRESH() do { F.tid = FRESH_TID(); F.lane = F.tid & 63; F.wave = wave_u; } while (0)
#ifdef PROBE_A
    int nst_ = 0; unsigned long long* tsb_ = (unsigned long long*)(ws + 32768);
#define STAMP() do { if (blockIdx.x == 0 && threadIdx.x == 0) tsb_[nst_] = __builtin_amdgcn_s_memrealtime(); ++nst_; } while (0)
#else
#define STAMP() do {} while (0)
#endif
    STAMP();
#define GRID_BAR() do { xcd_barrier(xbar); REFRESH(); STAMP(); } while (0)
#define GRID_BAR_CG() do { grid.sync(); REFRESH(); STAMP(); } while (0)
    p0_prologue(F);
#ifdef DUP_P0
    __syncthreads(); REFRESH(); p0_prologue(F);
#endif
    if (args.ws == nullptr) grid.sync();
    GRID_BAR();
#ifdef DUP_BAR
    GRID_BAR(); GRID_BAR(); GRID_BAR(); GRID_BAR(); GRID_BAR(); GRID_BAR(); GRID_BAR(); GRID_BAR(); GRID_BAR(); GRID_BAR();
#endif
    p1_rows(F);
#ifdef DUP_P1
    __syncthreads(); REFRESH(); p1_rows(F);
#endif
    GRID_BAR();
    { pg8::Gemm g{(const bf16_t*)(ws + WS_H), (const bf16_t*)(ws + WS_WINT), M, NZ, DM, DM, DM}; pg8::StaticOrder S; S.init(M, NZ, F.G, F.bid);
      EpiZ E{ws}; pg8::gemm_phase<EpiZ, pg8::StaticOrder>(F.lds, g, S, E, FRESH_TID()); }
#ifdef DUP_P2
    __syncthreads(); REFRESH();
    { pg8::Gemm g{(const bf16_t*)(ws + WS_H), (const bf16_t*)(ws + WS_WINT), M, NZ, DM, DM, DM}; pg8::StaticOrder S; S.init(M, NZ, F.G, F.bid);
      EpiZ E{ws}; pg8::gemm_phase<EpiZ, pg8::StaticOrder>(F.lds, g, S, E, FRESH_TID()); }
#endif
    GRID_BAR();
    { for (int n = F.bid; n < 256; n += F.G) { const int mat = n >> 7, pm = (n >> 3) & 15, pn = (n >> 2) & 1, ks = n & 3;
        pg8::Gemm g{(const bf16_t*)(ws + WS_KV + (size_t)mat * KV_STRIDE) + (size_t)pm * 256 * 1024 + ks * 256,
                    (const bf16_t*)(ws + (mat ? WS_CW1VT : WS_CW1KT)) + pn * 1024 + ks * 256, 256, 256, 256, 1024, 2048};
        EpiBf16<0> E{(bf16_t*)(ws + WS_CP) + ((size_t)(mat * 4 + ks) * 4096 + pm * 256) * 512 + pn * 256, 512, nullptr};
        pg8::gemm_phase<EpiBf16<0>, pg8::OneUnit>(F.lds, g, pg8::OneUnit{}, E, FRESH_TID()); }
      __syncthreads(); REFRESH();
      for (int it = F.bid; it < 512; it += F.G) rnn_item<1>(F, it >> 6, it & 63); }
#ifdef DUP_P3
    __syncthreads(); REFRESH();
    { for (int n = F.bid; n < 256; n += F.G) { const int mat = n >> 7, pm = (n >> 3) & 15, pn = (n >> 2) & 1, ks = n & 3;
        pg8::Gemm g{(const bf16_t*)(ws + WS_KV + (size_t)mat * KV_STRIDE) + (size_t)pm * 256 * 1024 + ks * 256,
                    (const bf16_t*)(ws + (mat ? WS_CW1VT : WS_CW1KT)) + pn * 1024 + ks * 256, 256, 256, 256, 1024, 2048};
        EpiBf16<0> E{(bf16_t*)(ws + WS_CP) + ((size_t)(mat * 4 + ks) * 4096 + pm * 256) * 512 + pn * 256, 512, nullptr};
        pg8::gemm_phase<EpiBf16<0>, pg8::OneUnit>(F.lds, g, pg8::OneUnit{}, E, FRESH_TID()); }
      __syncthreads(); REFRESH();
      for (int it = F.bid; it < 512; it += F.G) rnn_item<1>(F, it >> 6, it & 63); }
#endif
    GRID_BAR();
    { const int gw = F.bid * 8 + F.wave, NGW = F.G * 8;
      for (int it = gw; it < 512 + 64; it += NGW) {
          if (it < 512) { cmp2_item(F, it); continue; }
          const int r = it - 512, b = r >> 3, ch = 64 * (r & 7) + F.lane; const float* RA = (const float*)(ws + WS_RA); const float* RH = (const float*)(ws + WS_RH); float* HIN = (float*)(ws + WS_RHIN);
          float h = 0.f;
#pragma unroll 32
          for (int c = 0; c < 64; ++c) { const size_t o = (size_t)(b * 64 + c) * 512 + ch; const float a = RA[o], hh = RH[o]; HIN[o] = h; h = a * h + hh; } } }
#ifdef DUP_P4
    __syncthreads(); REFRESH();
    { const int gw = F.bid * 8 + F.wave, NGW = F.G * 8;
      for (int it = gw; it < 512 + 64; it += NGW) {
          if (it < 512) { cmp2_item(F, it); continue; }
          const int r = it - 512, b = r >> 3, ch = 64 * (r & 7) + F.lane; const float* RA = (const float*)(ws + WS_RA); const float* RH = (const float*)(ws + WS_RH); float* HIN = (float*)(ws + WS_RHIN);
          float h = 0.f;
#pragma unroll 32
          for (int c = 0; c < 64; ++c) { const size_t o = (size_t)(b * 64 + c) * 512 + ch; const float a = RA[o], hh = RH[o]; HIN[o] = h; h = a * h + hh; } } }
#endif
    GRID_BAR();
    { for (int n = F.bid; n < 1024; n += F.G) { const int k = n >> 8, c = n & 255, b = c & 7, r = c >> 3;     const int i = (k == 0) ? r : (k == 1) ? 63 - r : (k == 2) ? 64 + r : 127 - r; attn_item(F, b, i); }
#ifdef DUP_ATT
      __syncthreads(); REFRESH();
      for (int n = F.bid; n < 1024; n += F.G) { const int k = n >> 8, c = n & 255, b = c & 7, r = c >> 3; const int i = (k == 0) ? r : (k == 1) ? 63 - r : (k == 2) ? 64 + r : 127 - r; attn_item(F, b, i); }
#endif
      __syncthreads();
      for (int it = F.bid; it < 512; it += F.G) rnn_item<2>(F, it >> 6, it & 63);
#ifdef DUP_RNN2
      __syncthreads(); REFRESH();
      for (int it = F.bid; it < 512; it += F.G) rnn_item<2>(F, it >> 6, it & 63);
#endif
    }
#ifdef DUP_P5
    __syncthreads(); REFRESH();
    { for (int n = F.bid; n < 1024; n += F.G) { const int k = n >> 8, c = n & 255, b = c & 7, r = c >> 3;     const int i = (k == 0) ? r : (k == 1) ? 63 - r : (k == 2) ? 64 + r : 127 - r; attn_item(F, b, i); }
      __syncthreads();
      for (int it = F.bid; it < 512; it += F.G) rnn_item<2>(F, it >> 6, it & 63);
#endif
    GRID_BAR();
    { pg8::Gemm g{(const bf16_t*)(ws + WS_YCAT), (const bf16_t*)(ws + WS_WOUTT), M, DM, DM, DM, DM}; pg8::StaticOrder S; S.init(M, DM, F.G, F.bid);
      EpiBf16<0> E{(bf16_t*)(ws + WS_Y), DM, nullptr}; pg8::gemm_phase<EpiBf16<0>, pg8::StaticOrder>(F.lds, g, S, E, FRESH_TID()); }
#ifdef DUP_P6
    __syncthreads(); REFRESH();
    { pg8::Gemm g{(const bf16_t*)(ws + WS_YCAT), (const bf16_t*)(ws + WS_WOUTT), M, DM, DM, DM, DM}; pg8::StaticOrder S; S.init(M, DM, F.G, F.bid);
      EpiBf16<0> E{(bf16_t*)(ws + WS_Y), DM, nullptr}; pg8::gemm_phase<EpiBf16<0>, pg8::StaticOrder>(F.lds, g, S, E, FRESH_TID()); }
#endif
    GRID_BAR();
    p7_rows(F);
#ifdef DUP_P7
    __syncthreads(); REFRESH(); p7_rows(F);
#endif
    GRID_BAR();
    { pg8::Gemm g{(const bf16_t*)(ws + WS_H), (const bf16_t*)(ws + WS_WFF1T), M, DFF, DM, DM, DM}; pg8::StaticOrder S; S.init(M, DFF, F.G, F.bid);
      EpiBf16<1> E{(bf16_t*)(ws + WS_HID), DFF, nullptr}; pg8::gemm_phase<EpiBf16<1>, pg8::StaticOrder>(F.lds, g, S, E, FRESH_TID()); }
#ifdef DUP_P8
    __syncthreads(); REFRESH();
    { pg8::Gemm g{(const bf16_t*)(ws + WS_H), (const bf16_t*)(ws + WS_WFF1T), M, DFF, DM, DM, DM}; pg8::StaticOrder S; S.init(M, DFF, F.G, F.bid);
      EpiBf16<1> E{(bf16_t*)(ws + WS_HID), DFF, nullptr}; pg8::gemm_phase<EpiBf16<1>, pg8::StaticOrder>(F.lds, g, S, E, FRESH_TID()); }
#endif
    GRID_BAR();
    { pg8::Gemm g{(const bf16_t*)(ws + WS_HID), (const bf16_t*)(ws + WS_WFF2T), M, DM, DFF, DFF, DFF}; pg8::StaticOrder S; S.init(M, DM, F.G, F.bid);
      EpiBf16<0> E{(bf16_t*)(ws + WS_Y2), DM, nullptr}; pg8::gemm_phase<EpiBf16<0>, pg8::StaticOrder>(F.lds, g, S, E, FRESH_TID()); }
#ifdef DUP_P9
    __syncthreads(); REFRESH();
    { pg8::Gemm g{(const bf16_t*)(ws + WS_HID), (const bf16_t*)(ws + WS_WFF2T), M, DM, DFF, DFF, DFF}; pg8::StaticOrder S; S.init(M, DM, F.G, F.bid);
      EpiBf16<0> E{(bf16_t*)(ws + WS_Y2), DM, nullptr}; pg8::gemm_phase<EpiBf16<0>, pg8::StaticOrder>(F.lds, g, S, E, FRESH_TID()); }
#endif
    GRID_BAR();
    p10_rows(F, args.out);
#ifdef DUP_P10
    __syncthreads(); REFRESH(); p10_rows(F, args.out);
#endif
#ifdef PROBE_A
    GRID_BAR();
    { const float Ta = (float)(tsb_[PROBE_A + 1] - tsb_[PROBE_A]) * 0.01f, Tb = (float)(tsb_[PROBE_B + 1] - tsb_[PROBE_B]) * 0.01f;
      if (blockIdx.x == 0 && threadIdx.x == 0) args.out[0] += Ta;
      for (int idx = 1024 + blockIdx.x * 512 + threadIdx.x; idx < 1024 + (1 << 20); idx += gridDim.x * 512) args.out[idx] += Tb * 0.01f; }
#endif
}

extern "C" void kernel_launch(void* const* d_in, const int* in_sizes, int n_in, void* d_out, int out_size, void* d_ws, size_t ws_size, hipStream_t stream) {
    static int grid = 0;
    if (grid == 0) {
        if (n_in != 27 || out_size != M * DM || ws_size < WS_END) { fprintf(stderr, "kernel_launch: unexpected problem (n_in %d out %d ws %zu)\n", n_in, out_size, ws_size); grid = -1; return; }
        int dev = 0, cus = 0, per_cu = 0;
        (void)hipGetDevice(&dev); (void)hipDeviceGetAttribute(&cus, hipDeviceAttributeMultiprocessorCount, dev);
        (void)hipFuncSetAttribute((const void*)hybrid_fwd, hipFuncAttributeMaxDynamicSharedMemorySize, LDS_BYTES);
        if (hipOccupancyMaxActiveBlocksPerMultiprocessor(&per_cu, (const void*)hybrid_fwd, 512, LDS_BYTES) != hipSuccess || per_cu < 1) per_cu = 1;
        (void)hipGetLastError();
        grid = cus * 1;
        fprintf(stderr, "kernel_launch: grid %d (per_cu %d)\n", grid, per_cu);
    }
    if (grid < 0) return;
    (void)hipMemsetAsync(d_ws, 0, 16384, stream);
    Args a{};
    for (int i = 0; i < 27; ++i) a.in[i] = (const float*)d_in[i];
    a.out = (float*)d_out; a.ws = (unsigned char*)d_ws;
    void* kargs[] = {&a};
    hipError_t e = hipLaunchCooperativeKernel((const void*)hybrid_fwd, dim3(grid), dim3(512), kargs, LDS_BYTES, stream);
    if (e != hipSuccess) fprintf(stderr, "kernel_launch: cooperative launch failed: %s\n", hipGetErrorString(e));
}
```

```cpp
#include <hip/hip_runtime.h>
#include <hip/hip_cooperative_groups.h>
#include <cstdio>
#include <cstdint>
namespace cg = cooperative_groups;

#define LAS __attribute__((address_space(3)))
typedef unsigned short bf16_t;
typedef short bf16x8 __attribute__((ext_vector_type(8)));
typedef short s16x4 __attribute__((ext_vector_type(4)));
typedef float f32x4 __attribute__((ext_vector_type(4)));
typedef float f32x16 __attribute__((ext_vector_type(16)));
typedef unsigned u32x4 __attribute__((ext_vector_type(4)));
typedef unsigned u32x2 __attribute__((ext_vector_type(2)));
#define LOG2E_C 1.4426950408889634f

namespace pg8 {
constexpr int BM = 256, BK = 64, HALF = 128, HTB = HALF * BK * 2, STAGE_BYTES = 8 * HTB, NXCD = 8, WGM = 8;
__host__ __device__ __forceinline__ int lds_byte(int r, int c) { const int st = (r >> 4) * 2 + (c >> 5), rr = r & 15, cc = c & 31, ob = rr * 64 + cc * 2; return st * 1024 + (ob ^ (((ob >> 9) & 1) << 5)); }
__host__ __device__ __forceinline__ void stage_rc(int b, int& R, int& C) { const int st = b / 1024, sb = b % 1024, swz = sb ^ (((sb >> 9) & 1) << 5); R = (st >> 1) * 16 + swz / 64; C = (st & 1) * 32 + (swz % 64) / 2; }
__host__ __device__ __forceinline__ int perm32(int rho) { const int n = rho >> 4, i = rho & 15; return 8 * (i >> 2) + 4 * n + (i & 3); }

struct Unit { int pm, pn; };
struct Gemm { const bf16_t* A; const bf16_t* Bt; int M, N, K, lda, ldb; };

struct StaticOrder {
    int nM, nN, nwg, G, c;
    __device__ void init(int M, int N, int G_, int c_) { nM = M / BM; nN = N / BM; nwg = nM * nN; G = G_; c = c_; }
    __device__ bool next(int i, Unit& u) const {
        const long L = (long)i * G + c; if (L >= nwg) return false;
        int wgid = (int)L; { const int q = nwg / NXCD, r = nwg % NXCD, xcd = wgid % NXCD, off = wgid / NXCD; wgid = (xcd < r ? xcd * (q + 1) : r * (q + 1) + (xcd - r) * q) + off; }
        const int nig = WGM * nN, gid = wgid / nig, fm = gid * WGM, gsz = (nM - fm) < WGM ? (nM - fm) : WGM;
        u.pm = fm + ((wgid % nig) % gsz); u.pn = (wgid % nig) / gsz; return true;
    }
};
struct OneUnit { __device__ bool next(int i, Unit& u) const { if (i) return false; u.pm = 0; u.pn = 0; return true; } };
struct ColOrder {
    int nM, G, c;
    __device__ bool next(int i, Unit& u) const { const long L = (long)i * G + c; if (c < 0 || L >= nM) return false; u.pm = (int)L; u.pn = 0; return true; }
};

__device__ __forceinline__ unsigned cvt_pk_bf16(float lo, float hi) { unsigned r; asm volatile("v_cvt_pk_bf16_f32 %0, %1, %2" : "=v"(r) : "v"(lo), "v"(hi)); return r; }

template <class Epi, class Sched>
__device__ __forceinline__ void gemm_phase(LAS unsigned char* lds, const Gemm g, const Sched& S, const Epi& E, int tid) {
    const int wid = __builtin_amdgcn_readfirstlane(tid >> 6), lane = tid & 63, wr = wid >> 2, wc = wid & 3, fr = lane & 15, fq = lane >> 4;
    const int K = g.K, nt = K / BK, lda = g.lda, ldb = g.ldb;
    unsigned voffA[2], voffB[2];
#pragma unroll
    for (int i = 0; i < 2; ++i) { int R, C; stage_rc(tid * 16 + i * 8192, R, C); const int Rb = Epi::PERM ? ((R & ~31) + perm32(R & 31)) : R;
        voffA[i] = (unsigned)(R * lda + C) * 2u; voffB[i] = (unsigned)(Rb * ldb + C) * 2u; }
    const size_t kstep = (size_t)(BK * 2);
    const size_t hstepA = (size_t)HALF * lda * 2, hstepB = (size_t)HALF * ldb * 2;
    const size_t tstepA = 2 * hstepA, tstepB = 2 * hstepB;
    const unsigned ldsw = (unsigned)wid * 1024u;
    const int aoff = lds_byte(wr * 64 + fr, fq * 8), boff = lds_byte(wc * 32 + fr, fq * 8);
#define PG8_SA(b, h) (((b) * 2 + (h)) * HTB)
#define PG8_SB(b, h) ((4 + (b) * 2 + (h)) * HTB)
#define PG8_STAGE(bufoff, gbase, voff) do { _Pragma("unroll") for (int _i = 0; _i < 2; ++_i) \
        __builtin_amdgcn_global_load_lds((const unsigned*)((const char*)(gbase) + (voff)[_i]), (LAS unsigned*)(lds + (bufoff) + ldsw + _i * 8192), 16, 0, 0); } while (0)
#define PG8_LDA(dst, b, h) do { _Pragma("unroll") for (int m = 0; m < 4; ++m) _Pragma("unroll") for (int k = 0; k < 2; ++k) dst[m][k] = *(const LAS bf16x8*)(lds + PG8_SA(b, h) + aoff + m * 2048 + k * 1024); } while (0)
#define PG8_LDB(dst, b, h) do { _Pragma("unroll") for (int n = 0; n < 2; ++n) _Pragma("unroll") for (int k = 0; k < 2; ++k) dst[n][k] = *(const LAS bf16x8*)(lds + PG8_SB(b, h) + boff + n * 2048 + k * 1024); } while (0)
#define PG8_MMA(ai, bj, At, Bt) do { __builtin_amdgcn_s_setprio(1); _Pragma("unroll") for (int m = 0; m < 4; ++m) _Pragma("unroll") for (int n = 0; n < 2; ++n) _Pragma("unroll") for (int k = 0; k < 2; ++k) \
        acc[ai][bj][m][n] = __builtin_amdgcn_mfma_f32_16x16x32_bf16(Bt[n][k], At[m][k], acc[ai][bj][m][n], 0, 0, 0); __builtin_amdgcn_s_setprio(0); } while (0)
#define PG8_WAIT_V(n) asm volatile("s_waitcnt vmcnt(" #n ")" ::: "memory")
#define PG8_WAIT_L(n) asm volatile("s_waitcnt lgkmcnt(" #n ")" ::: "memory")
#define PG8_BAR __builtin_amdgcn_s_barrier()
#define PG8_SCHED __builtin_amdgcn_sched_barrier(0)
    Unit cur, nxt; int ui = 0;
    if (!S.next(0, cur)) return;
    f32x4 acc[2][2][4][2];
#pragma unroll
    for (int a = 0; a < 2; ++a)
#pragma unroll
        for (int b = 0; b < 2; ++b)
#pragma unroll
            for (int m = 0; m < 4; ++m)
#pragma unroll
                for (int n = 0; n < 2; ++n) acc[a][b][m][n] = (f32x4){0.f, 0.f, 0.f, 0.f};
    bf16x8 At[4][2], B0[2][2], B1[2][2];
    const char* cA = (const char*)g.A + (size_t)cur.pm * tstepA; const char* cB = (const char*)g.Bt + (size_t)cur.pn * tstepB;
    PG8_STAGE(PG8_SB(0, 0), cB, voffB); PG8_STAGE(PG8_SB(0, 1), cB + hstepB, voffB); PG8_STAGE(PG8_SA(0, 0), cA, voffA); PG8_STAGE(PG8_SA(0, 1), cA + hstepA, voffA);
    if (wr == 1) PG8_BAR;
    PG8_WAIT_V(2); PG8_BAR;
    PG8_STAGE(PG8_SB(1, 0), cB + kstep, voffB); PG8_STAGE(PG8_SA(1, 0), cA + kstep, voffA); PG8_STAGE(PG8_SB(1, 1), cB + hstepB + kstep, voffB);
    PG8_WAIT_V(6); PG8_BAR;
    for (;;) {
        const bool has_next = S.next(ui + 1, nxt);
        const char* nA = has_next ? (const char*)g.A + (size_t)nxt.pm * tstepA : cA; const char* nB = has_next ? (const char*)g.Bt + (size_t)nxt.pn * tstepB : cB;
        for (int t = 0; t < nt; t += 2) {
            const bool last = (t == nt - 2);
            const char* a1 = cA + (size_t)(t + 1) * kstep;
            const char* a2 = last ? nA : cA + (size_t)(t + 2) * kstep; const char* b2 = last ? nB : cB + (size_t)(t + 2) * kstep;
            const char* a3 = a2 + kstep; const char* b3 = b2 + kstep;
            PG8_LDB(B0, 0, 0); PG8_LDB(B1, 0, 1); PG8_SCHED; PG8_LDA(At, 0, 0); PG8_STAGE(PG8_SA(1, 1), a1 + hstepA, voffA);
            PG8_WAIT_V(8); PG8_WAIT_L(0); PG8_BAR; PG8_MMA(0, 0, At, B0); PG8_MMA(0, 1, At, B1); PG8_BAR; PG8_SCHED;
            PG8_LDA(At, 0, 1); PG8_STAGE(PG8_SB(0, 0), b2, voffB); PG8_STAGE(PG8_SB(0, 1), b2 + hstepB, voffB); PG8_STAGE(PG8_SA(0, 0), a2, voffA);
            PG8_WAIT_V(8); PG8_WAIT_L(0); PG8_BAR; PG8_MMA(1, 0, At, B0); PG8_MMA(1, 1, At, B1); PG8_BAR; PG8_SCHED;
            PG8_LDB(B0, 1, 0); PG8_LDB(B1, 1, 1); PG8_SCHED; PG8_LDA(At, 1, 0); PG8_STAGE(PG8_SA(0, 1), a2 + hstepA, voffA);
            PG8_WAIT_V(8); PG8_WAIT_L(0); PG8_BAR; PG8_MMA(0, 0, At, B0); PG8_MMA(0, 1, At, B1); PG8_BAR; PG8_SCHED;
            PG8_LDA(At, 1, 1); PG8_STAGE(PG8_SB(1, 0), b3, voffB); PG8_STAGE(PG8_SB(1, 1), b3 + hstepB, voffB); PG8_STAGE(PG8_SA(1, 0), a3, voffA);
            PG8_WAIT_V(8); PG8_WAIT_L(0); PG8_BAR; PG8_MMA(1, 0, At, B0); PG8_MMA(1, 1, At, B1); PG8_BAR; PG8_SCHED;
        }
        E(acc, cur, wr, wc, fr, fq);
        if (!has_next) break;
#pragma unroll
        for (int a = 0; a < 2; ++a)
#pragma unroll
            for (int b = 0; b < 2; ++b)
#pragma unroll
                for (int m = 0; m < 4; ++m)
#pragma unroll
                    for (int n = 0; n < 2; ++n) acc[a][b][m][n] = (f32x4){0.f, 0.f, 0.f, 0.f};
        cur = nxt; cA = nA; cB = nB; ++ui;
    }
    PG8_WAIT_V(0);
    if (wr == 0) PG8_BAR;
    PG8_BAR;
#undef PG8_SA
#undef PG8_SB
#undef PG8_STAGE
#undef PG8_LDA
#undef PG8_LDB
#undef PG8_MMA
#undef PG8_WAIT_V
#undef PG8_WAIT_L
#undef PG8_BAR
#undef PG8_SCHED
}
}

constexpr int BATCH = 8, SEQ = 4096, DM = 1024, M = BATCH * SEQ, NZ = 2560, DFF = 4096, NMOD = 6 * DM;
constexpr float EPS = 1e-6f, NEGF = -1e30f, LOG2E = 1.4426950408889634f;
constexpr size_t MiB = 1u << 20, KiB = 1024;
constexpr size_t WS_MOD = 64 * KiB;
constexpr size_t WS_CB1P = 320 * KiB;
constexpr size_t WS_CB1 = 384 * KiB;
constexpr size_t WS_LRUC = 400 * KiB;
constexpr size_t WS_WAT = 448 * KiB, WS_WXT = 512 * KiB;
constexpr size_t WS_CW2KT = 576 * KiB, WS_CW2VT = 640 * KiB;
constexpr size_t WS_WINT = 2 * MiB, WS_WOUTT = 8 * MiB, WS_WFF1T = 10 * MiB, WS_WFF2T = 18 * MiB, WS_CW1KT = 26 * MiB, WS_CW1VT = 27 * MiB;
constexpr size_t WS_CHIDK = 28 * MiB, WS_CHIDV = 30 * MiB;
constexpr size_t WS_H = 32 * MiB;
constexpr size_t WS_GRNN = 96 * MiB, WS_XRNN = 128 * MiB, WS_Q = 160 * MiB;
constexpr size_t WS_KV = 192 * MiB, KV_STRIDE = 8 * MiB;
constexpr size_t WS_GATE = 240 * MiB;
constexpr size_t WS_KCMP = 244 * MiB, WS_VCMPT = WS_KCMP + 512 * KiB;
constexpr size_t WS_RA = 246 * MiB, WS_RH = 247 * MiB, WS_RHIN = 248 * MiB;
constexpr size_t WS_YCAT = 256 * MiB;
constexpr size_t WS_Y = 416 * MiB;
constexpr size_t WS_HID = 96 * MiB;
constexpr size_t WS_Y2 = 352 * MiB;
constexpr size_t WS_RG = 416 * MiB;
constexpr size_t WS_CP = WS_Y2;
constexpr size_t WS_END = 480 * MiB;
constexpr int LDS_BYTES = 147456, LDS_MISC = 147200;

struct Args { const float* in[27]; float* out; unsigned char* ws; };

struct Frame {
    LAS unsigned char* lds; int tid, lane, wave, G, bid; unsigned char* ws; const float* const* in;
};

__device__ __forceinline__ unsigned f2bf(float f) { unsigned u = __builtin_bit_cast(unsigned, f); return (u + 0x7fffu + ((u >> 16) & 1u)) >> 16; }
typedef __bf16 bf16x2_t __attribute__((ext_vector_type(2)));
typedef float f32x2_t __attribute__((ext_vector_type(2)));
__device__ __forceinline__ unsigned pk2(float lo, float hi) { f32x2_t v = {lo, hi}; bf16x2_t b = __builtin_convertvector(v, bf16x2_t); return __builtin_bit_cast(unsigned, b); }
__device__ __forceinline__ float bf2f(bf16_t b) { return __builtin_bit_cast(float, (unsigned)b << 16); }
__device__ __forceinline__ float wave_sum(float v) {
#pragma unroll
    for (int o = 1; o < 64; o <<= 1) v += __shfl_xor(v, o);
    return v;
}
__device__ __forceinline__ float sigmoidf_(float x) { return __builtin_amdgcn_rcpf(1.0f + __builtin_amdgcn_exp2f(-LOG2E_C * x)); }
__device__ __forceinline__ float gelu_tanh(float v) { const float u = (-2.0f * 0.7978845608028654f * LOG2E_C) * (v + 0.044715f * v * v * v); return v * __builtin_amdgcn_rcpf(1.0f + __builtin_amdgcn_exp2f(u)); }
__device__ __forceinline__ float expm1_small(float x) { float p = 1.0f / 5040.0f; p = fmaf(p, x, 1.0f / 720.0f); p = fmaf(p, x, 1.0f / 120.0f); p = fmaf(p, x, 1.0f / 24.0f); p = fmaf(p, x, 1.0f / 6.0f); p = fmaf(p, x, 0.5f); p = fmaf(p, x, 1.0f); return p * x; }
#define LDS_FENCE() asm volatile("s_waitcnt lgkmcnt(0)" ::: "memory")
__device__ __forceinline__ int fresh_tid2(int wave_u) { int z = 0; asm volatile("" : "+v"(z)); int t = (wave_u << 6) | (int)__builtin_amdgcn_mbcnt_hi(~0u, __builtin_amdgcn_mbcnt_lo(~0u, (unsigned)z)); asm volatile("" : "+v"(t)); return t; }
__device__ __forceinline__ int fresh_tid() { int t = threadIdx.x; asm volatile("" : "+v"(t)); return t; }

struct EpiF32 {
    static constexpr bool PERM = false;
    float* O; int ldc;
    __device__ __forceinline__ void operator()(const f32x4 (&acc)[2][2][4][2], const pg8::Unit& u, int wr, int wc, int fr, int fq) const {
        const int row0 = u.pm * 256 + wr * 64 + fr, col0 = u.pn * 256 + wc * 32 + 4 * fq;
#pragma unroll
        for (int ai = 0; ai < 2; ++ai)
#pragma unroll
            for (int m = 0; m < 4; ++m) { float* rowp = O + (size_t)(row0 + ai * 128 + m * 16) * ldc + col0;
#pragma unroll
                for (int bj = 0; bj < 2; ++bj)
#pragma unroll
                    for (int n = 0; n < 2; ++n) *(f32x4*)(rowp + bj * 128 + n * 16) = acc[ai][bj][m][n]; }
    }
};
template <int ACT  > struct EpiBf16 {
    static constexpr bool PERM = true;
    bf16_t* O; int ldc; const float* bias;
    __device__ __forceinline__ void operator()(const f32x4 (&acc)[2][2][4][2], const pg8::Unit& u, int wr, int wc, int fr, int fq) const {
        const int row0 = u.pm * 256 + wr * 64 + fr, col0 = u.pn * 256 + wc * 32 + 8 * fq;
        f32x4 bv[2][2];
#pragma unroll
        for (int bj = 0; bj < 2; ++bj)
#pragma unroll
            for (int n = 0; n < 2; ++n) bv[bj][n] = (ACT == 2) ? *(const f32x4*)(bias + col0 + bj * 128 + 4 * n) : (f32x4){0.f, 0.f, 0.f, 0.f};
#pragma unroll
        for (int ai = 0; ai < 2; ++ai)
#pragma unroll
            for (int m = 0; m < 4; ++m) { bf16_t* rowp = O + (size_t)(row0 + ai * 128 + m * 16) * ldc + col0;
#pragma unroll
                for (int bj = 0; bj < 2; ++bj) { f32x4 v0 = acc[ai][bj][m][0] + bv[bj][0], v1 = acc[ai][bj][m][1] + bv[bj][1];
#pragma unroll
                    for (int e = 0; e < 4; ++e) {
                        if (ACT == 1) { const float a = fmaxf(v0[e], 0.f), b = fmaxf(v1[e], 0.f); v0[e] = a * a; v1[e] = b * b; }
                        if (ACT == 2) { v0[e] = gelu_tanh(v0[e]); v1[e] = gelu_tanh(v1[e]); } }
                    u32x4 w; w.x = pk2(v0[0], v0[1]); w.y = pk2(v0[2], v0[3]); w.z = pk2(v1[0], v1[1]); w.w = pk2(v1[2], v1[3]);
                    *(u32x4*)(rowp + bj * 128) = w; } }
    }
};
struct EpiZ {
    static constexpr bool PERM = true;
    unsigned char* ws;
    __device__ __forceinline__ void operator()(const f32x4 (&acc)[2][2][4][2], const pg8::Unit& u, int wr, int wc, int fr, int fq) const {
        const int row0 = u.pm * 256 + wr * 64 + fr, pn = u.pn;
        if (pn < 6) {
            bf16_t* base = (bf16_t*)(ws + (pn < 2 ? WS_GRNN : pn < 4 ? WS_XRNN : WS_Q)); const float sc = pn >= 4 ? 0.125f * LOG2E_C : 1.0f;
            const int col0 = (pn & 1) * 256 + wc * 32 + 8 * fq;
#pragma unroll
            for (int ai = 0; ai < 2; ++ai)
#pragma unroll
                for (int m = 0; m < 4; ++m) { bf16_t* rowp = base + (size_t)(row0 + ai * 128 + m * 16) * 512 + col0;
#pragma unroll
                    for (int bj = 0; bj < 2; ++bj) { const f32x4 v0 = acc[ai][bj][m][0] * sc, v1 = acc[ai][bj][m][1] * sc;
                        u32x4 w; w.x = pk2(v0[0], v0[1]); w.y = pk2(v0[2], v0[3]); w.z = pk2(v1[0], v1[1]); w.w = pk2(v1[2], v1[3]);
                        *(u32x4*)(rowp + bj * 128) = w; } }
        } else if (pn < 9) {
            const int p = pn - 6, g = wc >> 1, d0 = 32 * (wc & 1) + 8 * fq;
            bf16_t* Kb = (bf16_t*)(ws + WS_KV + (size_t)(2 * p) * KV_STRIDE); bf16_t* Vb = (bf16_t*)(ws + WS_KV + (size_t)(2 * p + 1) * KV_STRIDE);
#pragma unroll
            for (int ai = 0; ai < 2; ++ai)
#pragma unroll
                for (int m = 0; m < 4; ++m) { const int row = row0 + ai * 128 + m * 16, b = row >> 12, s = row & 4095;
                    { const f32x4 v0 = acc[ai][0][m][0], v1 = acc[ai][0][m][1];
                      u32x4 w; w.x = pk2(v0[0], v0[1]); w.y = pk2(v0[2], v0[3]); w.z = pk2(v1[0], v1[1]); w.w = pk2(v1[2], v1[3]);
                      *(u32x4*)(Kb + ((size_t)(b * 2 + g) * 4096 + s) * 64 + d0) = w; }
                    if (p == 0) { const f32x4 v0 = acc[ai][1][m][0], v1 = acc[ai][1][m][1];
                      u32x4 w; w.x = pk2(v0[0], v0[1]); w.y = pk2(v0[2], v0[3]); w.z = pk2(v1[0], v1[1]); w.w = pk2(v1[2], v1[3]);
                      *(u32x4*)(Vb + ((size_t)(b * 2 + g) * 4096 + s) * 64 + d0) = w; }
                    else { bf16_t* vp = Vb + ((size_t)(b * 2 + g) * 64 + d0) * 4096 + s;
#pragma unroll
                      for (int n = 0; n < 2; ++n)
#pragma unroll
                          for (int e = 0; e < 4; ++e) vp[(size_t)(4 * n + e) * 4096] = (bf16_t)f2bf(acc[ai][1][m][n][e]); } }
        } else {
            if (wc == 0 && fq < 3) { float* G = (float*)(ws + WS_GATE);
#pragma unroll
                for (int ai = 0; ai < 2; ++ai)
#pragma unroll
                    for (int m = 0; m < 4; ++m) { float* gp = G + (size_t)(row0 + ai * 128 + m * 16) * 24 + 8 * fq;
#pragma unroll
                        for (int n = 0; n < 2; ++n) { f32x4 v = acc[ai][0][m][n];
#pragma unroll
                            for (int e = 0; e < 4; ++e) v[e] = sigmoidf_(v[e]);
                            *(f32x4*)(gp + 4 * n) = v; } } }
        }
    }
};

#define XB_TMO      128
#define XB_XCNT(j)  (256  + 64 * (j))
#define XB_XSUB(j)  (1280 + 64 * (j))
#define XB_XGEN(j)  (2304 + 64 * (j))
#define XB_TOP      3328
#define XB_TOPGEN   3392
#define XCD_BAR_WORDS 3456
#define XB_SPIN_CAP (1u << 18)

__device__ __forceinline__ unsigned xb_ld(unsigned* p)              { return __hip_atomic_load(p, __ATOMIC_RELAXED, __HIP_MEMORY_SCOPE_AGENT); }
__device__ __forceinline__ unsigned xb_add(unsigned* p, unsigned v) { return __hip_atomic_fetch_add(p, v, __ATOMIC_RELAXED, __HIP_MEMORY_SCOPE_AGENT); }
__device__ __forceinline__ unsigned xb_xcc_id() { return (unsigned)__builtin_amdgcn_s_getreg((3 << 11) | 20) & 0xFu; }
#define XB_SPIN(cond, bar) do { unsigned _sp = 0; while (cond) { __builtin_amdgcn_s_sleep(1); \
    if ((++_sp & 255u) == 0u) { if (xb_ld(&(bar)[XB_TMO])) break; if (_sp > XB_SPIN_CAP) { atomicAdd(&(bar)[XB_TMO], 1u); break; } } } } while (0)

struct XcdBarrier {
    unsigned* bar; unsigned x;
    volatile LAS unsigned* st;
};

__device__ __forceinline__ XcdBarrier xcd_barrier_post(unsigned* bar, volatile LAS unsigned* st) {
    XcdBarrier b; b.bar = bar; b.x = xb_xcc_id(); b.st = st;
    if (threadIdx.x == 0) (void)xb_add(&bar[XB_XCNT(b.x)], 1u);
    return b;
}
__device__ __forceinline__ void xcd_barrier_complete(unsigned* bar, unsigned x, unsigned& nloc, unsigned& nx) {
    const unsigned G = gridDim.x * gridDim.y * gridDim.z;
    unsigned sum, cnt, mine, sp = 0u;
    for (;;) {
        sum = 0u; cnt = 0u; mine = 0u;
#pragma unroll
        for (unsigned j = 0; j < 16; ++j) { const unsigned c = xb_ld(&bar[XB_XCNT(j)]); sum += c; cnt += (c > 0u) ? 1u : 0u; mine = (j == x) ? c : mine; }
        if (sum == G) break;
        __builtin_amdgcn_s_sleep(1);
        if ((++sp & 255u) == 0u) { if (xb_ld(&bar[XB_TMO])) break; if (sp > XB_SPIN_CAP) { atomicAdd(&bar[XB_TMO], 1u); break; } }
    }
    nloc = mine > 0u ? mine : 1u; nx = cnt > 0u ? cnt : 1u;
}

__device__ __forceinline__ void xcd_barrier(const XcdBarrier& b) {
    asm volatile("s_waitcnt vmcnt(0)" ::: "memory");
    __syncthreads();
    if (threadIdx.x == 0) {
        unsigned* bar = b.bar;
        __builtin_amdgcn_s_waitcnt(0);
        unsigned nloc = b.st[0], nx = b.st[1];
        if (nloc == 0u) { xcd_barrier_complete(bar, b.x, nloc, nx); b.st[0] = nloc; b.st[1] = nx; }
        const unsigned old = xb_add(&bar[XB_XSUB(b.x)], 1u);
        const unsigned gen = old / nloc;
        if (old + 1u == (gen + 1u) * nloc) {
            __builtin_amdgcn_fence(__ATOMIC_RELEASE, "agent");
            asm volatile("s_waitcnt vmcnt(0)" ::: "memory");
            const unsigned og = xb_add(&bar[XB_TOP], 1u);
            const unsigned tg = og / nx;
            if (og + 1u == (tg + 1u) * nx) xb_add(&bar[XB_TOPGEN], 1u);
            else XB_SPIN(xb_ld(&bar[XB_TOPGEN]) == tg, bar);
            __builtin_amdgcn_fence(__ATOMIC_ACQUIRE, "agent");
            xb_add(&bar[XB_XGEN(b.x)], 1u);
            asm volatile("s_waitcnt vmcnt(0)" ::: "memory");
        } else {
            XB_SPIN(xb_ld(&bar[XB_XGEN(b.x)]) == gen, bar);
            __builtin_amdgcn_fence(__ATOMIC_ACQUIRE, "agent");
            asm volatile("s_waitcnt vmcnt(0)" ::: "memory");
        }
    }
    __syncthreads();
}


__device__ __forceinline__ void tr_item(const float* W, int K, int N, bf16_t* WT, int NT, const float* gA, const float* gB, LAS float* scr, int item, int lane) {
    const int nblk = NT / 64, kb = item / nblk, nb = item % nblk, k0 = 64 * kb, n0 = 64 * nb;
    const int nn = n0 + 4 * (lane & 15);
#pragma unroll 8
    for (int i = 0; i < 16; ++i) { const int kk = 4 * i + (lane >> 4), k = k0 + kk;
        f32x4 v = (nn < N) ? *(const f32x4*)(W + (size_t)k * N + nn) : (f32x4){0.f, 0.f, 0.f, 0.f};
        if (gA) v = v * ((k < 512) ? gA[k] : gB[k - 512]);
        LAS float* d = scr + kk * 65 + 4 * (lane & 15); d[0] = v.x; d[1] = v.y; d[2] = v.z; d[3] = v.w; }
    LDS_FENCE();
    const int c = lane & 7;
#pragma unroll
    for (int j = 0; j < 8; ++j) { const int n = (lane >> 3) + 8 * j; const LAS float* s = scr + (8 * c) * 65 + n;
        u32x4 o; o.x = pk2(s[0 * 65], s[1 * 65]); o.y = pk2(s[2 * 65], s[3 * 65]); o.z = pk2(s[4 * 65], s[5 * 65]); o.w = pk2(s[6 * 65], s[7 * 65]);
        *(u32x4*)(WT + (size_t)(n0 + n) * K + k0 + 8 * c) = o; }
    LDS_FENCE();
}
__device__ __forceinline__ void p0_mod_item(Frame& F, int item) {
    LAS float* sc = (LAS float*)F.lds; LAS float* red = (LAS float*)(F.lds + 32768);
    const float* c = F.in[1]; const float* ada_w = F.in[2]; const float* ada_b = F.in[3];
    for (int idx = F.tid; idx < 8192; idx += 512) { const float v = c[idx]; sc[idx] = v / (1.0f + __expf(-v)); }
    __syncthreads();
    float acc[8];
#pragma unroll
    for (int b = 0; b < 8; ++b) acc[b] = 0.f;
    const int kbase = 128 * F.wave; const float* wp = ada_w + (size_t)kbase * NMOD + 64 * item + F.lane;
#pragma unroll 8
    for (int kk = 0; kk < 128; ++kk) { const float wv = wp[(size_t)kk * NMOD];
#pragma unroll
        for (int b = 0; b < 8; ++b) acc[b] += sc[b * 1024 + kbase + kk] * wv; }
#pragma unroll
    for (int b = 0; b < 8; ++b) red[(F.wave * 8 + b) * 64 + F.lane] = acc[b];
    __syncthreads();
    { const int b = F.tid >> 6, col = F.tid & 63; float s = ada_b[64 * item + col];
#pragma unroll
      for (int w = 0; w < 8; ++w) s += red[(w * 8 + b) * 64 + col];
      ((float*)(F.ws + WS_MOD))[b * NMOD + 64 * item + col] = s; }
    __syncthreads();
}
__device__ __forceinline__ void p0_prologue(Frame& F) {
    for (int it = F.bid; it < NMOD / 64; it += F.G) p0_mod_item(F, it);
    LAS float* scr = (LAS float*)(F.lds + F.wave * 16640);
    const int nmb = (NMOD / 64 < F.G) ? NMOD / 64 : 0;
    const int gw = ((F.bid + F.G - nmb) % F.G) * 8 + F.wave, NGW = F.G * 8;
    constexpr int I_IN = 16 * (NZ / 64), I_OUT = 16 * 16, I_F1 = 16 * 64, I_F2 = 64 * 16, I_C1 = 32 * 4, I_C2 = 4 * 1, I_L = 1;
    constexpr int NTR = I_IN + I_OUT + I_F1 + I_F2 + 2 * I_C1 + 2 * I_C2 + 16 * I_L;
    constexpr int NITEMS = NTR + 128 + 8;
    unsigned char* ws = F.ws;
    for (int it = gw; it < NITEMS; it += NGW) {
        int r = it;
        if (r < I_IN) { tr_item(F.in[5], DM, 2328, (bf16_t*)(ws + WS_WINT), NZ, nullptr, nullptr, scr, r, F.lane); continue; } r -= I_IN;
        if (r < I_OUT) { tr_item(F.in[21], DM, DM, (bf16_t*)(ws + WS_WOUTT), DM, F.in[19], F.in[20], scr, r, F.lane); continue; } r -= I_OUT;
        if (r < I_F1) { tr_item(F.in[24], DM, DFF, (bf16_t*)(ws + WS_WFF1T), DFF, nullptr, nullptr, scr, r, F.lane); continue; } r -= I_F1;
        if (r < I_F2) { tr_item(F.in[25], DFF, DM, (bf16_t*)(ws + WS_WFF2T), DM, nullptr, nullptr, scr, r, F.lane); continue; } r -= I_F2;
        if (r < I_C1) { tr_item(F.in[14], 2048, 256, (bf16_t*)(ws + WS_CW1KT), 256, nullptr, nullptr, scr, r, F.lane); continue; } r -= I_C1;
        if (r < I_C1) { tr_item(F.in[17], 2048, 256, (bf16_t*)(ws + WS_CW1VT), 256, nullptr, nullptr, scr, r, F.lane); continue; } r -= I_C1;
        if (r < I_C2) { tr_item(F.in[15], 256, 64, (bf16_t*)(ws + WS_CW2KT), 64, nullptr, nullptr, scr, r, F.lane); continue; } r -= I_C2;
        if (r < I_C2) { tr_item(F.in[18], 256, 64, (bf16_t*)(ws + WS_CW2VT), 64, nullptr, nullptr, scr, r, F.lane); continue; } r -= I_C2;
        if (r < 8 * I_L) { const int n = r / I_L; tr_item(F.in[8] + n * 4096, 64, 64, (bf16_t*)(ws + WS_WAT) + n * 4096, 64, nullptr, nullptr, scr, r % I_L, F.lane); continue; } r -= 8 * I_L;
        if (r < 8 * I_L) { const int n = r / I_L; tr_item(F.in[10] + n * 4096, 64, 64, (bf16_t*)(ws + WS_WXT) + n * 4096, 64, nullptr, nullptr, scr, r % I_L, F.lane); continue; } r -= 8 * I_L;
        if (r < 128) {
            const int mat = r >> 6, cgp = (r >> 4) & 3, ks = r & 15; const float* pos = F.in[mat ? 16 : 13]; const float* w1 = F.in[mat ? 17 : 14];
            float a = 0.f; const int col = 64 * cgp + F.lane;
#pragma unroll 8
            for (int kk = 0; kk < 128; ++kk) { const int k = 128 * ks + kk; a += pos[k] * w1[(size_t)k * 256 + col]; }
            ((float*)(ws + WS_CB1P))[(mat * 16 + ks) * 256 + col] = a; continue; } r -= 128;
        { const int ch = 64 * r + F.lane; const float lam = F.in[12][ch]; ((float*)(ws + WS_LRUC))[ch] = -8.0f * log1pf(expf(-lam)); }
    }
}

__device__ __forceinline__ void p1_rows(Frame& F) {
    if (F.bid == 0) { const int mat = F.tid >> 8, col = F.tid & 255; float s = 0.f; const float* P = (const float*)(F.ws + WS_CB1P);
#pragma unroll
        for (int ks = 0; ks < 16; ++ks) s += P[(mat * 16 + ks) * 256 + col];
        ((float*)(F.ws + WS_CB1))[mat * 256 + col] = s; }
    const float* x = F.in[0]; const float* g = F.in[4]; const float* mod = (const float*)(F.ws + WS_MOD); bf16_t* H = (bf16_t*)(F.ws + WS_H);
    const int gw = F.bid * 8 + F.wave, NGW = F.G * 8;
    for (int rb = gw; rb < M / 16; rb += NGW) {
        const int b = (rb * 16) >> 12; f32x4 Gk[4], Sh[4];
#pragma unroll
        for (int j = 0; j < 4; ++j) { const int k = 4 * F.lane + 256 * j; const f32x4 gg = *(const f32x4*)(g + k), sc = *(const f32x4*)(mod + b * NMOD + 1024 + k);
            Gk[j] = gg * (sc + 1.0f); Sh[j] = *(const f32x4*)(mod + b * NMOD + k); }
        for (int rr = 0; rr < 16; ++rr) { const size_t row = (size_t)rb * 16 + rr; const f32x4* xr = (const f32x4*)(x + row * DM) + F.lane;
            f32x4 v[4]; float s = 0.f;
#pragma unroll
            for (int j = 0; j < 4; ++j) { v[j] = xr[64 * j]; s += (v[j].x * v[j].x + v[j].y * v[j].y) + (v[j].z * v[j].z + v[j].w * v[j].w); }
            const float rstd = rsqrtf(wave_sum(s) * (1.0f / DM) + EPS);
            unsigned long long* o8 = (unsigned long long*)(H + row * DM) + F.lane;
#pragma unroll
            for (int j = 0; j < 4; ++j) { const f32x4 h = v[j] * rstd * Gk[j] + Sh[j]; o8[64 * j] = (unsigned long long)pk2(h.x, h.y) | ((unsigned long long)pk2(h.z, h.w) << 32); } }
    }
}
__device__ __forceinline__ f32x4 ld_bf16x4(const bf16_t* p) { const u32x2 w = *(const u32x2*)p; return (f32x4){__builtin_bit_cast(float, w.x << 16), __builtin_bit_cast(float, w.x & 0xffff0000u), __builtin_bit_cast(float, w.y << 16), __builtin_bit_cast(float, w.y & 0xffff0000u)}; }
__device__ __forceinline__ void p7_rows(Frame& F) {
    const float* x = F.in[0]; const float* pnm = F.in[22]; const float* pre = F.in[23]; const float* mod = (const float*)(F.ws + WS_MOD);
    const bf16_t* Y = (const bf16_t*)(F.ws + WS_Y); bf16_t* H = (bf16_t*)(F.ws + WS_H);
    const int gw = F.bid * 8 + F.wave, NGW = F.G * 8;
    for (int rb = gw; rb < M / 16; rb += NGW) {
        const int b = (rb * 16) >> 12; f32x4 A1[4], G2[4], S2[4];
#pragma unroll
        for (int j = 0; j < 4; ++j) { const int k = 4 * F.lane + 256 * j;
            A1[j] = *(const f32x4*)(pnm + k) * (*(const f32x4*)(mod + b * NMOD + 2048 + k) + 1.0f);
            G2[j] = *(const f32x4*)(pre + k) * (*(const f32x4*)(mod + b * NMOD + 4096 + k) + 1.0f);
            S2[j] = *(const f32x4*)(mod + b * NMOD + 3072 + k); }
#pragma unroll 2
        for (int rr = 0; rr < 16; ++rr) { const size_t row = (size_t)rb * 16 + rr;
            const f32x4* xr = (const f32x4*)(x + row * DM) + F.lane; const bf16_t* yr = Y + row * DM + 4 * F.lane;
            f32x4 xv[4], yv[4]; float s = 0.f;
#pragma unroll
            for (int j = 0; j < 4; ++j) { xv[j] = xr[64 * j]; yv[j] = ld_bf16x4(yr + 256 * j); s += (yv[j].x * yv[j].x + yv[j].y * yv[j].y) + (yv[j].z * yv[j].z + yv[j].w * yv[j].w); }
            const float rstd = rsqrtf(wave_sum(s) * (1.0f / DM) + EPS); float s2 = 0.f;
#pragma unroll
            for (int j = 0; j < 4; ++j) { xv[j] = xv[j] + A1[j] * (yv[j] * rstd); s2 += (xv[j].x * xv[j].x + xv[j].y * xv[j].y) + (xv[j].z * xv[j].z + xv[j].w * xv[j].w); }
            const float rstd2 = rsqrtf(wave_sum(s2) * (1.0f / DM) + EPS);
            unsigned long long* o8 = (unsigned long long*)(H + row * DM) + F.lane;
#pragma unroll
            for (int j = 0; j < 4; ++j) { const f32x4 h = xv[j] * rstd2 * G2[j] + S2[j]; o8[64 * j] = (unsigned long long)pk2(h.x, h.y) | ((unsigned long long)pk2(h.z, h.w) << 32); } }
    }
}
__device__ __forceinline__ void p10_rows(Frame& F, float* out) {
    const float* x = F.in[0]; const float* pnm1 = F.in[22]; const float* pnm2 = F.in[26]; const float* mod = (const float*)(F.ws + WS_MOD);
    const bf16_t* Y = (const bf16_t*)(F.ws + WS_Y); const bf16_t* Y2 = (const bf16_t*)(F.ws + WS_Y2);
    const int gw = F.bid * 8 + F.wave, NGW = F.G * 8;
    for (int rb = gw; rb < M / 16; rb += NGW) {
        const int b = (rb * 16) >> 12; f32x4 A1[4], A2[4];
#pragma unroll
        for (int j = 0; j < 4; ++j) { const int k = 4 * F.lane + 256 * j;
            A1[j] = *(const f32x4*)(pnm1 + k) * (*(const f32x4*)(mod + b * NMOD + 2048 + k) + 1.0f);
            A2[j] = *(const f32x4*)(pnm2 + k) * (*(const f32x4*)(mod + b * NMOD + 5120 + k) + 1.0f); }
#pragma unroll 2
        for (int rr = 0; rr < 16; ++rr) { const size_t row = (size_t)rb * 16 + rr;
            const f32x4* xr = (const f32x4*)(x + row * DM) + F.lane; const bf16_t* yr = Y + row * DM + 4 * F.lane; const bf16_t* y2r = Y2 + row * DM + 4 * F.lane;
            f32x4 xv[4], yv[4], zv[4]; float s = 0.f, s2 = 0.f;
#pragma unroll
            for (int j = 0; j < 4; ++j) { xv[j] = xr[64 * j]; yv[j] = ld_bf16x4(yr + 256 * j); zv[j] = ld_bf16x4(y2r + 256 * j);
                s += (yv[j].x * yv[j].x + yv[j].y * yv[j].y) + (yv[j].z * yv[j].z + yv[j].w * yv[j].w); s2 += (zv[j].x * zv[j].x + zv[j].y * zv[j].y) + (zv[j].z * zv[j].z + zv[j].w * zv[j].w); }
            const float rstd = rsqrtf(wave_sum(s) * (1.0f / DM) + EPS), rstd2 = rsqrtf(wave_sum(s2) * (1.0f / DM) + EPS);
            f32x4* orow = (f32x4*)(out + row * DM) + F.lane;
#pragma unroll
            for (int j = 0; j < 4; ++j) orow[64 * j] = (xv[j] + A1[j] * (yv[j] * rstd)) + A2[j] * (zv[j] * rstd2); }
    }
}

constexpr int RNN_WL = 11264, RNN_PART_OFF = 8 * RNN_WL;
template <int PASS> __device__ __forceinline__ void rnn_item(Frame& F, int b, int chunk) {
    const int n = F.wave, lane = F.lane, ch = 64 * n + lane, fr = lane & 15, fq = lane >> 4;
    LAS unsigned char* wl = F.lds + n * RNN_WL;
    LAS bf16_t* xcb = (LAS bf16_t*)wl; LAS float* Ab = (LAS float*)(wl + 2304); LAS float* Gb = (LAS float*)(wl + 6656);
    LAS float* part = (LAS float*)(F.lds + RNN_PART_OFF);
    const float* conv_w = F.in[6]; const float cw0 = conv_w[ch], cw1 = conv_w[512 + ch], cw2 = conv_w[1024 + ch], cw3 = conv_w[1536 + ch], cb = F.in[7][ch];
    const bf16_t* WA = (const bf16_t*)(F.ws + WS_WAT) + n * 4096; const bf16_t* WX = (const bf16_t*)(F.ws + WS_WXT) + n * 4096;
    bf16x8 waf[4][2], wxf[4][2];
    if (PASS == 1) {
#pragma unroll
        for (int nb = 0; nb < 4; ++nb) {
#pragma unroll
            for (int ks = 0; ks < 2; ++ks) { waf[nb][ks] = *(const bf16x8*)(WA + (16 * nb + fr) * 64 + 32 * ks + 8 * fq); wxf[nb][ks] = *(const bf16x8*)(WX + (16 * nb + fr) * 64 + 32 * ks + 8 * fq); } } }
    const float* pba = F.in[9] + 64 * n + 4 * fq; const float* pbx = F.in[11] + 64 * n + 4 * fq; const float* plc = (const float*)(F.ws + WS_LRUC) + 64 * n + 4 * fq;
    const bf16_t* XR = (const bf16_t*)(F.ws + WS_XRNN); const bf16_t* GR = (const bf16_t*)(F.ws + WS_GRNN); bf16_t* YC = (bf16_t*)(F.ws + WS_YCAT);
    unsigned* RG = (unsigned*)(F.ws + WS_RG);
    const int t0 = chunk * 64; const size_t rowbase = (size_t)b * SEQ;
    float xm3 = 0.f, xm2 = 0.f, xm1 = 0.f;
    if (chunk > 0) { xm3 = bf2f(XR[(rowbase + t0 - 3) * 512 + ch]); xm2 = bf2f(XR[(rowbase + t0 - 2) * 512 + ch]); xm1 = bf2f(XR[(rowbase + t0 - 1) * 512 + ch]); }
    float h = 0.f, ap = 1.f;
    float* RA = (float*)(F.ws + WS_RA); float* RH = (float*)(F.ws + WS_RH);
    if (PASS == 2) h = ((const float*)(F.ws + WS_RHIN))[(size_t)(b * 64 + chunk) * 512 + ch];
    bf16_t xnext[16], gnext[16]; unsigned rgnext[16];
#pragma unroll
    for (int tt = 0; tt < 16; ++tt) { xnext[tt] = XR[(rowbase + t0 + tt) * 512 + ch];
        gnext[tt] = (PASS == 2) ? GR[(rowbase + t0 + tt) * 512 + ch] : (bf16_t)0; rgnext[tt] = (PASS == 2) ? RG[(rowbase + t0 + tt) * 512 + ch] : 0u; }
    for (int sub = 0; sub < 4; ++sub) {
        float xc[16]; const size_t r0 = rowbase + t0 + 16 * sub;
        bf16_t xcur[16], gcur[16]; unsigned rgcur[16];
#pragma unroll
        for (int tt = 0; tt < 16; ++tt) { xcur[tt] = xnext[tt]; gcur[tt] = gnext[tt]; rgcur[tt] = rgnext[tt]; }
        if (sub < 3) {
#pragma unroll
            for (int tt = 0; tt < 16; ++tt) { xnext[tt] = XR[(r0 + 16 + tt) * 512 + ch]; if (PASS == 2) { gnext[tt] = GR[(r0 + 16 + tt) * 512 + ch]; rgnext[tt] = RG[(r0 + 16 + tt) * 512 + ch]; } } }
#pragma unroll
        for (int tt = 0; tt < 16; ++tt) { const float xv = bf2f(xcur[tt]); xc[tt] = cb + cw0 * xm3 + cw1 * xm2 + cw2 * xm1 + cw3 * xv; xm3 = xm2; xm2 = xm1; xm1 = xv;
            if (PASS == 1) xcb[tt * 72 + lane] = (bf16_t)f2bf(xc[tt]); }
        float y[16];
        if (PASS == 1) {
            LDS_FENCE();
            bf16x8 xb[2];
#pragma unroll
            for (int ks = 0; ks < 2; ++ks) xb[ks] = *(const LAS bf16x8*)(xcb + fr * 72 + 32 * ks + 8 * fq);
            asm volatile("" : "+v"(pba), "+v"(pbx), "+v"(plc));
#pragma unroll
            for (int nb = 0; nb < 4; ++nb) { f32x4 aA = {0.f, 0.f, 0.f, 0.f}, aX = {0.f, 0.f, 0.f, 0.f};
                const f32x4 ba4n = *(const f32x4*)(pba + 16 * nb), bx4n = *(const f32x4*)(pbx + 16 * nb), lc4n = *(const f32x4*)(plc + 16 * nb);
#pragma unroll
                for (int ks = 0; ks < 2; ++ks) { aA = __builtin_amdgcn_mfma_f32_16x16x32_bf16(waf[nb][ks], xb[ks], aA, 0, 0, 0); aX = __builtin_amdgcn_mfma_f32_16x16x32_bf16(wxf[nb][ks], xb[ks], aX, 0, 0, 0); }
                f32x4 av, gv; u32x4 pk;
#pragma unroll
                for (int e = 0; e < 4; ++e) { const float rr = sigmoidf_(aA[e] + ba4n[e]), ii = sigmoidf_(aX[e] + bx4n[e]); const float la = lc4n[e] * rr;
                    const float em1 = expm1_small(la); av[e] = 1.0f + em1; gv[e] = __builtin_amdgcn_sqrtf(fmaxf(-em1 * (2.0f + em1), 0.f)) * ii; pk[e] = pk2(la, gv[e]); }
                *(LAS f32x4*)(Ab + fr * 68 + 16 * nb + 4 * fq) = av; *(LAS f32x4*)(Gb + fr * 68 + 16 * nb + 4 * fq) = gv;
                *(u32x4*)(RG + (r0 + fr) * 512 + 64 * n + 16 * nb + 4 * fq) = pk; }
            LDS_FENCE();
#pragma unroll
            for (int tt = 0; tt < 16; ++tt) { const float a = Ab[tt * 68 + lane], gg = Gb[tt * 68 + lane]; h = a * h + gg * xc[tt]; ap *= a; }
            LDS_FENCE();
        } else {
#pragma unroll
            for (int tt = 0; tt < 16; ++tt) { const float la = __builtin_bit_cast(float, rgcur[tt] << 16), gg = __builtin_bit_cast(float, rgcur[tt] & 0xffff0000u);
                const float a = 1.0f + expm1_small(la); h = a * h + gg * xc[tt]; y[tt] = h * gelu_tanh(bf2f(gcur[tt])); }
#pragma unroll
            for (int tt = 0; tt < 16; ++tt) Ab[tt * 68 + lane] = y[tt] * y[tt];
            LDS_FENCE();
            { const LAS float* rp = Ab + fr * 68 + 16 * fq; const f32x4 a0 = *(const LAS f32x4*)(rp), a1 = *(const LAS f32x4*)(rp + 4), a2 = *(const LAS f32x4*)(rp + 8), a3 = *(const LAS f32x4*)(rp + 12);
              float v = ((a0.x + a0.y) + (a0.z + a0.w)) + ((a1.x + a1.y) + (a1.z + a1.w)) + ((a2.x + a2.y) + (a2.z + a2.w)) + ((a3.x + a3.y) + (a3.z + a3.w));
              v += __shfl_xor(v, 16); v += __shfl_xor(v, 32);
              if (lane < 16) part[((sub & 1) * 8 + n) * 16 + lane] = v; }
            __syncthreads();
#pragma unroll
            for (int tt = 0; tt < 16; ++tt) { float tot = 0.f;
#pragma unroll
                for (int w = 0; w < 8; ++w) tot += part[((sub & 1) * 8 + w) * 16 + tt];
                const float rstd = rsqrtf(tot * (1.0f / 512.0f) + EPS);
                YC[(r0 + tt) * 1024 + ch] = (bf16_t)f2bf(y[tt] * rstd); }
        }
    }
    if (PASS == 1) { const size_t o = (size_t)(b * 64 + chunk) * 512 + ch; RA[o] = ap; RH[o] = h; }
    if (PASS == 2) __syncthreads();
}

__device__ __forceinline__ void cmp2_item(Frame& F, int item) {
    const int mat = item >> 8, rb = item & 255, lane = F.lane, fr = lane & 15, fq = lane >> 4;
    const int R0 = 16 * rb + fr, R1 = ((R0 & 255) < 255) ? R0 + 1 : R0;
    const bf16_t* P = (const bf16_t*)(F.ws + WS_CP) + (size_t)mat * 4 * 4096 * 512; const float* cb = (const float*)(F.ws + WS_CB1) + mat * 256;
    const bf16_t* W2 = (const bf16_t*)(F.ws + (mat ? WS_CW2VT : WS_CW2KT)) + (size_t)fr * 256 + 8 * fq;
    f32x4 acc[4];
#pragma unroll
    for (int nb = 0; nb < 4; ++nb) acc[nb] = (f32x4){0.f, 0.f, 0.f, 0.f};
#pragma unroll 1
    for (int kp = 0; kp < 4; ++kp) {
        u32x4 pa[2][4], pc[2][4]; bf16x8 wf[2][4]; f32x4 cb0[2], cb1[2];
#pragma unroll
        for (int q = 0; q < 2; ++q) { const int ks = 2 * kp + q, n0 = 32 * ks + 8 * fq;
            cb0[q] = *(const f32x4*)(cb + n0); cb1[q] = *(const f32x4*)(cb + n0 + 4);
#pragma unroll
            for (int k4 = 0; k4 < 4; ++k4) { pa[q][k4] = *(const u32x4*)(P + ((size_t)k4 * 4096 + R0) * 512 + n0); pc[q][k4] = *(const u32x4*)(P + ((size_t)k4 * 4096 + R1) * 512 + 256 + n0); }
#pragma unroll
            for (int nb = 0; nb < 4; ++nb) wf[q][nb] = *(const bf16x8*)(W2 + (size_t)(16 * nb) * 256 + 32 * ks); }
        __builtin_amdgcn_sched_barrier(0);
#pragma unroll
        for (int q = 0; q < 2; ++q) { f32x4 h0 = cb0[q], h1 = cb1[q];
#pragma unroll
            for (int k4 = 0; k4 < 4; ++k4) { const u32x4 a = pa[q][k4], c = pc[q][k4];
                h0 += (f32x4){__builtin_bit_cast(float, a.x << 16), __builtin_bit_cast(float, a.x & 0xffff0000u), __builtin_bit_cast(float, a.y << 16), __builtin_bit_cast(float, a.y & 0xffff0000u)}
                    + (f32x4){__builtin_bit_cast(float, c.x << 16), __builtin_bit_cast(float, c.x & 0xffff0000u), __builtin_bit_cast(float, c.y << 16), __builtin_bit_cast(float, c.y & 0xffff0000u)};
                h1 += (f32x4){__builtin_bit_cast(float, a.z << 16), __builtin_bit_cast(float, a.z & 0xffff0000u), __builtin_bit_cast(float, a.w << 16), __builtin_bit_cast(float, a.w & 0xffff0000u)}
                    + (f32x4){__builtin_bit_cast(float, c.z << 16), __builtin_bit_cast(float, c.z & 0xffff0000u), __builtin_bit_cast(float, c.w << 16), __builtin_bit_cast(float, c.w & 0xffff0000u)}; }
            u32x4 hw; hw.x = pk2(gelu_tanh(h0[0]), gelu_tanh(h0[1])); hw.y = pk2(gelu_tanh(h0[2]), gelu_tanh(h0[3])); hw.z = pk2(gelu_tanh(h1[0]), gelu_tanh(h1[1])); hw.w = pk2(gelu_tanh(h1[2]), gelu_tanh(h1[3]));
            const bf16x8 hb = __builtin_bit_cast(bf16x8, hw);
#pragma unroll
            for (int nb = 0; nb < 4; ++nb) acc[nb] = __builtin_amdgcn_mfma_f32_16x16x32_bf16(wf[q][nb], hb, acc[nb], 0, 0, 0); }
        __builtin_amdgcn_sched_barrier(0);
    }
    const int R = 16 * rb + fr;
    if (mat == 0) { bf16_t* O = (bf16_t*)(F.ws + WS_KCMP) + (size_t)R * 64 + 4 * fq;
#pragma unroll
        for (int nb = 0; nb < 4; ++nb) { u32x2 w; w.x = pk2(acc[nb][0], acc[nb][1]); w.y = pk2(acc[nb][2], acc[nb][3]); *(u32x2*)(O + 16 * nb) = w; }
    } else { const int bg = R >> 8, c = R & 255; bf16_t* O = (bf16_t*)(F.ws + WS_VCMPT) + (size_t)bg * 64 * 256 + c;
#pragma unroll
        for (int nb = 0; nb < 4; ++nb)
#pragma unroll
            for (int e = 0; e < 4; ++e) O[(size_t)(16 * nb + 4 * fq + e) * 256] = (bf16_t)f2bf(acc[nb][e]); }
}

constexpr int AT_BUF = 35840, AT_K1 = 9216, AT_V0 = 18432, AT_V1 = 27136, AT_IMP = 2 * AT_BUF, AT_IMP_BYTES = 8 * 32 * 65 * 4;
constexpr int AT_SELM = AT_IMP + AT_IMP_BYTES, AT_UNION = AT_SELM + 512, AT_SSQ = AT_UNION + 16, AT_SC = AT_SSQ + 1024;
static_assert(AT_SC + 4096 <= LDS_MISC, "attention LDS map");
__device__ __forceinline__ unsigned cvtpk(float lo, float hi) { f32x2_t v = {lo, hi}; bf16x2_t b = __builtin_convertvector(v, bf16x2_t); return __builtin_bit_cast(unsigned, b); }
__device__ __forceinline__ float xor32(float x, int hi) { auto rr = __builtin_amdgcn_permlane32_swap(__builtin_bit_cast(unsigned, x), __builtin_bit_cast(unsigned, x), false, false);
    return __builtin_bit_cast(float, hi ? rr[0] : rr[1]); }
struct TileSrc { const bf16_t* k0; const bf16_t* k1; const bf16_t* v0; const bf16_t* v1; };
__device__ __forceinline__ void at_load(u32x4 (&st)[4], const TileSrc& s, int vpitch, int tid) {
    st[0] = *(const u32x4*)(s.k0 + tid * 8); st[1] = *(const u32x4*)(s.k1 + tid * 8);
    const int dim = tid >> 3, part = tid & 7;
    st[2] = *(const u32x4*)(s.v0 + (size_t)dim * vpitch + part * 8); st[3] = *(const u32x4*)(s.v1 + (size_t)dim * vpitch + part * 8);
}
__device__ __forceinline__ void at_store(LAS unsigned char* buf, const u32x4 (&st)[4], int tid) {
    const int key = tid >> 3, part = tid & 7;
    *(LAS u32x4*)(buf + key * 144 + part * 16) = st[0];
    *(LAS u32x4*)(buf + AT_K1 + key * 144 + part * 16) = st[1];
    LAS unsigned char* v0 = buf + AT_V0 + key * 136 + part * 16; LAS unsigned char* v1 = buf + AT_V1 + key * 136 + part * 16;
    *(LAS u32x2*)(v0) = (u32x2){st[2].x, st[2].y}; *(LAS u32x2*)(v0 + 8) = (u32x2){st[2].z, st[2].w};
    *(LAS u32x2*)(v1) = (u32x2){st[3].x, st[3].y}; *(LAS u32x2*)(v1 + 8) = (u32x2){st[3].z, st[3].w};
}
__device__ __forceinline__ void at_qk(f32x16 (&s)[2], const LAS unsigned char* kb, const bf16x8 (&qf)[4], const bf16x8 qx, const bf16x8 (&kx)[2], int r32, int hi) {
    bf16x8 kf[2][4];
#pragma unroll
    for (int kb2 = 0; kb2 < 2; ++kb2)
#pragma unroll
        for (int ks = 0; ks < 4; ++ks) kf[kb2][ks] = *(const LAS bf16x8*)(kb + (32 * kb2 + r32) * 144 + (16 * ks + 8 * hi) * 2);
    __builtin_amdgcn_sched_barrier(0);
    f32x16 a0 = {}, a1 = {};
    a0 = __builtin_amdgcn_mfma_f32_32x32x16_bf16(kx[0], qx, a0, 0, 0, 0);
    a1 = __builtin_amdgcn_mfma_f32_32x32x16_bf16(kx[1], qx, a1, 0, 0, 0);
#pragma unroll
    for (int ks = 0; ks < 4; ++ks) { a0 = __builtin_amdgcn_mfma_f32_32x32x16_bf16(kf[0][ks], qf[ks], a0, 0, 0, 0); a1 = __builtin_amdgcn_mfma_f32_32x32x16_bf16(kf[1][ks], qf[ks], a1, 0, 0, 0); }
    s[0] = a0; s[1] = a1;
    __builtin_amdgcn_sched_barrier(0);
}
template <int MASK  >
__device__ __forceinline__ void at_keymask(f32x16 (&s)[2], int lim, int hi) {
    if (MASK) { const int limh = lim - 4 * hi;
#pragma unroll
        for (int kb2 = 0; kb2 < 2; ++kb2)
#pragma unroll
            for (int r = 0; r < 16; ++r) { const int kc = 32 * kb2 + (r & 3) + 8 * (r >> 2); const bool ok = (MASK == 1) ? (kc <= limh) : (kc >= limh); s[kb2][r] = ok ? s[kb2][r] : NEGF; } }
}
__device__ __forceinline__ float at_max(const f32x16 (&s)[2], int hi) {
    float mx = fmaxf(s[0][0], s[1][0]);
#pragma unroll
    for (int r = 1; r < 16; ++r) mx = fmaxf(fmaxf(mx, s[0][r]), s[1][r]);
    return fmaxf(mx, xor32(mx, hi));
}
__device__ __forceinline__ void at_pv(f32x16 (&O)[2], const LAS unsigned char* vb, const f32x16 (&p)[2], int r32, int hi) {
    u32x2 vlo[2][2][2], vhi[2][2][2];
#pragma unroll
    for (int kb2 = 0; kb2 < 2; ++kb2)
#pragma unroll
        for (int s2 = 0; s2 < 2; ++s2)
#pragma unroll
            for (int db = 0; db < 2; ++db) { const LAS unsigned char* va = vb + (32 * db + r32) * 136 + (32 * kb2 + 16 * s2 + 4 * hi) * 2;
                vlo[kb2][s2][db] = *(const LAS u32x2*)(va); vhi[kb2][s2][db] = *(const LAS u32x2*)(va + 16); }
    bf16x8 pf[2][2];
#pragma unroll
    for (int kb2 = 0; kb2 < 2; ++kb2)
#pragma unroll
        for (int s2 = 0; s2 < 2; ++s2) { u32x4 pw; pw.x = cvtpk(p[kb2][8 * s2 + 0], p[kb2][8 * s2 + 1]); pw.y = cvtpk(p[kb2][8 * s2 + 2], p[kb2][8 * s2 + 3]); pw.z = cvtpk(p[kb2][8 * s2 + 4], p[kb2][8 * s2 + 5]); pw.w = cvtpk(p[kb2][8 * s2 + 6], p[kb2][8 * s2 + 7]);
            pf[kb2][s2] = __builtin_bit_cast(bf16x8, pw); }
    __builtin_amdgcn_sched_barrier(0);
#pragma unroll
    for (int kb2 = 0; kb2 < 2; ++kb2)
#pragma unroll
        for (int s2 = 0; s2 < 2; ++s2)
#pragma unroll
            for (int db = 0; db < 2; ++db) { const bf16x8 vf = __builtin_bit_cast(bf16x8, (u32x4){vlo[kb2][s2][db].x, vlo[kb2][s2][db].y, vhi[kb2][s2][db].x, vhi[kb2][s2][db].y});
                O[db] = __builtin_amdgcn_mfma_f32_32x32x16_bf16(vf, pf[kb2][s2], O[db], 0, 0, 0); }
    __builtin_amdgcn_sched_barrier(0);
}
__device__ __forceinline__ void at_online(int mode, f32x16 (&s)[2], float& m, float& l, f32x16 (&O)[2], const LAS unsigned char* vb, float ctile, bool rowok, int lim, int r32, int hi) {
    if (mode == 1) at_keymask<1>(s, lim, hi); else if (mode == 2) at_keymask<2>(s, lim, hi);
    const float tmx = at_max(s, hi); const float mt = rowok ? tmx + ctile : NEGF; const float mn = fmaxf(m, mt);
    if (__any(mn > m)) { const float f = __builtin_amdgcn_exp2f(m - mn); l *= f;
#pragma unroll
        for (int db = 0; db < 2; ++db)
#pragma unroll
            for (int r = 0; r < 16; ++r) O[db][r] *= f; }
    m = mn;
    const float shift = rowok ? mn - ctile : __builtin_inff(); float ps = 0.f;
#pragma unroll
    for (int kb2 = 0; kb2 < 2; ++kb2)
#pragma unroll
        for (int r = 0; r < 16; ++r) { const float p = __builtin_amdgcn_exp2f(s[kb2][r] - shift); s[kb2][r] = p; ps += p; }
    l += ps;
    at_pv(O, vb, s, r32, hi);
}

__device__ __forceinline__ void attn_item(Frame& F, int b, int i) {
    const int tid = F.tid, lane = F.lane, h = F.wave, g = h >> 2, r32 = lane & 31, hi = lane >> 5;
    const int q0 = 32 * i, tq = q0 + r32; const size_t row = (size_t)b * SEQ + tq;
    LAS unsigned char* lds = F.lds;
    LAS float* IMP = (LAS float*)(lds + AT_IMP); LAS unsigned long long* SELM = (LAS unsigned long long*)(lds + AT_SELM);
    LAS unsigned* UNI = (LAS unsigned*)(lds + AT_UNION); LAS float* SSQ = (LAS float*)(lds + AT_SSQ); LAS float* SC = (LAS float*)(lds + AT_SC);
    const bf16_t* Qp = (const bf16_t*)(F.ws + WS_Q) + row * 512 + h * 64 + 8 * hi;
    bf16x8 qf[4];
#pragma unroll
    for (int ks = 0; ks < 4; ++ks) qf[ks] = *(const bf16x8*)(Qp + 16 * ks);
    const float slope2 = __builtin_amdgcn_exp2f(-(float)(h + 1)) * LOG2E;
    bf16x8 qx, qx16, kx[2];
    { const unsigned s_hi = f2bf(slope2); const float rem = slope2 - __builtin_bit_cast(float, s_hi << 16); const unsigned w1 = hi ? 0u : (s_hi | (f2bf(rem) << 16));
      const float sl16 = 16.0f * slope2; const unsigned t_hi = f2bf(sl16); const float rem16 = sl16 - __builtin_bit_cast(float, t_hi << 16); const unsigned w16 = hi ? 0u : (t_hi | (f2bf(rem16) << 16));
      qx = __builtin_bit_cast(bf16x8, (u32x4){w1, 0u, 0u, 0u}); qx16 = __builtin_bit_cast(bf16x8, (u32x4){w16, 0u, 0u, 0u});
#pragma unroll
      for (int kb2 = 0; kb2 < 2; ++kb2) { const unsigned kk = f2bf((float)(32 * kb2 + r32)); kx[kb2] = __builtin_bit_cast(bf16x8, (u32x4){hi ? 0u : (kk | (kk << 16)), 0u, 0u, 0u}); } }
    const float* GT = (const float*)(F.ws + WS_GATE) + row * 24; const float gate_c = GT[h], gate_s = GT[8 + h], gate_w = GT[16 + h];
    f32x16 out[2]; out[0] = f32x16{}; out[1] = f32x16{};
    if (tid < 4) UNI[tid] = 0u;
    const int koff = g ? AT_K1 : 0, voff = g ? AT_V1 : AT_V0;
    const size_t bg0 = (size_t)b * 2;
    u32x4 st[4];
    const bf16_t* KVb = (const bf16_t*)(F.ws + WS_KV);
    const int jhi = q0 >> 6, dlim = tq - 64 * jhi;
#define KV_SRC(kidx, j) TileSrc{KVb + (size_t)(kidx) * (KV_STRIDE / 2) + ((bg0 + 0) * 4096 + 64 * (j)) * 64, KVb + (size_t)(kidx) * (KV_STRIDE / 2) + ((bg0 + 1) * 4096 + 64 * (j)) * 64, \
        KVb + (size_t)((kidx) + 1) * (KV_STRIDE / 2) + (bg0 + 0) * 64 * 4096 + 64 * (j), KVb + (size_t)((kidx) + 1) * (KV_STRIDE / 2) + (bg0 + 1) * 64 * 4096 + 64 * (j)}
    const bf16_t* KC = (const bf16_t*)(F.ws + WS_KCMP); const bf16_t* VC = (const bf16_t*)(F.ws + WS_VCMPT);
    const int nc = (i >> 5) + 1;
#define CMP_SRC(jc) TileSrc{KC + ((bg0 + 0) * 256 + 64 * (jc)) * 64, KC + ((bg0 + 1) * 256 + 64 * (jc)) * 64, VC + (bg0 + 0) * 64 * 256 + 64 * (jc), VC + (bg0 + 1) * 64 * 256 + 64 * (jc)}
    float m = NEGF, l = 0.f;
    {
        f32x16 O[2]; O[0] = f32x16{}; O[1] = f32x16{}; float carry = 0.f; float mref[4] = {0.f, 0.f, 0.f, 0.f};
        { at_load(st, CMP_SRC(0), 256, tid); at_store(lds, st, tid); __syncthreads(); }
#pragma unroll
        for (int jc = 0; jc < 4; ++jc) { if (jc < nc) {
            LAS unsigned char* buf = lds + (jc & 1) * AT_BUF; const bool more = jc + 1 < nc;
            if (more) at_load(st, CMP_SRC(jc + 1), 256, tid); else at_load(st, KV_SRC(2, jhi), 4096, tid);
            f32x16 s[2]; at_qk(s, buf + koff, qf, qx16, kx, r32, hi);
            const float mprev = m;
            at_online((jc + 2 >= nc) ? 1 : 0, s, m, l, O, buf + voff, slope2 * (float)(1024 * jc + 31 - tq), true, ((tq - 31) >> 4) - 64 * jc, r32, hi);
            mref[jc] = m; carry *= __builtin_amdgcn_exp2f(mprev - m);
            float sum4[8], recv[8];
#pragma unroll
            for (int g8 = 0; g8 < 8; ++g8) { const int kb2 = g8 >> 2, qq = g8 & 3; sum4[g8] = (s[kb2][4 * qq] + s[kb2][4 * qq + 1]) + (s[kb2][4 * qq + 2] + s[kb2][4 * qq + 3]); recv[g8] = xor32(s[kb2][4 * qq + 3], hi); }
#pragma unroll
            for (int g8 = 0; g8 < 8; ++g8) { const float extra = hi ? recv[g8] : (g8 ? recv[g8 > 0 ? g8 - 1 : 0] : carry);
                IMP[(h * 32 + r32) * 65 + 16 * jc + 2 * g8 + hi] = sum4[g8] + extra; }
            carry = recv[7];
            if (more) at_store(lds + ((jc + 1) & 1) * AT_BUF, st, tid);
            __syncthreads();
        } }
        const float ltot = l + xor32(l, hi); const float inv = (tq >= 31) ? __builtin_amdgcn_rcpf(ltot) : 0.f;
        if (hi == 0) {
#pragma unroll
            for (int jc = 0; jc < 4; ++jc) SC[(h * 32 + r32) * 4 + jc] = (jc < nc) ? __builtin_amdgcn_exp2f(mref[jc] - m) * inv : 0.f; }
        const float oc = gate_c * inv;
#pragma unroll
        for (int db = 0; db < 2; ++db)
#pragma unroll
            for (int r = 0; r < 16; ++r) out[db][r] = oc * O[db][r];
        __syncthreads();
    }
#undef CMP_SRC
    LAS float* PARK = (LAS float*)(lds + AT_IMP) + (size_t)h * 2048 + lane;
    {
        unsigned long long un0 = 0ull, un1 = 0ull;
        for (int pp = 0; pp < 8; ++pp) { const int g2 = pp >> 2, q = 4 * h + (pp & 3), t = q0 + q, cur_t = t >> 6;
            float v = 0.f;
#pragma unroll
            for (int hh = 0; hh < 4; ++hh) v += IMP[((4 * g2 + hh) * 32 + q) * 65 + lane] * SC[((4 * g2 + hh) * 32 + q) * 4 + (lane >> 4)];
            const bool forced = (lane == 0) || (lane == cur_t) || (lane == cur_t - 1), vis = lane <= cur_t;
            const unsigned key = forced ? (0x7f000000u | (unsigned)(63 - lane)) : (vis ? ((__builtin_bit_cast(unsigned, v) & ~63u) | (unsigned)(63 - lane)) : 0u);
            int rank = 0;
            if (cur_t >= 16) {
#pragma unroll
                for (int jj = 0; jj < 64; ++jj) { const unsigned o = (unsigned)__builtin_amdgcn_readlane((int)key, jj); rank += (o > key) ? 1 : 0; } }
            const unsigned long long mask = __ballot((rank < 16) && vis);
            if (lane == 0) SELM[g2 * 32 + q] = mask;
            if (g2) un1 |= mask; else un0 |= mask; }
        if (lane == 0) { atomicOr((unsigned*)&UNI[0], (unsigned)un0); atomicOr((unsigned*)&UNI[1], (unsigned)(un0 >> 32)); atomicOr((unsigned*)&UNI[2], (unsigned)un1); atomicOr((unsigned*)&UNI[3], (unsigned)(un1 >> 32)); }
        __syncthreads();
    }
#pragma unroll
    for (int db = 0; db < 2; ++db)
#pragma unroll
        for (int r = 0; r < 16; ++r) PARK[(db * 16 + r) * 64] = out[db][r];
    {
        const unsigned u0 = __builtin_amdgcn_readfirstlane(UNI[0]), u1 = __builtin_amdgcn_readfirstlane(UNI[1]), u2 = __builtin_amdgcn_readfirstlane(UNI[2]), u3 = __builtin_amdgcn_readfirstlane(UNI[3]);
        const unsigned long long U0 = ((unsigned long long)u1 << 32) | u0, U1 = ((unsigned long long)u3 << 32) | u2, Ug = g ? U1 : U0;
        unsigned long long rem = U0 | U1;
        const unsigned long long mysel = SELM[g * 32 + r32];
        m = NEGF; l = 0.f; f32x16 O[2]; O[0] = f32x16{}; O[1] = f32x16{};
        int j = 63 - __builtin_clzll(rem); rem &= ~(1ull << j);
        { at_store(lds, st, tid); __syncthreads(); }
        int par = 0;
        for (;;) {
            LAS unsigned char* buf = lds + par * AT_BUF; const bool more = rem != 0ull; const int jn = more ? 63 - __builtin_clzll(rem) : 0; rem &= ~(1ull << jn);
            if (more) at_load(st, KV_SRC(2, jn), 4096, tid); else at_load(st, KV_SRC(4, jhi), 4096, tid);
            if ((Ug >> j) & 1ull) { f32x16 s[2]; at_qk(s, buf + koff, qf, qx, kx, r32, hi);
                const float ctile = slope2 * (float)(64 * j - tq); const bool rowok = ((mysel >> j) & 1ull) != 0ull;
                at_online(j == jhi ? 1 : 0, s, m, l, O, buf + voff, ctile, rowok, dlim, r32, hi); }
            if (more) at_store(lds + (par ^ 1) * AT_BUF, st, tid);
            __syncthreads();
            if (!more) break;
            j = jn; par ^= 1;
        }
        const float ltot = l + xor32(l, hi); const float sc = gate_s * __builtin_amdgcn_rcpf(ltot);
#pragma unroll
        for (int db = 0; db < 2; ++db)
#pragma unroll
            for (int r = 0; r < 16; ++r) PARK[(db * 16 + r) * 64] += sc * O[db][r];
    }
    {
        int jlo = (q0 - 511) >> 6; if (jlo < 0) jlo = 0;
        const int llim = tq - 511 - 64 * jlo;
        m = NEGF; l = 0.f; f32x16 O[2]; O[0] = f32x16{}; O[1] = f32x16{};
        { at_store(lds, st, tid); __syncthreads(); }
        for (int j = jhi; j >= jlo; --j) {
            LAS unsigned char* buf = lds + ((jhi - j) & 1) * AT_BUF; const bool more = j > jlo;
            if (more) at_load(st, KV_SRC(4, j - 1), 4096, tid);
            f32x16 s[2]; at_qk(s, buf + koff, qf, qx, kx, r32, hi);
            const float ctile = slope2 * (float)(64 * j - tq);
            at_online(j == jhi ? 1 : (j == jlo ? 2 : 0), s, m, l, O, buf + voff, ctile, true, j == jhi ? dlim : llim, r32, hi);
            if (more) at_store(lds + ((jhi - j + 1) & 1) * AT_BUF, st, tid);
            __syncthreads();
        }
        const float ltot = l + xor32(l, hi); const float sc = gate_w * __builtin_amdgcn_rcpf(ltot);
#pragma unroll
        for (int db = 0; db < 2; ++db)
#pragma unroll
            for (int r = 0; r < 16; ++r) out[db][r] = PARK[(db * 16 + r) * 64] + sc * O[db][r];
    }
#undef KV_SRC
    {
        float ss = 0.f;
#pragma unroll
        for (int db = 0; db < 2; ++db)
#pragma unroll
            for (int r = 0; r < 16; ++r) ss += out[db][r] * out[db][r];
        ss += xor32(ss, hi);
        if (hi == 0) SSQ[h * 32 + r32] = ss;
        __syncthreads();
        float tot = 0.f;
#pragma unroll
        for (int hh = 0; hh < 8; ++hh) tot += SSQ[hh * 32 + r32];
        const float rstd = rsqrtf(tot * (1.0f / 512.0f) + EPS);
        bf16_t* yp = (bf16_t*)(F.ws + WS_YCAT) + row * 1024 + 512 + h * 64 + 4 * hi;
#pragma unroll
        for (int db = 0; db < 2; ++db)
#pragma unroll
            for (int qq = 0; qq < 4; ++qq) { u32x2 w; w.x = cvtpk(out[db][4 * qq] * rstd, out[db][4 * qq + 1] * rstd); w.y = cvtpk(out[db][4 * qq + 2] * rstd, out[db][4 * qq + 3] * rstd);
                *(u32x2*)(yp + 32 * db + 8 * qq) = w; }
        __syncthreads();
    }
}

__global__ void __launch_bounds__(512) hybrid_fwd(Args args) {
    extern __shared__ __attribute__((aligned(16))) unsigned char lds_raw[];
    cg::grid_group grid = cg::this_grid();
    Frame F; F.lds = (LAS unsigned char*)lds_raw; F.tid = threadIdx.x; F.lane = F.tid & 63; F.wave = __builtin_amdgcn_readfirstlane(F.tid >> 6);
    F.G = gridDim.x; F.bid = blockIdx.x; F.ws = args.ws; F.in = args.in;
    unsigned char* ws = args.ws;
    volatile LAS unsigned* MISC = (volatile LAS unsigned*)(F.lds + LDS_MISC);
    if (F.tid < 2) MISC[F.tid] = 0u;
    __syncthreads();
    XcdBarrier xbar = xcd_barrier_post((unsigned*)ws, MISC);
    const int wave_u = __builtin_amdgcn_readfirstlane((int)threadIdx.x >> 6);
#define FRESH_TID() fresh_tid2(wave_u)
#define REFRESH() do { F.tid = FRESH_TID(); F.lane = F.tid & 63; F.wave = wave_u; } while (0)
#ifdef PROBE_A
    int nst_ = 0; unsigned long long* tsb_ = (unsigned long long*)(ws + 32768);
#define STAMP() do { if (blockIdx.x == 0 && threadIdx.x == 0) tsb_[nst_] = __builtin_amdgcn_s_memrealtime(); ++nst_; } while (0)
#else
#define STAMP() do {} while (0)
#endif
    STAMP();
#define GRID_BAR() do { xcd_barrier(xbar); REFRESH(); STAMP(); } while (0)
#define GRID_BAR_CG() do { grid.sync(); REFRESH(); STAMP(); } while (0)
    p0_prologue(F);
#ifdef DUP_P0
    __syncthreads(); REFRESH(); p0_prologue(F);
#endif
    if (args.ws == nullptr) grid.sync();
    GRID_BAR();
#ifdef DUP_BAR
    GRID_BAR(); GRID_BAR(); GRID_BAR(); GRID_BAR(); GRID_BAR(); GRID_BAR(); GRID_BAR(); GRID_BAR(); GRID_BAR(); GRID_BAR();
#endif
    p1_rows(F);
#ifdef DUP_P1
    __syncthreads(); REFRESH(); p1_rows(F);
#endif
    GRID_BAR();
    { pg8::Gemm g{(const bf16_t*)(ws + WS_H), (const bf16_t*)(ws + WS_WINT), M, NZ, DM, DM, DM}; pg8::StaticOrder S; S.init(M, NZ, F.G, F.bid);
      EpiZ E{ws}; pg8::gemm_phase<EpiZ, pg8::StaticOrder>(F.lds, g, S, E, FRESH_TID()); }
#ifdef DUP_P2
    __syncthreads(); REFRESH();
    { pg8::Gemm g{(const bf16_t*)(ws + WS_H), (const bf16_t*)(ws + WS_WINT), M, NZ, DM, DM, DM}; pg8::StaticOrder S; S.init(M, NZ, F.G, F.bid);
      EpiZ E{ws}; pg8::gemm_phase<EpiZ, pg8::StaticOrder>(F.lds, g, S, E, FRESH_TID()); }
#endif
    GRID_BAR();
    { for (int n = F.bid; n < 256; n += F.G) { const int mat = n >> 7, pm = (n >> 3) & 15, pn = (n >> 2) & 1, ks = n & 3;
        pg8::Gemm g{(const bf16_t*)(ws + WS_KV + (size_t)mat * KV_STRIDE) + (size_t)pm * 256 * 1024 + ks * 256,
                    (const bf16_t*)(ws + (mat ? WS_CW1VT : WS_CW1KT)) + pn * 1024 + ks * 256, 256, 256, 256, 1024, 2048};
        EpiBf16<0> E{(bf16_t*)(ws + WS_CP) + ((size_t)(mat * 4 + ks) * 4096 + pm * 256) * 512 + pn * 256, 512, nullptr};
        pg8::gemm_phase<EpiBf16<0>, pg8::OneUnit>(F.lds, g, pg8::OneUnit{}, E, FRESH_TID()); }
      __syncthreads(); REFRESH();
      for (int it = F.bid; it < 512; it += F.G) rnn_item<1>(F, it >> 6, it & 63); }
#ifdef DUP_P3
    __syncthreads(); REFRESH();
    { for (int n = F.bid; n < 256; n += F.G) { const int mat = n >> 7, pm = (n >> 3) & 15, pn = (n >> 2) & 1, ks = n & 3;
        pg8::Gemm g{(const bf16_t*)(ws + WS_KV + (size_t)mat * KV_STRIDE) + (size_t)pm * 256 * 1024 + ks * 256,
                    (const bf16_t*)(ws + (mat ? WS_CW1VT : WS_CW1KT)) + pn * 1024 + ks * 256, 256, 256, 256, 1024, 2048};
        EpiBf16<0> E{(bf16_t*)(ws + WS_CP) + ((size_t)(mat * 4 + ks) * 4096 + pm * 256) * 512 + pn * 256, 512, nullptr};
        pg8::gemm_phase<EpiBf16<0>, pg8::OneUnit>(F.lds, g, pg8::OneUnit{}, E, FRESH_TID()); }
      __syncthreads(); REFRESH();
      for (int it = F.bid; it < 512; it += F.G) rnn_item<1>(F, it >> 6, it & 63); }
#endif
    GRID_BAR();
    { const int gw = F.bid * 8 + F.wave, NGW = F.G * 8;
      for (int it = gw; it < 512 + 64; it += NGW) {
          if (it < 512) { cmp2_item(F, it); continue; }
          const int r = it - 512, b = r >> 3, ch = 64 * (r & 7) + F.lane; const float* RA = (const float*)(ws + WS_RA); const float* RH = (const float*)(ws + WS_RH); float* HIN = (float*)(ws + WS_RHIN);
          float h = 0.f;
#pragma unroll 32
          for (int c = 0; c < 64; ++c) { const size_t o = (size_t)(b * 64 + c) * 512 + ch; const float a = RA[o], hh = RH[o]; HIN[o] = h; h = a * h + hh; } } }
#ifdef DUP_P4
    __syncthreads(); REFRESH();
    { const int gw = F.bid * 8 + F.wave, NGW = F.G * 8;
      for (int it = gw; it < 512 + 64; it += NGW) {
          if (it < 512) { cmp2_item(F, it); continue; }
          const int r = it - 512, b = r >> 3, ch = 64 * (r & 7) + F.lane; const float* RA = (const float*)(ws + WS_RA); const float* RH = (const float*)(ws + WS_RH); float* HIN = (float*)(ws + WS_RHIN);
          float h = 0.f;
#pragma unroll 32
          for (int c = 0; c < 64; ++c) { const size_t o = (size_t)(b * 64 + c) * 512 + ch; const float a = RA[o], hh = RH[o]; HIN[o] = h; h = a * h + hh; } } }
#endif
    GRID_BAR();
    { for (int n = F.bid; n < 1024; n += F.G) { const int k = n >> 8, c = n & 255, b = c & 7, r = c >> 3;     const int i = (k == 0) ? r : (k == 1) ? 63 - r : (k == 2) ? 64 + r : 127 - r; attn_item(F, b, i); }
#ifdef DUP_ATT
      __syncthreads(); REFRESH();
      for (int n = F.bid; n < 1024; n += F.G) { const int k = n >> 8, c = n & 255, b = c & 7, r = c >> 3; const int i = (k == 0) ? r : (k == 1) ? 63 - r : (k == 2) ? 64 + r : 127 - r; attn_item(F, b, i); }
#endif
      __syncthreads();
      for (int it = F.bid; it < 512; it += F.G) rnn_item<2>(F, it >> 6, it & 63);
#ifdef DUP_RNN2
      __syncthreads(); REFRESH();
      for (int it = F.bid; it < 512; it += F.G) rnn_item<2>(F, it >> 6, it & 63);
#endif
    }
#ifdef DUP_P5
    __syncthreads(); REFRESH();
    { for (int n = F.bid; n < 1024; n += F.G) { const int k = n >> 8, c = n & 255, b = c & 7, r = c >> 3;     const int i = (k == 0) ? r : (k == 1) ? 63 - r : (k == 2) ? 64 + r : 127 - r; attn_item(F, b, i); }
      __syncthreads();
      for (int it = F.bid; it < 512; it += F.G) rnn_item<2>(F, it >> 6, it & 63);
#endif
    GRID_BAR();
    { pg8::Gemm g{(const bf16_t*)(ws + WS_YCAT), (const bf16_t*)(ws + WS_WOUTT), M, DM, DM, DM, DM}; pg8::StaticOrder S; S.init(M, DM, F.G, F.bid);
      EpiBf16<0> E{(bf16_t*)(ws + WS_Y), DM, nullptr}; pg8::gemm_phase<EpiBf16<0>, pg8::StaticOrder>(F.lds, g, S, E, FRESH_TID()); }
#ifdef DUP_P6
    __syncthreads(); REFRESH();
    { pg8::Gemm g{(const bf16_t*)(ws + WS_YCAT), (const bf16_t*)(ws + WS_WOUTT), M, DM, DM, DM, DM}; pg8::StaticOrder S; S.init(M, DM, F.G, F.bid);
      EpiBf16<0> E{(bf16_t*)(ws + WS_Y), DM, nullptr}; pg8::gemm_phase<EpiBf16<0>, pg8::StaticOrder>(F.lds, g, S, E, FRESH_TID()); }
#endif
    GRID_BAR();
    p7_rows(F);
#ifdef DUP_P7
    __syncthreads(); REFRESH(); p7_rows(F);
#endif
    GRID_BAR();
    { pg8::Gemm g{(const bf16_t*)(ws + WS_H), (const bf16_t*)(ws + WS_WFF1T), M, DFF, DM, DM, DM}; pg8::StaticOrder S; S.init(M, DFF, F.G, F.bid);
      EpiBf16<1> E{(bf16_t*)(ws + WS_HID), DFF, nullptr}; pg8::gemm_phase<EpiBf16<1>, pg8::StaticOrder>(F.lds, g, S, E, FRESH_TID()); }
#ifdef DUP_P8
    __syncthreads(); REFRESH();
    { pg8::Gemm g{(const bf16_t*)(ws + WS_H), (const bf16_t*)(ws + WS_WFF1T), M, DFF, DM, DM, DM}; pg8::StaticOrder S; S.init(M, DFF, F.G, F.bid);
      EpiBf16<1> E{(bf16_t*)(ws + WS_HID), DFF, nullptr}; pg8::gemm_phase<EpiBf16<1>, pg8::StaticOrder>(F.lds, g, S, E, FRESH_TID()); }
#endif
    GRID_BAR();
    { pg8::Gemm g{(const bf16_t*)(ws + WS_HID), (const bf16_t*)(ws + WS_WFF2T), M, DM, DFF, DFF, DFF}; pg8::StaticOrder S; S.init(M, DM, F.G, F.bid);
      EpiBf16<0> E{(bf16_t*)(ws + WS_Y2), DM, nullptr}; pg8::gemm_phase<EpiBf16<0>, pg8::StaticOrder>(F.lds, g, S, E, FRESH_TID()); }
#ifdef DUP_P9
    __syncthreads(); REFRESH();
    { pg8::Gemm g{(const bf16_t*)(ws + WS_HID), (const bf16_t*)(ws + WS_WFF2T), M, DM, DFF, DFF, DFF}; pg8::StaticOrder S; S.init(M, DM, F.G, F.bid);
      EpiBf16<0> E{(bf16_t*)(ws + WS_Y2), DM, nullptr}; pg8::gemm_phase<EpiBf16<0>, pg8::StaticOrder>(F.lds, g, S, E, FRESH_TID()); }
#endif
    GRID_BAR();
    p10_rows(F, args.out);
#ifdef DUP_P10
    __syncthreads(); REFRESH(); p10_rows(F, args.out);
#endif
#ifdef PROBE_A
    GRID_BAR();
    { const float Ta = (float)(tsb_[PROBE_A + 1] - tsb_[PROBE_A]) * 0.01f, Tb = (float)(tsb_[PROBE_B + 1] - tsb_[PROBE_B]) * 0.01f;
      if (blockIdx.x == 0 && threadIdx.x == 0) args.out[0] += Ta;
      for (int idx = 1024 + blockIdx.x * 512 + threadIdx.x; idx < 1024 + (1 << 20); idx += gridDim.x * 512) args.out[idx] += Tb * 0.01f; }
#endif
}

extern "C" void kernel_launch(void* const* d_in, const int* in_sizes, int n_in, void* d_out, int out_size, void* d_ws, size_t ws_size, hipStream_t stream) {
    static int grid = 0;
    if (grid == 0) {
        if (n_in != 27 || out_size != M * DM || ws_size < WS_END) { fprintf(stderr, "kernel_launch: unexpected problem (n_in %d out %d ws %zu)\n", n_in, out_size, ws_size); grid = -1; return; }
        int dev = 0, cus = 0, per_cu = 0;
        (void)hipGetDevice(&dev); (void)hipDeviceGetAttribute(&cus, hipDeviceAttributeMultiprocessorCount, dev);
        (void)hipFuncSetAttribute((const void*)hybrid_fwd, hipFuncAttributeMaxDynamicSharedMemorySize, LDS_BYTES);
        if (hipOccupancyMaxActiveBlocksPerMultiprocessor(&per_cu, (const void*)hybrid_fwd, 512, LDS_BYTES) != hipSuccess || per_cu < 1) per_cu = 1;
        (void)hipGetLastError();
        grid = cus * 1;
        fprintf(stderr, "kernel_launch: grid %d (per_cu %d)\n", grid, per_cu);
    }
    if (grid < 0) return;
    (void)hipMemsetAsync(d_ws, 0, 16384, stream);
    Args a{};
    for (int i = 0; i < 27; ++i) a.in[i] = (const float*)d_in[i];
    a.out = (float*)d_out; a.ws = (unsigned char*)d_ws;
    void* kargs[] = {&a};
    hipError_t e = hipLaunchCooperativeKernel((const void*)hybrid_fwd, dim3(grid), dim3(512), kargs, LDS_BYTES, stream);
    if (e != hipSuccess) fprintf(stderr, "kernel_launch: cooperative launch failed: %s\n", hipGetErrorString(e));
}
```

```cpp
#include <hip/hip_runtime.h>
#include <hip/hip_cooperative_groups.h>
#include <cstdio>
#include <cstdint>
namespace cg = cooperative_groups;

#define LAS __attribute__((address_space(3)))
typedef unsigned short bf16_t;
typedef short bf16x8 __attribute__((ext_vector_type(8)));
typedef short s16x4 __attribute__((ext_vector_type(4)));
typedef float f32x4 __attribute__((ext_vector_type(4)));
typedef float f32x16 __attribute__((ext_vector_type(16)));
typedef unsigned u32x4 __attribute__((ext_vector_type(4)));
typedef unsigned u32x2 __attribute__((ext_vector_type(2)));
#define LOG2E_C 1.4426950408889634f

namespace pg8 {
constexpr int BM = 256, BK = 64, HALF = 128, HTB = HALF * BK * 2, STAGE_BYTES = 8 * HTB, NXCD = 8, WGM = 8;
__host__ __device__ __forceinline__ int lds_byte(int r, int c) { const int st = (r >> 4) * 2 + (c >> 5), rr = r & 15, cc = c & 31, ob = rr * 64 + cc * 2; return st * 1024 + (ob ^ (((ob >> 9) & 1) << 5)); }
__host__ __device__ __forceinline__ void stage_rc(int b, int& R, int& C) { const int st = b / 1024, sb = b % 1024, swz = sb ^ (((sb >> 9) & 1) << 5); R = (st >> 1) * 16 + swz / 64; C = (st & 1) * 32 + (swz % 64) / 2; }
__host__ __device__ __forceinline__ int perm32(int rho) { const int n = rho >> 4, i = rho & 15; return 8 * (i >> 2) + 4 * n + (i & 3); }

struct Unit { int pm, pn; };
struct Gemm { const bf16_t* A; const bf16_t* Bt; int M, N, K, lda, ldb; };

struct StaticOrder {
    int nM, nN, nwg, G, c;
    __device__ void init(int M, int N, int G_, int c_) { nM = M / BM; nN = N / BM; nwg = nM * nN; G = G_; c = c_; }
    __device__ bool next(int i, Unit& u) const {
        const long L = (long)i * G + c; if (L >= nwg) return false;
        int wgid = (int)L; { const int q = nwg / NXCD, r = nwg % NXCD, xcd = wgid % NXCD, off = wgid / NXCD; wgid = (xcd < r ? xcd * (q + 1) : r * (q + 1) + (xcd - r) * q) + off; }
        const int nig = WGM * nN, gid = wgid / nig, fm = gid * WGM, gsz = (nM - fm) < WGM ? (nM - fm) : WGM;
        u.pm = fm + ((wgid % nig) % gsz); u.pn = (wgid % nig) / gsz; return true;
    }
};
struct OneUnit { __device__ bool next(int i, Unit& u) const { if (i) return false; u.pm = 0; u.pn = 0; return true; } };
struct ColOrder {
    int nM, G, c;
    __device__ bool next(int i, Unit& u) const { const long L = (long)i * G + c; if (c < 0 || L >= nM) return false; u.pm = (int)L; u.pn = 0; return true; }
};

__device__ __forceinline__ unsigned cvt_pk_bf16(float lo, float hi) { unsigned r; asm volatile("v_cvt_pk_bf16_f32 %0, %1, %2" : "=v"(r) : "v"(lo), "v"(hi)); return r; }

template <class Epi, class Sched>
__device__ __forceinline__ void gemm_phase(LAS unsigned char* lds, const Gemm g, const Sched& S, const Epi& E, int tid) {
    const int wid = __builtin_amdgcn_readfirstlane(tid >> 6), lane = tid & 63, wr = wid >> 2, wc = wid & 3, fr = lane & 15, fq = lane >> 4;
    const int K = g.K, nt = K / BK, lda = g.lda, ldb = g.ldb;
    unsigned voffA[2], voffB[2];
#pragma unroll
    for (int i = 0; i < 2; ++i) { int R, C; stage_rc(tid * 16 + i * 8192, R, C); const int Rb = Epi::PERM ? ((R & ~31) + perm32(R & 31)) : R;
        voffA[i] = (unsigned)(R * lda + C) * 2u; voffB[i] = (unsigned)(Rb * ldb + C) * 2u; }
    const size_t kstep = (size_t)(BK * 2);
    const size_t hstepA = (size_t)HALF * lda * 2, hstepB = (size_t)HALF * ldb * 2;
    const size_t tstepA = 2 * hstepA, tstepB = 2 * hstepB;
    const unsigned ldsw = (unsigned)wid * 1024u;
    const int aoff = lds_byte(wr * 64 + fr, fq * 8), boff = lds_byte(wc * 32 + fr, fq * 8);
#define PG8_SA(b, h) (((b) * 2 + (h)) * HTB)
#define PG8_SB(b, h) ((4 + (b) * 2 + (h)) * HTB)
#define PG8_STAGE(bufoff, gbase, voff) do { _Pragma("unroll") for (int _i = 0; _i < 2; ++_i) \
        __builtin_amdgcn_global_load_lds((const unsigned*)((const char*)(gbase) + (voff)[_i]), (LAS unsigned*)(lds + (bufoff) + ldsw + _i * 8192), 16, 0, 0); } while (0)
#define PG8_LDA(dst, b, h) do { _Pragma("unroll") for (int m = 0; m < 4; ++m) _Pragma("unroll") for (int k = 0; k < 2; ++k) dst[m][k] = *(const LAS bf16x8*)(lds + PG8_SA(b, h) + aoff + m * 2048 + k * 1024); } while (0)
#define PG8_LDB(dst, b, h) do { _Pragma("unroll") for (int n = 0; n < 2; ++n) _Pragma("unroll") for (int k = 0; k < 2; ++k) dst[n][k] = *(const LAS bf16x8*)(lds + PG8_SB(b, h) + boff + n * 2048 + k * 1024); } while (0)
#define PG8_MMA(ai, bj, At, Bt) do { __builtin_amdgcn_s_setprio(1); _Pragma("unroll") for (int m = 0; m < 4; ++m) _Pragma("unroll") for (int n = 0; n < 2; ++n) _Pragma("unroll") for (int k = 0; k < 2; ++k) \
        acc[ai][bj][m][n] = __builtin_amdgcn_mfma_f32_16x16x32_bf16(Bt[n][k], At[m][k], acc[ai][bj][m][n], 0, 0, 0); __builtin_amdgcn_s_setprio(0); } while (0)
#define PG8_WAIT_V(n) asm volatile("s_waitcnt vmcnt(" #n ")" ::: "memory")
#define PG8_WAIT_L(n) asm volatile("s_waitcnt lgkmcnt(" #n ")" ::: "memory")
#define PG8_BAR __builtin_amdgcn_s_barrier()
#define PG8_SCHED __builtin_amdgcn_sched_barrier(0)
    Unit cur, nxt; int ui = 0;
    if (!S.next(0, cur)) return;
    f32x4 acc[2][2][4][2];
#pragma unroll
    for (int a = 0; a < 2; ++a)
#pragma unroll
        for (int b = 0; b < 2; ++b)
#pragma unroll
            for (int m = 0; m < 4; ++m)
#pragma unroll
                for (int n = 0; n < 2; ++n) acc[a][b][m][n] = (f32x4){0.f, 0.f, 0.f, 0.f};
    bf16x8 At[4][2], B0[2][2], B1[2][2];
    const char* cA = (const char*)g.A + (size_t)cur.pm * tstepA; const char* cB = (const char*)g.Bt + (size_t)cur.pn * tstepB;
    PG8_STAGE(PG8_SB(0, 0), cB, voffB); PG8_STAGE(PG8_SB(0, 1), cB + hstepB, voffB); PG8_STAGE(PG8_SA(0, 0), cA, voffA); PG8_STAGE(PG8_SA(0, 1), cA + hstepA, voffA);
    if (wr == 1) PG8_BAR;
    PG8_WAIT_V(2); PG8_BAR;
    PG8_STAGE(PG8_SB(1, 0), cB + kstep, voffB); PG8_STAGE(PG8_SA(1, 0), cA + kstep, voffA); PG8_STAGE(PG8_SB(1, 1), cB + hstepB + kstep, voffB);
    PG8_WAIT_V(6); PG8_BAR;
    for (;;) {
        const bool has_next = S.next(ui + 1, nxt);
        const char* nA = has_next ? (const char*)g.A + (size_t)nxt.pm * tstepA : cA; const char* nB = has_next ? (const char*)g.Bt + (size_t)nxt.pn * tstepB : cB;
        for (int t = 0; t < nt; t += 2) {
            const bool last = (t == nt - 2);
            const char* a1 = cA + (size_t)(t + 1) * kstep;
            const char* a2 = last ? nA : cA + (size_t)(t + 2) * kstep; const char* b2 = last ? nB : cB + (size_t)(t + 2) * kstep;
            const char* a3 = a2 + kstep; const char* b3 = b2 + kstep;
            PG8_LDB(B0, 0, 0); PG8_LDB(B1, 0, 1); PG8_SCHED; PG8_LDA(At, 0, 0); PG8_STAGE(PG8_SA(1, 1), a1 + hstepA, voffA);
            PG8_WAIT_V(8); PG8_WAIT_L(0); PG8_BAR; PG8_MMA(0, 0, At, B0); PG8_MMA(0, 1, At, B1); PG8_BAR; PG8_SCHED;
            PG8_LDA(At, 0, 1); PG8_STAGE(PG8_SB(0, 0), b2, voffB); PG8_STAGE(PG8_SB(0, 1), b2 + hstepB, voffB); PG8_STAGE(PG8_SA(0, 0), a2, voffA);
            PG8_WAIT_V(8); PG8_WAIT_L(0); PG8_BAR; PG8_MMA(1, 0, At, B0); PG8_MMA(1, 1, At, B1); PG8_BAR; PG8_SCHED;
            PG8_LDB(B0, 1, 0); PG8_LDB(B1, 1, 1); PG8_SCHED; PG8_LDA(At, 1, 0); PG8_STAGE(PG8_SA(0, 1), a2 + hstepA, voffA);
            PG8_WAIT_V(8); PG8_WAIT_L(0); PG8_BAR; PG8_MMA(0, 0, At, B0); PG8_MMA(0, 1, At, B1); PG8_BAR; PG8_SCHED;
            PG8_LDA(At, 1, 1); PG8_STAGE(PG8_SB(1, 0), b3, voffB); PG8_STAGE(PG8_SB(1, 1), b3 + hstepB, voffB); PG8_STAGE(PG8_SA(1, 0), a3, voffA);
            PG8_WAIT_V(8); PG8_WAIT_L(0); PG8_BAR; PG8_MMA(1, 0, At, B0); PG8_MMA(1, 1, At, B1); PG8_BAR; PG8_SCHED;
        }
        E(acc, cur, wr, wc, fr, fq);
        if (!has_next) break;
#pragma unroll
        for (int a = 0; a < 2; ++a)
#pragma unroll
            for (int b = 0; b < 2; ++b)
#pragma unroll
                for (int m = 0; m < 4; ++m)
#pragma unroll
                    for (int n = 0; n < 2; ++n) acc[a][b][m][n] = (f32x4){0.f, 0.f, 0.f, 0.f};
        cur = nxt; cA = nA; cB = nB; ++ui;
    }
    PG8_WAIT_V(0);
    if (wr == 0) PG8_BAR;
    PG8_BAR;
#undef PG8_SA
#undef PG8_SB
#undef PG8_STAGE
#undef PG8_LDA
#undef PG8_LDB
#undef PG8_MMA
#undef PG8_WAIT_V
#undef PG8_WAIT_L
#undef PG8_BAR
#undef PG8_SCHED
}
}

constexpr int BATCH = 8, SEQ = 4096, DM = 1024, M = BATCH * SEQ, NZ = 2560, DFF = 4096, NMOD = 6 * DM;
constexpr float EPS = 1e-6f, NEGF = -1e30f, LOG2E = 1.4426950408889634f;
constexpr size_t MiB = 1u << 20, KiB = 1024;
constexpr size_t WS_MOD = 64 * KiB;
constexpr size_t WS_CB1P = 320 * KiB;
constexpr size_t WS_CB1 = 384 * KiB;
constexpr size_t WS_LRUC = 400 * KiB;
constexpr size_t WS_WAT = 448 * KiB, WS_WXT = 512 * KiB;
constexpr size_t WS_CW2KT = 576 * KiB, WS_CW2VT = 640 * KiB;
constexpr size_t WS_WINT = 2 * MiB, WS_WOUTT = 8 * MiB, WS_WFF1T = 10 * MiB, WS_WFF2T = 18 * MiB, WS_CW1KT = 26 * MiB, WS_CW1VT = 27 * MiB;
constexpr size_t WS_CHIDK = 28 * MiB, WS_CHIDV = 30 * MiB;
constexpr size_t WS_H = 32 * MiB;
constexpr size_t WS_GRNN = 96 * MiB, WS_XRNN = 128 * MiB, WS_Q = 160 * MiB;
constexpr size_t WS_KV = 192 * MiB, KV_STRIDE = 8 * MiB;
constexpr size_t WS_GATE = 240 * MiB;
constexpr size_t WS_KCMP = 244 * MiB, WS_VCMPT = WS_KCMP + 512 * KiB;
constexpr size_t WS_RA = 246 * MiB, WS_RH = 247 * MiB, WS_RHIN = 248 * MiB;
constexpr size_t WS_YCAT = 256 * MiB;
constexpr size_t WS_Y = 416 * MiB;
constexpr size_t WS_HID = 96 * MiB;
constexpr size_t WS_Y2 = 352 * MiB;
constexpr size_t WS_RG = 416 * MiB;
constexpr size_t WS_CP = WS_Y2;
constexpr size_t WS_END = 480 * MiB;
constexpr int LDS_BYTES = 147456, LDS_MISC = 147200;

struct Args { const float* in[27]; float* out; unsigned char* ws; };

struct Frame {
    LAS unsigned char* lds; int tid, lane, wave, G, bid; unsigned char* ws; const float* const* in;
};

__device__ __forceinline__ unsigned f2bf(float f) { unsigned u = __builtin_bit_cast(unsigned, f); return (u + 0x7fffu + ((u >> 16) & 1u)) >> 16; }
typedef __bf16 bf16x2_t __attribute__((ext_vector_type(2)));
typedef float f32x2_t __attribute__((ext_vector_type(2)));
__device__ __forceinline__ unsigned pk2(float lo, float hi) { f32x2_t v = {lo, hi}; bf16x2_t b = __builtin_convertvector(v, bf16x2_t); return __builtin_bit_cast(unsigned, b); }
__device__ __forceinline__ float bf2f(bf16_t b) { return __builtin_bit_cast(float, (unsigned)b << 16); }
__device__ __forceinline__ float wave_sum(float v) {
#pragma unroll
    for (int o = 1; o < 64; o <<= 1) v += __shfl_xor(v, o);
    return v;
}
__device__ __forceinline__ float sigmoidf_(float x) { return __builtin_amdgcn_rcpf(1.0f + __builtin_amdgcn_exp2f(-LOG2E_C * x)); }
__device__ __forceinline__ float gelu_tanh(float v) { const float u = (-2.0f * 0.7978845608028654f * LOG2E_C) * (v + 0.044715f * v * v * v); return v * __builtin_amdgcn_rcpf(1.0f + __builtin_amdgcn_exp2f(u)); }
__device__ __forceinline__ float expm1_small(float x) { float p = 1.0f / 5040.0f; p = fmaf(p, x, 1.0f / 720.0f); p = fmaf(p, x, 1.0f / 120.0f); p = fmaf(p, x, 1.0f / 24.0f); p = fmaf(p, x, 1.0f / 6.0f); p = fmaf(p, x, 0.5f); p = fmaf(p, x, 1.0f); return p * x; }
#define LDS_FENCE() asm volatile("s_waitcnt lgkmcnt(0)" ::: "memory")
__device__ __forceinline__ int fresh_tid2(int wave_u) { int z = 0; asm volatile("" : "+v"(z)); int t = (wave_u << 6) | (int)__builtin_amdgcn_mbcnt_hi(~0u, __builtin_amdgcn_mbcnt_lo(~0u, (unsigned)z)); asm volatile("" : "+v"(t)); return t; }
__device__ __forceinline__ int fresh_tid() { int t = threadIdx.x; asm volatile("" : "+v"(t)); return t; }

struct EpiF32 {
    static constexpr bool PERM = false;
    float* O; int ldc;
    __device__ __forceinline__ void operator()(const f32x4 (&acc)[2][2][4][2], const pg8::Unit& u, int wr, int wc, int fr, int fq) const {
        const int row0 = u.pm * 256 + wr * 64 + fr, col0 = u.pn * 256 + wc * 32 + 4 * fq;
#pragma unroll
        for (int ai = 0; ai < 2; ++ai)
#pragma unroll
            for (int m = 0; m < 4; ++m) { float* rowp = O + (size_t)(row0 + ai * 128 + m * 16) * ldc + col0;
#pragma unroll
                for (int bj = 0; bj < 2; ++bj)
#pragma unroll
                    for (int n = 0; n < 2; ++n) *(f32x4*)(rowp + bj * 128 + n * 16) = acc[ai][bj][m][n]; }
    }
};
template <int ACT  > struct EpiBf16 {
    static constexpr bool PERM = true;
    bf16_t* O; int ldc; const float* bias;
    __device__ __forceinline__ void operator()(const f32x4 (&acc)[2][2][4][2], const pg8::Unit& u, int wr, int wc, int fr, int fq) const {
        const int row0 = u.pm * 256 + wr * 64 + fr, col0 = u.pn * 256 + wc * 32 + 8 * fq;
        f32x4 bv[2][2];
#pragma unroll
        for (int bj = 0; bj < 2; ++bj)
#pragma unroll
            for (int n = 0; n < 2; ++n) bv[bj][n] = (ACT == 2) ? *(const f32x4*)(bias + col0 + bj * 128 + 4 * n) : (f32x4){0.f, 0.f, 0.f, 0.f};
#pragma unroll
        for (int ai = 0; ai < 2; ++ai)
#pragma unroll
            for (int m = 0; m < 4; ++m) { bf16_t* rowp = O + (size_t)(row0 + ai * 128 + m * 16) * ldc + col0;
#pragma unroll
                for (int bj = 0; bj < 2; ++bj) { f32x4 v0 = acc[ai][bj][m][0] + bv[bj][0], v1 = acc[ai][bj][m][1] + bv[bj][1];
#pragma unroll
                    for (int e = 0; e < 4; ++e) {
                        if (ACT == 1) { const float a = fmaxf(v0[e], 0.f), b = fmaxf(v1[e], 0.f); v0[e] = a * a; v1[e] = b * b; }
                        if (ACT == 2) { v0[e] = gelu_tanh(v0[e]); v1[e] = gelu_tanh(v1[e]); } }
                    u32x4 w; w.x = pk2(v0[0], v0[1]); w.y = pk2(v0[2], v0[3]); w.z = pk2(v1[0], v1[1]); w.w = pk2(v1[2], v1[3]);
                    *(u32x4*)(rowp + bj * 128) = w; } }
    }
};
struct EpiZ {
    static constexpr bool PERM = true;
    unsigned char* ws;
    __device__ __forceinline__ void operator()(const f32x4 (&acc)[2][2][4][2], const pg8::Unit& u, int wr, int wc, int fr, int fq) const {
        const int row0 = u.pm * 256 + wr * 64 + fr, pn = u.pn;
        if (pn < 6) {
            bf16_t* base = (bf16_t*)(ws + (pn < 2 ? WS_GRNN : pn < 4 ? WS_XRNN : WS_Q)); const float sc = pn >= 4 ? 0.125f * LOG2E_C : 1.0f;
            const int col0 = (pn & 1) * 256 + wc * 32 + 8 * fq;
#pragma unroll
            for (int ai = 0; ai < 2; ++ai)
#pragma unroll
                for (int m = 0; m < 4; ++m) { bf16_t* rowp = base + (size_t)(row0 + ai * 128 + m * 16) * 512 + col0;
#pragma unroll
                    for (int bj = 0; bj < 2; ++bj) { const f32x4 v0 = acc[ai][bj][m][0] * sc, v1 = acc[ai][bj][m][1] * sc;
                        u32x4 w; w.x = pk2(v0[0], v0[1]); w.y = pk2(v0[2], v0[3]); w.z = pk2(v1[0], v1[1]); w.w = pk2(v1[2], v1[3]);
                        *(u32x4*)(rowp + bj * 128) = w; } }
        } else if (pn < 9) {
            const int p = pn - 6, g = wc >> 1, d0 = 32 * (wc & 1) + 8 * fq;
            bf16_t* Kb = (bf16_t*)(ws + WS_KV + (size_t)(2 * p) * KV_STRIDE); bf16_t* Vb = (bf16_t*)(ws + WS_KV + (size_t)(2 * p + 1) * KV_STRIDE);
#pragma unroll
            for (int ai = 0; ai < 2; ++ai)
#pragma unroll
                for (int m = 0; m < 4; ++m) { const int row = row0 + ai * 128 + m * 16, b = row >> 12, s = row & 4095;
                    { const f32x4 v0 = acc[ai][0][m][0], v1 = acc[ai][0][m][1];
                      u32x4 w; w.x = pk2(v0[0], v0[1]); w.y = pk2(v0[2], v0[3]); w.z = pk2(v1[0], v1[1]); w.w = pk2(v1[2], v1[3]);
                      *(u32x4*)(Kb + ((size_t)(b * 2 + g) * 4096 + s) * 64 + d0) = w; }
                    if (p == 0) { const f32x4 v0 = acc[ai][1][m][0], v1 = acc[ai][1][m][1];
                      u32x4 w; w.x = pk2(v0[0], v0[1]); w.y = pk2(v0[2], v0[3]); w.z = pk2(v1[0], v1[1]); w.w = pk2(v1[2], v1[3]);
                      *(u32x4*)(Vb + ((size_t)(b * 2 + g) * 4096 + s) * 64 + d0) = w; }
                    else { bf16_t* vp = Vb + ((size_t)(b * 2 + g) * 64 + d0) * 4096 + s;
#pragma unroll
                      for (int n = 0; n < 2; ++n)
#pragma unroll
                          for (int e = 0; e < 4; ++e) vp[(size_t)(4 * n + e) * 4096] = (bf16_t)f2bf(acc[ai][1][m][n][e]); } }
        } else {
            if (wc == 0 && fq < 3) { float* G = (float*)(ws + WS_GATE);
#pragma unroll
                for (int ai = 0; ai < 2; ++ai)
#pragma unroll
                    for (int m = 0; m < 4; ++m) { float* gp = G + (size_t)(row0 + ai * 128 + m * 16) * 24 + 8 * fq;
#pragma unroll
                        for (int n = 0; n < 2; ++n) { f32x4 v = acc[ai][0][m][n];
#pragma unroll
                            for (int e = 0; e < 4; ++e) v[e] = sigmoidf_(v[e]);
                            *(f32x4*)(gp + 4 * n) = v; } } }
        }
    }
};

#define XB_TMO      128
#define XB_XCNT(j)  (256  + 64 * (j))
#define XB_XSUB(j)  (1280 + 64 * (j))
#define XB_XGEN(j)  (2304 + 64 * (j))
#define XB_TOP      3328
#define XB_TOPGEN   3392
#define XCD_BAR_WORDS 3456
#define XB_SPIN_CAP (1u << 18)

__device__ __forceinline__ unsigned xb_ld(unsigned* p)              { return __hip_atomic_load(p, __ATOMIC_RELAXED, __HIP_MEMORY_SCOPE_AGENT); }
__device__ __forceinline__ unsigned xb_add(unsigned* p, unsigned v) { return __hip_atomic_fetch_add(p, v, __ATOMIC_RELAXED, __HIP_MEMORY_SCOPE_AGENT); }
__device__ __forceinline__ unsigned xb_xcc_id() { return (unsigned)__builtin_amdgcn_s_getreg((3 << 11) | 20) & 0xFu; }
#define XB_SPIN(cond, bar) do { unsigned _sp = 0; while (cond) { __builtin_amdgcn_s_sleep(1); \
    if ((++_sp & 255u) == 0u) { if (xb_ld(&(bar)[XB_TMO])) break; if (_sp > XB_SPIN_CAP) { atomicAdd(&(bar)[XB_TMO], 1u); break; } } } } while (0)

struct XcdBarrier {
    unsigned* bar; unsigned x;
    volatile LAS unsigned* st;
};

__device__ __forceinline__ XcdBarrier xcd_barrier_post(unsigned* bar, volatile LAS unsigned* st) {
    XcdBarrier b; b.bar = bar; b.x = xb_xcc_id(); b.st = st;
    if (threadIdx.x == 0) (void)xb_add(&bar[XB_XCNT(b.x)], 1u);
    return b;
}
__device__ __forceinline__ void xcd_barrier_complete(unsigned* bar, unsigned x, unsigned& nloc, unsigned& nx) {
    const unsigned G = gridDim.x * gridDim.y * gridDim.z;
    unsigned sum, cnt, mine, sp = 0u;
    for (;;) {
        sum = 0u; cnt = 0u; mine = 0u;
#pragma unroll
        for (unsigned j = 0; j < 16; ++j) { const unsigned c = xb_ld(&bar[XB_XCNT(j)]); sum += c; cnt += (c > 0u) ? 1u : 0u; mine = (j == x) ? c : mine; }
        if (sum == G) break;
        __builtin_amdgcn_s_sleep(1);
        if ((++sp & 255u) == 0u) { if (xb_ld(&bar[XB_TMO])) break; if (sp > XB_SPIN_CAP) { atomicAdd(&bar[XB_TMO], 1u); break; } }
    }
    nloc = mine > 0u ? mine : 1u; nx = cnt > 0u ? cnt : 1u;
}

__device__ __forceinline__ void xcd_barrier(const XcdBarrier& b) {
    asm volatile("s_waitcnt vmcnt(0)" ::: "memory");
    __syncthreads();
    if (threadIdx.x == 0) {
        unsigned* bar = b.bar;
        __builtin_amdgcn_s_waitcnt(0);
        unsigned nloc = b.st[0], nx = b.st[1];
        if (nloc == 0u) { xcd_barrier_complete(bar, b.x, nloc, nx); b.st[0] = nloc; b.st[1] = nx; }
        const unsigned old = xb_add(&bar[XB_XSUB(b.x)], 1u);
        const unsigned gen = old / nloc;
        if (old + 1u == (gen + 1u) * nloc) {
            __builtin_amdgcn_fence(__ATOMIC_RELEASE, "agent");
            asm volatile("s_waitcnt vmcnt(0)" ::: "memory");
            const unsigned og = xb_add(&bar[XB_TOP], 1u);
            const unsigned tg = og / nx;
            if (og + 1u == (tg + 1u) * nx) xb_add(&bar[XB_TOPGEN], 1u);
            else XB_SPIN(xb_ld(&bar[XB_TOPGEN]) == tg, bar);
            __builtin_amdgcn_fence(__ATOMIC_ACQUIRE, "agent");
            xb_add(&bar[XB_XGEN(b.x)], 1u);
            asm volatile("s_waitcnt vmcnt(0)" ::: "memory");
        } else {
            XB_SPIN(xb_ld(&bar[XB_XGEN(b.x)]) == gen, bar);
            __builtin_amdgcn_fence(__ATOMIC_ACQUIRE, "agent");
            asm volatile("s_waitcnt vmcnt(0)" ::: "memory");
        }
    }
    __syncthreads();
}


__device__ __forceinline__ void tr_item(const float* W, int K, int N, bf16_t* WT, int NT, const float* gA, const float* gB, LAS float* scr, int item, int lane) {
    const int nblk = NT / 64, kb = item / nblk, nb = item % nblk, k0 = 64 * kb, n0 = 64 * nb;
    const int nn = n0 + 4 * (lane & 15);
#pragma unroll 8
    for (int i = 0; i < 16; ++i) { const int kk = 4 * i + (lane >> 4), k = k0 + kk;
        f32x4 v = (nn < N) ? *(const f32x4*)(W + (size_t)k * N + nn) : (f32x4){0.f, 0.f, 0.f, 0.f};
        if (gA) v = v * ((k < 512) ? gA[k] : gB[k - 512]);
        LAS float* d = scr + kk * 65 + 4 * (lane & 15); d[0] = v.x; d[1] = v.y; d[2] = v.z; d[3] = v.w; }
    LDS_FENCE();
    const int c = lane & 7;
#pragma unroll
    for (int j = 0; j < 8; ++j) { const int n = (lane >> 3) + 8 * j; const LAS float* s = scr + (8 * c) * 65 + n;
        u32x4 o; o.x = pk2(s[0 * 65], s[1 * 65]); o.y = pk2(s[2 * 65], s[3 * 65]); o.z = pk2(s[4 * 65], s[5 * 65]); o.w = pk2(s[6 * 65], s[7 * 65]);
        *(u32x4*)(WT + (size_t)(n0 + n) * K + k0 + 8 * c) = o; }
    LDS_FENCE();
}
__device__ __forceinline__ void p0_mod_item(Frame& F, int item) {
    LAS float* sc = (LAS float*)F.lds; LAS float* red = (LAS float*)(F.lds + 32768);
    const float* c = F.in[1]; const float* ada_w = F.in[2]; const float* ada_b = F.in[3];
    for (int idx = F.tid; idx < 8192; idx += 512) { const float v = c[idx]; sc[idx] = v / (1.0f + __expf(-v)); }
    __syncthreads();
    float acc[8];
#pragma unroll
    for (int b = 0; b < 8; ++b) acc[b] = 0.f;
    const int kbase = 128 * F.wave; const float* wp = ada_w + (size_t)kbase * NMOD + 64 * item + F.lane;
#pragma unroll 8
    for (int kk = 0; kk < 128; ++kk) { const float wv = wp[(size_t)kk * NMOD];
#pragma unroll
        for (int b = 0; b < 8; ++b) acc[b] += sc[b * 1024 + kbase + kk] * wv; }
#pragma unroll
    for (int b = 0; b < 8; ++b) red[(F.wave * 8 + b) * 64 + F.lane] = acc[b];
    __syncthreads();
    { const int b = F.tid >> 6, col = F.tid & 63; float s = ada_b[64 * item + col];
#pragma unroll
      for (int w = 0; w < 8; ++w) s += red[(w * 8 + b) * 64 + col];
      ((float*)(F.ws + WS_MOD))[b * NMOD + 64 * item + col] = s; }
    __syncthreads();
}
__device__ __forceinline__ void p0_prologue(Frame& F) {
    for (int it = F.bid; it < NMOD / 64; it += F.G) p0_mod_item(F, it);
    LAS float* scr = (LAS float*)(F.lds + F.wave * 16640);
    const int nmb = (NMOD / 64 < F.G) ? NMOD / 64 : 0;
    const int gw = ((F.bid + F.G - nmb) % F.G) * 8 + F.wave, NGW = F.G * 8;
    constexpr int I_IN = 16 * (NZ / 64), I_OUT = 16 * 16, I_F1 = 16 * 64, I_F2 = 64 * 16, I_C1 = 32 * 4, I_C2 = 4 * 1, I_L = 1;
    constexpr int NTR = I_IN + I_OUT + I_F1 + I_F2 + 2 * I_C1 + 2 * I_C2 + 16 * I_L;
    constexpr int NITEMS = NTR + 128 + 8;
    unsigned char* ws = F.ws;
    for (int it = gw; it < NITEMS; it += NGW) {
        int r = it;
        if (r < I_IN) { tr_item(F.in[5], DM, 2328, (bf16_t*)(ws + WS_WINT), NZ, nullptr, nullptr, scr, r, F.lane); continue; } r -= I_IN;
        if (r < I_OUT) { tr_item(F.in[21], DM, DM, (bf16_t*)(ws + WS_WOUTT), DM, F.in[19], F.in[20], scr, r, F.lane); continue; } r -= I_OUT;
        if (r < I_F1) { tr_item(F.in[24], DM, DFF, (bf16_t*)(ws + WS_WFF1T), DFF, nullptr, nullptr, scr, r, F.lane); continue; } r -= I_F1;
        if (r < I_F2) { tr_item(F.in[25], DFF, DM, (bf16_t*)(ws + WS_WFF2T), DM, nullptr, nullptr, scr, r, F.lane); continue; } r -= I_F2;
        if (r < I_C1) { tr_item(F.in[14], 2048, 256, (bf16_t*)(ws + WS_CW1KT), 256, nullptr, nullptr, scr, r, F.lane); continue; } r -= I_C1;
        if (r < I_C1) { tr_item(F.in[17], 2048, 256, (bf16_t*)(ws + WS_CW1VT), 256, nullptr, nullptr, scr, r, F.lane); continue; } r -= I_C1;
        if (r < I_C2) { tr_item(F.in[15], 256, 64, (bf16_t*)(ws + WS_CW2KT), 64, nullptr, nullptr, scr, r, F.lane); continue; } r -= I_C2;
        if (r < I_C2) { tr_item(F.in[18], 256, 64, (bf16_t*)(ws + WS_CW2VT), 64, nullptr, nullptr, scr, r, F.lane); continue; } r -= I_C2;
        if (r < 8 * I_L) { const int n = r / I_L; tr_item(F.in[8] + n * 4096, 64, 64, (bf16_t*)(ws + WS_WAT) + n * 4096, 64, nullptr, nullptr, scr, r % I_L, F.lane); continue; } r -= 8 * I_L;
        if (r < 8 * I_L) { const int n = r / I_L; tr_item(F.in[10] + n * 4096, 64, 64, (bf16_t*)(ws + WS_WXT) + n * 4096, 64, nullptr, nullptr, scr, r % I_L, F.lane); continue; } r -= 8 * I_L;
        if (r < 128) {
            const int mat = r >> 6, cgp = (r >> 4) & 3, ks = r & 15; const float* pos = F.in[mat ? 16 : 13]; const float* w1 = F.in[mat ? 17 : 14];
            float a = 0.f; const int col = 64 * cgp + F.lane;
#pragma unroll 8
            for (int kk = 0; kk < 128; ++kk) { const int k = 128 * ks + kk; a += pos[k] * w1[(size_t)k * 256 + col]; }
            ((float*)(ws + WS_CB1P))[(mat * 16 + ks) * 256 + col] = a; continue; } r -= 128;
        { const int ch = 64 * r + F.lane; const float lam = F.in[12][ch]; ((float*)(ws + WS_LRUC))[ch] = -8.0f * log1pf(expf(-lam)); }
    }
}

__device__ __forceinline__ void p1_rows(Frame& F) {
    if (F.bid == 0) { const int mat = F.tid >> 8, col = F.tid & 255; float s = 0.f; const float* P = (const float*)(F.ws + WS_CB1P);
#pragma unroll
        for (int ks = 0; ks < 16; ++ks) s += P[(mat * 16 + ks) * 256 + col];
        ((float*)(F.ws + WS_CB1))[mat * 256 + col] = s; }
    const float* x = F.in[0]; const float* g = F.in[4]; const float* mod = (const float*)(F.ws + WS_MOD); bf16_t* H = (bf16_t*)(F.ws + WS_H);
    const int gw = F.bid * 8 + F.wave, NGW = F.G * 8;
    for (int rb = gw; rb < M / 16; rb += NGW) {
        const int b = (rb * 16) >> 12; f32x4 Gk[4], Sh[4];
#pragma unroll
        for (int j = 0; j < 4; ++j) { const int k = 4 * F.lane + 256 * j; const f32x4 gg = *(const f32x4*)(g + k), sc = *(const f32x4*)(mod + b * NMOD + 1024 + k);
            Gk[j] = gg * (sc + 1.0f); Sh[j] = *(const f32x4*)(mod + b * NMOD + k); }
        for (int rr = 0; rr < 16; ++rr) { const size_t row = (size_t)rb * 16 + rr; const f32x4* xr = (const f32x4*)(x + row * DM) + F.lane;
            f32x4 v[4]; float s = 0.f;
#pragma unroll
            for (int j = 0; j < 4; ++j) { v[j] = xr[64 * j]; s += (v[j].x * v[j].x + v[j].y * v[j].y) + (v[j].z * v[j].z + v[j].w * v[j].w); }
            const float rstd = rsqrtf(wave_sum(s) * (1.0f / DM) + EPS);
            unsigned long long* o8 = (unsigned long long*)(H + row * DM) + F.lane;
#pragma unroll
            for (int j = 0; j < 4; ++j) { const f32x4 h = v[j] * rstd * Gk[j] + Sh[j]; o8[64 * j] = (unsigned long long)pk2(h.x, h.y) | ((unsigned long long)pk2(h.z, h.w) << 32); } }
    }
}
__device__ __forceinline__ f32x4 ld_bf16x4(const bf16_t* p) { const u32x2 w = *(const u32x2*)p; return (f32x4){__builtin_bit_cast(float, w.x << 16), __builtin_bit_cast(float, w.x & 0xffff0000u), __builtin_bit_cast(float, w.y << 16), __builtin_bit_cast(float, w.y & 0xffff0000u)}; }
__device__ __forceinline__ void p7_rows(Frame& F) {
    const float* x = F.in[0]; const float* pnm = F.in[22]; const float* pre = F.in[23]; const float* mod = (const float*)(F.ws + WS_MOD);
    const bf16_t* Y = (const bf16_t*)(F.ws + WS_Y); bf16_t* H = (bf16_t*)(F.ws + WS_H);
    const int gw = F.bid * 8 + F.wave, NGW = F.G * 8;
    for (int rb = gw; rb < M / 16; rb += NGW) {
        const int b = (rb * 16) >> 12; f32x4 A1[4], G2[4], S2[4];
#pragma unroll
        for (int j = 0; j < 4; ++j) { const int k = 4 * F.lane + 256 * j;
            A1[j] = *(const f32x4*)(pnm + k) * (*(const f32x4*)(mod + b * NMOD + 2048 + k) + 1.0f);
            G2[j] = *(const f32x4*)(pre + k) * (*(const f32x4*)(mod + b * NMOD + 4096 + k) + 1.0f);
            S2[j] = *(const f32x4*)(mod + b * NMOD + 3072 + k); }
#pragma unroll 2
        for (int rr = 0; rr < 16; ++rr) { const size_t row = (size_t)rb * 16 + rr;
            const f32x4* xr = (const f32x4*)(x + row * DM) + F.lane; const bf16_t* yr = Y + row * DM + 4 * F.lane;
            f32x4 xv[4], yv[4]; float s = 0.f;
#pragma unroll
            for (int j = 0; j < 4; ++j) { xv[j] = xr[64 * j]; yv[j] = ld_bf16x4(yr + 256 * j); s += (yv[j].x * yv[j].x + yv[j].y * yv[j].y) + (yv[j].z * yv[j].z + yv[j].w * yv[j].w); }
            const float rstd = rsqrtf(wave_sum(s) * (1.0f / DM) + EPS); float s2 = 0.f;
#pragma unroll
            for (int j = 0; j < 4; ++j) { xv[j] = xv[j] + A1[j] * (yv[j] * rstd); s2 += (xv[j].x * xv[j].x + xv[j].y * xv[j].y) + (xv[j].z * xv[j].z + xv[j].w * xv[j].w); }
            const float rstd2 = rsqrtf(wave_sum(s2) * (1.0f / DM) + EPS);
            unsigned long long* o8 = (unsigned long long*)(H + row * DM) + F.lane;
#pragma unroll
            for (int j = 0; j < 4; ++j) { const f32x4 h = xv[j] * rstd2 * G2[j] + S2[j]; o8[64 * j] = (unsigned long long)pk2(h.x, h.y) | ((unsigned long long)pk2(h.z, h.w) << 32); } }
    }
}
__device__ __forceinline__ void p10_rows(Frame& F, float* out) {
    const float* x = F.in[0]; const float* pnm1 = F.in[22]; const float* pnm2 = F.in[26]; const float* mod = (const float*)(F.ws + WS_MOD);
    const bf16_t* Y = (const bf16_t*)(F.ws + WS_Y); const bf16_t* Y2 = (const bf16_t*)(F.ws + WS_Y2);
    const int gw = F.bid * 8 + F.wave, NGW = F.G * 8;
    for (int rb = gw; rb < M / 16; rb += NGW) {
        const int b = (rb * 16) >> 12; f32x4 A1[4], A2[4];
#pragma unroll
        for (int j = 0; j < 4; ++j) { const int k = 4 * F.lane + 256 * j;
            A1[j] = *(const f32x4*)(pnm1 + k) * (*(const f32x4*)(mod + b * NMOD + 2048 + k) + 1.0f);
            A2[j] = *(const f32x4*)(pnm2 + k) * (*(const f32x4*)(mod + b * NMOD + 5120 + k) + 1.0f); }
#pragma unroll 2
        for (int rr = 0; rr < 16; ++rr) { const size_t row = (size_t)rb * 16 + rr;
            const f32x4* xr = (const f32x4*)(x + row * DM) + F.lane; const bf16_t* yr = Y + row * DM + 4 * F.lane; const bf16_t* y2r = Y2 + row * DM + 4 * F.lane;
            f32x4 xv[4], yv[4], zv[4]; float s = 0.f, s2 = 0.f;
#pragma unroll
            for (int j = 0; j < 4; ++j) { xv[j] = xr[64 * j]; yv[j] = ld_bf16x4(yr + 256 * j); zv[j] = ld_bf16x4(y2r + 256 * j);
                s += (yv[j].x * yv[j].x + yv[j].y * yv[j].y) + (yv[j].z * yv[j].z + yv[j].w * yv[j].w); s2 += (zv[j].x * zv[j].x + zv[j].y * zv[j].y) + (zv[j].z * zv[j].z + zv[j].w * zv[j].w); }
            const float rstd = rsqrtf(wave_sum(s) * (1.0f / DM) + EPS), rstd2 = rsqrtf(wave_sum(s2) * (1.0f / DM) + EPS);
            f32x4* orow = (f32x4*)(out + row * DM) + F.lane;
#pragma unroll
            for (int j = 0; j < 4; ++j) orow[64 * j] = (xv[j] + A1[j] * (yv[j] * rstd)) + A2[j] * (zv[j] * rstd2); }
    }
}

constexpr int RNN_WL = 11264, RNN_PART_OFF = 8 * RNN_WL;
template <int PASS> __device__ __forceinline__ void rnn_item(Frame& F, int b, int chunk) {
    const int n = F.wave, lane = F.lane, ch = 64 * n + lane, fr = lane & 15, fq = lane >> 4;
    LAS unsigned char* wl = F.lds + n * RNN_WL;
    LAS bf16_t* xcb = (LAS bf16_t*)wl; LAS float* Ab = (LAS float*)(wl + 2304); LAS float* Gb = (LAS float*)(wl + 6656);
    LAS float* part = (LAS float*)(F.lds + RNN_PART_OFF);
    const float* conv_w = F.in[6]; const float cw0 = conv_w[ch], cw1 = conv_w[512 + ch], cw2 = conv_w[1024 + ch], cw3 = conv_w[1536 + ch], cb = F.in[7][ch];
    const bf16_t* WA = (const bf16_t*)(F.ws + WS_WAT) + n * 4096; const bf16_t* WX = (const bf16_t*)(F.ws + WS_WXT) + n * 4096;
    bf16x8 waf[4][2], wxf[4][2];
    if (PASS == 1) {
#pragma unroll
        for (int nb = 0; nb < 4; ++nb) {
#pragma unroll
            for (int ks = 0; ks < 2; ++ks) { waf[nb][ks] = *(const bf16x8*)(WA + (16 * nb + fr) * 64 + 32 * ks + 8 * fq); wxf[nb][ks] = *(const bf16x8*)(WX + (16 * nb + fr) * 64 + 32 * ks + 8 * fq); } } }
    const float* pba = F.in[9] + 64 * n + 4 * fq; const float* pbx = F.in[11] + 64 * n + 4 * fq; const float* plc = (const float*)(F.ws + WS_LRUC) + 64 * n + 4 * fq;
    const bf16_t* XR = (const bf16_t*)(F.ws + WS_XRNN); const bf16_t* GR = (const bf16_t*)(F.ws + WS_GRNN); bf16_t* YC = (bf16_t*)(F.ws + WS_YCAT);
    unsigned* RG = (unsigned*)(F.ws + WS_RG);
    const int t0 = chunk * 64; const size_t rowbase = (size_t)b * SEQ;
    float xm3 = 0.f, xm2 = 0.f, xm1 = 0.f;
    if (chunk > 0) { xm3 = bf2f(XR[(rowbase + t0 - 3) * 512 + ch]); xm2 = bf2f(XR[(rowbase + t0 - 2) * 512 + ch]); xm1 = bf2f(XR[(rowbase + t0 - 1) * 512 + ch]); }
    float h = 0.f, ap = 1.f;
    float* RA = (float*)(F.ws + WS_RA); float* RH = (float*)(F.ws + WS_RH);
    if (PASS == 2) h = ((const float*)(F.ws + WS_RHIN))[(size_t)(b * 64 + chunk) * 512 + ch];
    bf16_t xnext[16], gnext[16]; unsigned rgnext[16];
#pragma unroll
    for (int tt = 0; tt < 16; ++tt) { xnext[tt] = XR[(rowbase + t0 + tt) * 512 + ch];
        gnext[tt] = (PASS == 2) ? GR[(rowbase + t0 + tt) * 512 + ch] : (bf16_t)0; rgnext[tt] = (PASS == 2) ? RG[(rowbase + t0 + tt) * 512 + ch] : 0u; }
    for (int sub = 0; sub < 4; ++sub) {
        float xc[16]; const size_t r0 = rowbase + t0 + 16 * sub;
        bf16_t xcur[16], gcur[16]; unsigned rgcur[16];
#pragma unroll
        for (int tt = 0; tt < 16; ++tt) { xcur[tt] = xnext[tt]; gcur[tt] = gnext[tt]; rgcur[tt] = rgnext[tt]; }
        if (sub < 3) {
#pragma unroll
            for (int tt = 0; tt < 16; ++tt) { xnext[tt] = XR[(r0 + 16 + tt) * 512 + ch]; if (PASS == 2) { gnext[tt] = GR[(r0 + 16 + tt) * 512 + ch]; rgnext[tt] = RG[(r0 + 16 + tt) * 512 + ch]; } } }
#pragma unroll
        for (int tt = 0; tt < 16; ++tt) { const float xv = bf2f(xcur[tt]); xc[tt] = cb + cw0 * xm3 + cw1 * xm2 + cw2 * xm1 + cw3 * xv; xm3 = xm2; xm2 = xm1; xm1 = xv;
            if (PASS == 1) xcb[tt * 72 + lane] = (bf16_t)f2bf(xc[tt]); }
        float y[16];
        if (PASS == 1) {
            LDS_FENCE();
            bf16x8 xb[2];
#pragma unroll
            for (int ks = 0; ks < 2; ++ks) xb[ks] = *(const LAS bf16x8*)(xcb + fr * 72 + 32 * ks + 8 * fq);
            asm volatile("" : "+v"(pba), "+v"(pbx), "+v"(plc));
#pragma unroll
            for (int nb = 0; nb < 4; ++nb) { f32x4 aA = {0.f, 0.f, 0.f, 0.f}, aX = {0.f, 0.f, 0.f, 0.f};
                const f32x4 ba4n = *(const f32x4*)(pba + 16 * nb), bx4n = *(const f32x4*)(pbx + 16 * nb), lc4n = *(const f32x4*)(plc + 16 * nb);
#pragma unroll
                for (int ks = 0; ks < 2; ++ks) { aA = __builtin_amdgcn_mfma_f32_16x16x32_bf16(waf[nb][ks], xb[ks], aA, 0, 0, 0); aX = __builtin_amdgcn_mfma_f32_16x16x32_bf16(wxf[nb][ks], xb[ks], aX, 0, 0, 0); }
                f32x4 av, gv; u32x4 pk;
#pragma unroll
                for (int e = 0; e < 4; ++e) { const float rr = sigmoidf_(aA[e] + ba4n[e]), ii = sigmoidf_(aX[e] + bx4n[e]); const float la = lc4n[e] * rr;
                    const float em1 = expm1_small(la); av[e] = 1.0f + em1; gv[e] = __builtin_amdgcn_sqrtf(fmaxf(-em1 * (2.0f + em1), 0.f)) * ii; pk[e] = pk2(la, gv[e]); }
                *(LAS f32x4*)(Ab + fr * 68 + 16 * nb + 4 * fq) = av; *(LAS f32x4*)(Gb + fr * 68 + 16 * nb + 4 * fq) = gv;
                *(u32x4*)(RG + (r0 + fr) * 512 + 64 * n + 16 * nb + 4 * fq) = pk; }
            LDS_FENCE();
#pragma unroll
            for (int tt = 0; tt < 16; ++tt) { const float a = Ab[tt * 68 + lane], gg = Gb[tt * 68 + lane]; h = a * h + gg * xc[tt]; ap *= a; }
            LDS_FENCE();
        } else {
#pragma unroll
            for (int tt = 0; tt < 16; ++tt) { const float la = __builtin_bit_cast(float, rgcur[tt] << 16), gg = __builtin_bit_cast(float, rgcur[tt] & 0xffff0000u);
                const float a = 1.0f + expm1_small(la); h = a * h + gg * xc[tt]; y[tt] = h * gelu_tanh(bf2f(gcur[tt])); }
#pragma unroll
            for (int tt = 0; tt < 16; ++tt) Ab[tt * 68 + lane] = y[tt] * y[tt];
            LDS_FENCE();
            { const LAS float* rp = Ab + fr * 68 + 16 * fq; const f32x4 a0 = *(const LAS f32x4*)(rp), a1 = *(const LAS f32x4*)(rp + 4), a2 = *(const LAS f32x4*)(rp + 8), a3 = *(const LAS f32x4*)(rp + 12);
              float v = ((a0.x + a0.y) + (a0.z + a0.w)) + ((a1.x + a1.y) + (a1.z + a1.w)) + ((a2.x + a2.y) + (a2.z + a2.w)) + ((a3.x + a3.y) + (a3.z + a3.w));
              v += __shfl_xor(v, 16); v += __shfl_xor(v, 32);
              if (lane < 16) part[((sub & 1) * 8 + n) * 16 + lane] = v; }
            __syncthreads();
#pragma unroll
            for (int tt = 0; tt < 16; ++tt) { float tot = 0.f;
#pragma unroll
                for (int w = 0; w < 8; ++w) tot += part[((sub & 1) * 8 + w) * 16 + tt];
                const float rstd = rsqrtf(tot * (1.0f / 512.0f) + EPS);
                YC[(r0 + tt) * 1024 + ch] = (bf16_t)f2bf(y[tt] * rstd); }
        }
    }
    if (PASS == 1) { const size_t o = (size_t)(b * 64 + chunk) * 512 + ch; RA[o] = ap; RH[o] = h; }
    if (PASS == 2) __syncthreads();
}

__device__ __forceinline__ void cmp2_item(Frame& F, int item) {
    const int mat = item >> 8, rb = item & 255, lane = F.lane, fr = lane & 15, fq = lane >> 4;
    const int R0 = 16 * rb + fr, R1 = ((R0 & 255) < 255) ? R0 + 1 : R0;
    const bf16_t* P = (const bf16_t*)(F.ws + WS_CP) + (size_t)mat * 4 * 4096 * 512; const float* cb = (const float*)(F.ws + WS_CB1) + mat * 256;
    const bf16_t* W2 = (const bf16_t*)(F.ws + (mat ? WS_CW2VT : WS_CW2KT)) + (size_t)fr * 256 + 8 * fq;
    f32x4 acc[4];
#pragma unroll
    for (int nb = 0; nb < 4; ++nb) acc[nb] = (f32x4){0.f, 0.f, 0.f, 0.f};
#pragma unroll 1
    for (int kp = 0; kp < 4; ++kp) {
        u32x4 pa[2][4], pc[2][4]; bf16x8 wf[2][4]; f32x4 cb0[2], cb1[2];
#pragma unroll
        for (int q = 0; q < 2; ++q) { const int ks = 2 * kp + q, n0 = 32 * ks + 8 * fq;
            cb0[q] = *(const f32x4*)(cb + n0); cb1[q] = *(const f32x4*)(cb + n0 + 4);
#pragma unroll
            for (int k4 = 0; k4 < 4; ++k4) { pa[q][k4] = *(const u32x4*)(P + ((size_t)k4 * 4096 + R0) * 512 + n0); pc[q][k4] = *(const u32x4*)(P + ((size_t)k4 * 4096 + R1) * 512 + 256 + n0); }
#pragma unroll
            for (int nb = 0; nb < 4; ++nb) wf[q][nb] = *(const bf16x8*)(W2 + (size_t)(16 * nb) * 256 + 32 * ks); }
        __builtin_amdgcn_sched_barrier(0);
#pragma unroll
        for (int q = 0; q < 2; ++q) { f32x4 h0 = cb0[q], h1 = cb1[q];
#pragma unroll
            for (int k4 = 0; k4 < 4; ++k4) { const u32x4 a = pa[q][k4], c = pc[q][k4];
                h0 += (f32x4){__builtin_bit_cast(float, a.x << 16), __builtin_bit_cast(float, a.x & 0xffff0000u), __builtin_bit_cast(float, a.y << 16), __builtin_bit_cast(float, a.y & 0xffff0000u)}
                    + (f32x4){__builtin_bit_cast(float, c.x << 16), __builtin_bit_cast(float, c.x & 0xffff0000u), __builtin_bit_cast(float, c.y << 16), __builtin_bit_cast(float, c.y & 0xffff0000u)};
                h1 += (f32x4){__builtin_bit_cast(float, a.z << 16), __builtin_bit_cast(float, a.z & 0xffff0000u), __builtin_bit_cast(float, a.w << 16), __builtin_bit_cast(float, a.w & 0xffff0000u)}
                    + (f32x4){__builtin_bit_cast(float, c.z << 16), __builtin_bit_cast(float, c.z & 0xffff0000u), __builtin_bit_cast(float, c.w << 16), __builtin_bit_cast(float, c.w & 0xffff0000u)}; }
            u32x4 hw; hw.x = pk2(gelu_tanh(h0[0]), gelu_tanh(h0[1])); hw.y = pk2(gelu_tanh(h0[2]), gelu_tanh(h0[3])); hw.z = pk2(gelu_tanh(h1[0]), gelu_tanh(h1[1])); hw.w = pk2(gelu_tanh(h1[2]), gelu_tanh(h1[3]));
            const bf16x8 hb = __builtin_bit_cast(bf16x8, hw);
#pragma unroll
            for (int nb = 0; nb < 4; ++nb) acc[nb] = __builtin_amdgcn_mfma_f32_16x16x32_bf16(wf[q][nb], hb, acc[nb], 0, 0, 0); }
        __builtin_amdgcn_sched_barrier(0);
    }
    const int R = 16 * rb + fr;
    if (mat == 0) { bf16_t* O = (bf16_t*)(F.ws + WS_KCMP) + (size_t)R * 64 + 4 * fq;
#pragma unroll
        for (int nb = 0; nb < 4; ++nb) { u32x2 w; w.x = pk2(acc[nb][0], acc[nb][1]); w.y = pk2(acc[nb][2], acc[nb][3]); *(u32x2*)(O + 16 * nb) = w; }
    } else { const int bg = R >> 8, c = R & 255; bf16_t* O = (bf16_t*)(F.ws + WS_VCMPT) + (size_t)bg * 64 * 256 + c;
#pragma unroll
        for (int nb = 0; nb < 4; ++nb)
#pragma unroll
            for (int e = 0; e < 4; ++e) O[(size_t)(16 * nb + 4 * fq + e) * 256] = (bf16_t)f2bf(acc[nb][e]); }
}

constexpr int AT_BUF = 35840, AT_K1 = 9216, AT_V0 = 18432, AT_V1 = 27136, AT_IMP = 2 * AT_BUF, AT_IMP_BYTES = 8 * 32 * 65 * 4;
constexpr int AT_SELM = AT_IMP + AT_IMP_BYTES, AT_UNION = AT_SELM + 512, AT_SSQ = AT_UNION + 16, AT_SC = AT_SSQ + 1024;
static_assert(AT_SC + 4096 <= LDS_MISC, "attention LDS map");
__device__ __forceinline__ unsigned cvtpk(float lo, float hi) { f32x2_t v = {lo, hi}; bf16x2_t b = __builtin_convertvector(v, bf16x2_t); return __builtin_bit_cast(unsigned, b); }
__device__ __forceinline__ float xor32(float x, int hi) { auto rr = __builtin_amdgcn_permlane32_swap(__builtin_bit_cast(unsigned, x), __builtin_bit_cast(unsigned, x), false, false);
    return __builtin_bit_cast(float, hi ? rr[0] : rr[1]); }
struct TileSrc { const bf16_t* k0; const bf16_t* k1; const bf16_t* v0; const bf16_t* v1; };
__device__ __forceinline__ void at_load(u32x4 (&st)[4], const TileSrc& s, int vpitch, int tid) {
    st[0] = *(const u32x4*)(s.k0 + tid * 8); st[1] = *(const u32x4*)(s.k1 + tid * 8);
    const int dim = tid >> 3, part = tid & 7;
    st[2] = *(const u32x4*)(s.v0 + (size_t)dim * vpitch + part * 8); st[3] = *(const u32x4*)(s.v1 + (size_t)dim * vpitch + part * 8);
}
__device__ __forceinline__ void at_store(LAS unsigned char* buf, const u32x4 (&st)[4], int tid) {
    const int key = tid >> 3, part = tid & 7;
    *(LAS u32x4*)(buf + key * 144 + part * 16) = st[0];
    *(LAS u32x4*)(buf + AT_K1 + key * 144 + part * 16) = st[1];
    LAS unsigned char* v0 = buf + AT_V0 + key * 136 + part * 16; LAS unsigned char* v1 = buf + AT_V1 + key * 136 + part * 16;
    *(LAS u32x2*)(v0) = (u32x2){st[2].x, st[2].y}; *(LAS u32x2*)(v0 + 8) = (u32x2){st[2].z, st[2].w};
    *(LAS u32x2*)(v1) = (u32x2){st[3].x, st[3].y}; *(LAS u32x2*)(v1 + 8) = (u32x2){st[3].z, st[3].w};
}
__device__ __forceinline__ void at_qk(f32x16 (&s)[2], const LAS unsigned char* kb, const bf16x8 (&qf)[4], const bf16x8 qx, const bf16x8 (&kx)[2], int r32, int hi) {
    bf16x8 kf[2][4];
#pragma unroll
    for (int kb2 = 0; kb2 < 2; ++kb2)
#pragma unroll
        for (int ks = 0; ks < 4; ++ks) kf[kb2][ks] = *(const LAS bf16x8*)(kb + (32 * kb2 + r32) * 144 + (16 * ks + 8 * hi) * 2);
    __builtin_amdgcn_sched_barrier(0);
    f32x16 a0 = {}, a1 = {};
    a0 = __builtin_amdgcn_mfma_f32_32x32x16_bf16(kx[0], qx, a0, 0, 0, 0);
    a1 = __builtin_amdgcn_mfma_f32_32x32x16_bf16(kx[1], qx, a1, 0, 0, 0);
#pragma unroll
    for (int ks = 0; ks < 4; ++ks) { a0 = __builtin_amdgcn_mfma_f32_32x32x16_bf16(kf[0][ks], qf[ks], a0, 0, 0, 0); a1 = __builtin_amdgcn_mfma_f32_32x32x16_bf16(kf[1][ks], qf[ks], a1, 0, 0, 0); }
    s[0] = a0; s[1] = a1;
    __builtin_amdgcn_sched_barrier(0);
}
template <int MASK  >
__device__ __forceinline__ void at_keymask(f32x16 (&s)[2], int lim, int hi) {
    if (MASK) { const int limh = lim - 4 * hi;
#pragma unroll
        for (int kb2 = 0; kb2 < 2; ++kb2)
#pragma unroll
            for (int r = 0; r < 16; ++r) { const int kc = 32 * kb2 + (r & 3) + 8 * (r >> 2); const bool ok = (MASK == 1) ? (kc <= limh) : (kc >= limh); s[kb2][r] = ok ? s[kb2][r] : NEGF; } }
}
__device__ __forceinline__ float at_max(const f32x16 (&s)[2], int hi) {
    float mx = fmaxf(s[0][0], s[1][0]);
#pragma unroll
    for (int r = 1; r < 16; ++r) mx = fmaxf(fmaxf(mx, s[0][r]), s[1][r]);
    return fmaxf(mx, xor32(mx, hi));
}
__device__ __forceinline__ void at_pv(f32x16 (&O)[2], const LAS unsigned char* vb, const f32x16 (&p)[2], int r32, int hi) {
    u32x2 vlo[2][2][2], vhi[2][2][2];
#pragma unroll
    for (int kb2 = 0; kb2 < 2; ++kb2)
#pragma unroll
        for (int s2 = 0; s2 < 2; ++s2)
#pragma unroll
            for (int db = 0; db < 2; ++db) { const LAS unsigned char* va = vb + (32 * db + r32) * 136 + (32 * kb2 + 16 * s2 + 4 * hi) * 2;
                vlo[kb2][s2][db] = *(const LAS u32x2*)(va); vhi[kb2][s2][db] = *(const LAS u32x2*)(va + 16); }
    bf16x8 pf[2][2];
#pragma unroll
    for (int kb2 = 0; kb2 < 2; ++kb2)
#pragma unroll
        for (int s2 = 0; s2 < 2; ++s2) { u32x4 pw; pw.x = cvtpk(p[kb2][8 * s2 + 0], p[kb2][8 * s2 + 1]); pw.y = cvtpk(p[kb2][8 * s2 + 2], p[kb2][8 * s2 + 3]); pw.z = cvtpk(p[kb2][8 * s2 + 4], p[kb2][8 * s2 + 5]); pw.w = cvtpk(p[kb2][8 * s2 + 6], p[kb2][8 * s2 + 7]);
            pf[kb2][s2] = __builtin_bit_cast(bf16x8, pw); }
    __builtin_amdgcn_sched_barrier(0);
#pragma unroll
    for (int kb2 = 0; kb2 < 2; ++kb2)
#pragma unroll
        for (int s2 = 0; s2 < 2; ++s2)
#pragma unroll
            for (int db = 0; db < 2; ++db) { const bf16x8 vf = __builtin_bit_cast(bf16x8, (u32x4){vlo[kb2][s2][db].x, vlo[kb2][s2][db].y, vhi[kb2][s2][db].x, vhi[kb2][s2][db].y});
                O[db] = __builtin_amdgcn_mfma_f32_32x32x16_bf16(vf, pf[kb2][s2], O[db], 0, 0, 0); }
    __builtin_amdgcn_sched_barrier(0);
}
__device__ __forceinline__ void at_online(int mode, f32x16 (&s)[2], float& m, float& l, f32x16 (&O)[2], const LAS unsigned char* vb, float ctile, bool rowok, int lim, int r32, int hi) {
    if (mode == 1) at_keymask<1>(s, lim, hi); else if (mode == 2) at_keymask<2>(s, lim, hi);
    const float tmx = at_max(s, hi); const float mt = rowok ? tmx + ctile : NEGF; const float mn = fmaxf(m, mt);
    if (__any(mn > m)) { const float f = __builtin_amdgcn_exp2f(m - mn); l *= f;
#pragma unroll
        for (int db = 0; db < 2; ++db)
#pragma unroll
            for (int r = 0; r < 16; ++r) O[db][r] *= f; }
    m = mn;
    const float shift = rowok ? mn - ctile : __builtin_inff(); float ps = 0.f;
#pragma unroll
    for (int kb2 = 0; kb2 < 2; ++kb2)
#pragma unroll
        for (int r = 0; r < 16; ++r) { const float p = __builtin_amdgcn_exp2f(s[kb2][r] - shift); s[kb2][r] = p; ps += p; }
    l += ps;
    at_pv(O, vb, s, r32, hi);
}

__device__ __forceinline__ void attn_item(Frame& F, int b, int i) {
    const int tid = F.tid, lane = F.lane, h = F.wave, g = h >> 2, r32 = lane & 31, hi = lane >> 5;
    const int q0 = 32 * i, tq = q0 + r32; const size_t row = (size_t)b * SEQ + tq;
    LAS unsigned char* lds = F.lds;
    LAS float* IMP = (LAS float*)(lds + AT_IMP); LAS unsigned long long* SELM = (LAS unsigned long long*)(lds + AT_SELM);
    LAS unsigned* UNI = (LAS unsigned*)(lds + AT_UNION); LAS float* SSQ = (LAS float*)(lds + AT_SSQ); LAS float* SC = (LAS float*)(lds + AT_SC);
    const bf16_t* Qp = (const bf16_t*)(F.ws + WS_Q) + row * 512 + h * 64 + 8 * hi;
    bf16x8 qf[4];
#pragma unroll
    for (int ks = 0; ks < 4; ++ks) qf[ks] = *(const bf16x8*)(Qp + 16 * ks);
    const float slope2 = __builtin_amdgcn_exp2f(-(float)(h + 1)) * LOG2E;
    bf16x8 qx, qx16, kx[2];
    { const unsigned s_hi = f2bf(slope2); const float rem = slope2 - __builtin_bit_cast(float, s_hi << 16); const unsigned w1 = hi ? 0u : (s_hi | (f2bf(rem) << 16));
      const float sl16 = 16.0f * slope2; const unsigned t_hi = f2bf(sl16); const float rem16 = sl16 - __builtin_bit_cast(float, t_hi << 16); const unsigned w16 = hi ? 0u : (t_hi | (f2bf(rem16) << 16));
      qx = __builtin_bit_cast(bf16x8, (u32x4){w1, 0u, 0u, 0u}); qx16 = __builtin_bit_cast(bf16x8, (u32x4){w16, 0u, 0u, 0u});
#pragma unroll
      for (int kb2 = 0; kb2 < 2; ++kb2) { const unsigned kk = f2bf((float)(32 * kb2 + r32)); kx[kb2] = __builtin_bit_cast(bf16x8, (u32x4){hi ? 0u : (kk | (kk << 16)), 0u, 0u, 0u}); } }
    const float* GT = (const float*)(F.ws + WS_GATE) + row * 24; const float gate_c = GT[h], gate_s = GT[8 + h], gate_w = GT[16 + h];
    f32x16 out[2]; out[0] = f32x16{}; out[1] = f32x16{};
    if (tid < 4) UNI[tid] = 0u;
    const int koff = g ? AT_K1 : 0, voff = g ? AT_V1 : AT_V0;
    const size_t bg0 = (size_t)b * 2;
    u32x4 st[4];
    const bf16_t* KVb = (const bf16_t*)(F.ws + WS_KV);
    const int jhi = q0 >> 6, dlim = tq - 64 * jhi;
#define KV_SRC(kidx, j) TileSrc{KVb + (size_t)(kidx) * (KV_STRIDE / 2) + ((bg0 + 0) * 4096 + 64 * (j)) * 64, KVb + (size_t)(kidx) * (KV_STRIDE / 2) + ((bg0 + 1) * 4096 + 64 * (j)) * 64, \
        KVb + (size_t)((kidx) + 1) * (KV_STRIDE / 2) + (bg0 + 0) * 64 * 4096 + 64 * (j), KVb + (size_t)((kidx) + 1) * (KV_STRIDE / 2) + (bg0 + 1) * 64 * 4096 + 64 * (j)}
    const bf16_t* KC = (const bf16_t*)(F.ws + WS_KCMP); const bf16_t* VC = (const bf16_t*)(F.ws + WS_VCMPT);
    const int nc = (i >> 5) + 1;
#define CMP_SRC(jc) TileSrc{KC + ((bg0 + 0) * 256 + 64 * (jc)) * 64, KC + ((bg0 + 1) * 256 + 64 * (jc)) * 64, VC + (bg0 + 0) * 64 * 256 + 64 * (jc), VC + (bg0 + 1) * 64 * 256 + 64 * (jc)}
    float m = NEGF, l = 0.f;
    {
        f32x16 O[2]; O[0] = f32x16{}; O[1] = f32x16{}; float carry = 0.f; float mref[4] = {0.f, 0.f, 0.f, 0.f};
        { at_load(st, CMP_SRC(0), 256, tid); at_store(lds, st, tid); __syncthreads(); }
#pragma unroll
        for (int jc = 0; jc < 4; ++jc) { if (jc < nc) {
            LAS unsigned char* buf = lds + (jc & 1) * AT_BUF; const bool more = jc + 1 < nc;
            if (more) at_load(st, CMP_SRC(jc + 1), 256, tid); else at_load(st, KV_SRC(2, jhi), 4096, tid);
            f32x16 s[2]; at_qk(s, buf + koff, qf, qx16, kx, r32, hi);
            const float mprev = m;
            at_online((jc + 2 >= nc) ? 1 : 0, s, m, l, O, buf + voff, slope2 * (float)(1024 * jc + 31 - tq), true, ((tq - 31) >> 4) - 64 * jc, r32, hi);
            mref[jc] = m; carry *= __builtin_amdgcn_exp2f(mprev - m);
            float sum4[8], recv[8];
#pragma unroll
            for (int g8 = 0; g8 < 8; ++g8) { const int kb2 = g8 >> 2, qq = g8 & 3; sum4[g8] = (s[kb2][4 * qq] + s[kb2][4 * qq + 1]) + (s[kb2][4 * qq + 2] + s[kb2][4 * qq + 3]); recv[g8] = xor32(s[kb2][4 * qq + 3], hi); }
#pragma unroll
            for (int g8 = 0; g8 < 8; ++g8) { const float extra = hi ? recv[g8] : (g8 ? recv[g8 > 0 ? g8 - 1 : 0] : carry);
                IMP[(h * 32 + r32) * 65 + 16 * jc + 2 * g8 + hi] = sum4[g8] + extra; }
            carry = recv[7];
            if (more) at_store(lds + ((jc + 1) & 1) * AT_BUF, st, tid);
            __syncthreads();
        } }
        const float ltot = l + xor32(l, hi); const float inv = (tq >= 31) ? __builtin_amdgcn_rcpf(ltot) : 0.f;
        if (hi == 0) {
#pragma unroll
            for (int jc = 0; jc < 4; ++jc) SC[(h * 32 + r32) * 4 + jc] = (jc < nc) ? __builtin_amdgcn_exp2f(mref[jc] - m) * inv : 0.f; }
        const float oc = gate_c * inv;
#pragma unroll
        for (int db = 0; db < 2; ++db)
#pragma unroll
            for (int r = 0; r < 16; ++r) out[db][r] = oc * O[db][r];
        __syncthreads();
    }
#undef CMP_SRC
    LAS float* PARK = (LAS float*)(lds + AT_IMP) + (size_t)h * 2048 + lane;
    {
        unsigned long long un0 = 0ull, un1 = 0ull;
        for (int pp = 0; pp < 8; ++pp) { const int g2 = pp >> 2, q = 4 * h + (pp & 3), t = q0 + q, cur_t = t >> 6;
            float v = 0.f;
#pragma unroll
            for (int hh = 0; hh < 4; ++hh) v += IMP[((4 * g2 + hh) * 32 + q) * 65 + lane] * SC[((4 * g2 + hh) * 32 + q) * 4 + (lane >> 4)];
            const bool forced = (lane == 0) || (lane == cur_t) || (lane == cur_t - 1), vis = lane <= cur_t;
            const unsigned key = forced ? (0x7f000000u | (unsigned)(63 - lane)) : (vis ? ((__builtin_bit_cast(unsigned, v) & ~63u) | (unsigned)(63 - lane)) : 0u);
            int rank = 0;
            if (cur_t >= 16) {
#pragma unroll
                for (int jj = 0; jj < 32; ++jj) { const unsigned o = (unsigned)__builtin_amdgcn_readlane((int)key, jj); rank += (o > key) ? 1 : 0; }
                if (cur_t >= 32) {
#pragma unroll
                    for (int jj = 32; jj < 48; ++jj) { const unsigned o = (unsigned)__builtin_amdgcn_readlane((int)key, jj); rank += (o > key) ? 1 : 0; }
                    if (cur_t >= 48) {
#pragma unroll
                        for (int jj = 48; jj < 64; ++jj) { const unsigned o = (unsigned)__builtin_amdgcn_readlane((int)key, jj); rank += (o > key) ? 1 : 0; } } } }
            const unsigned long long mask = __ballot((rank < 16) && vis);
            if (lane == 0) SELM[g2 * 32 + q] = mask;
            if (g2) un1 |= mask; else un0 |= mask; }
        if (lane == 0) { atomicOr((unsigned*)&UNI[0], (unsigned)un0); atomicOr((unsigned*)&UNI[1], (unsigned)(un0 >> 32)); atomicOr((unsigned*)&UNI[2], (unsigned)un1); atomicOr((unsigned*)&UNI[3], (unsigned)(un1 >> 32)); }
        __syncthreads();
    }
#pragma unroll
    for (int db = 0; db < 2; ++db)
#pragma unroll
        for (int r = 0; r < 16; ++r) PARK[(db * 16 + r) * 64] = out[db][r];
    {
        const unsigned u0 = __builtin_amdgcn_readfirstlane(UNI[0]), u1 = __builtin_amdgcn_readfirstlane(UNI[1]), u2 = __builtin_amdgcn_readfirstlane(UNI[2]), u3 = __builtin_amdgcn_readfirstlane(UNI[3]);
        const unsigned long long U0 = ((unsigned long long)u1 << 32) | u0, U1 = ((unsigned long long)u3 << 32) | u2, Ug = g ? U1 : U0;
        unsigned long long rem = U0 | U1;
        const unsigned long long mysel = SELM[g * 32 + r32];
        m = NEGF; l = 0.f; f32x16 O[2]; O[0] = f32x16{}; O[1] = f32x16{};
        int j = 63 - __builtin_clzll(rem); rem &= ~(1ull << j);
        { at_store(lds, st, tid); __syncthreads(); }
        int par = 0;
        for (;;) {
            LAS unsigned char* buf = lds + par * AT_BUF; const bool more = rem != 0ull; const int jn = more ? 63 - __builtin_clzll(rem) : 0; rem &= ~(1ull << jn);
            if (more) at_load(st, KV_SRC(2, jn), 4096, tid); else at_load(st, KV_SRC(4, jhi), 4096, tid);
            if ((Ug >> j) & 1ull) { f32x16 s[2]; at_qk(s, buf + koff, qf, qx, kx, r32, hi);
                const float ctile = slope2 * (float)(64 * j - tq); const bool rowok = ((mysel >> j) & 1ull) != 0ull;
                at_online(j == jhi ? 1 : 0, s, m, l, O, buf + voff, ctile, rowok, dlim, r32, hi); }
            if (more) at_store(lds + (par ^ 1) * AT_BUF, st, tid);
            __syncthreads();
            if (!more) break;
            j = jn; par ^= 1;
        }
        const float ltot = l + xor32(l, hi); const float sc = gate_s * __builtin_amdgcn_rcpf(ltot);
#pragma unroll
        for (int db = 0; db < 2; ++db)
#pragma unroll
            for (int r = 0; r < 16; ++r) PARK[(db * 16 + r) * 64] += sc * O[db][r];
    }
    {
        int jlo = (q0 - 511) >> 6; if (jlo < 0) jlo = 0;
        const int llim = tq - 511 - 64 * jlo;
        m = NEGF; l = 0.f; f32x16 O[2]; O[0] = f32x16{}; O[1] = f32x16{};
        { at_store(lds, st, tid); __syncthreads(); }
        for (int j = jhi; j >= jlo; --j) {
            LAS unsigned char* buf = lds + ((jhi - j) & 1) * AT_BUF; const bool more = j > jlo;
            if (more) at_load(st, KV_SRC(4, j - 1), 4096, tid);
            f32x16 s[2]; at_qk(s, buf + koff, qf, qx, kx, r32, hi);
            const float ctile = slope2 * (float)(64 * j - tq);
            at_online(j == jhi ? 1 : (j == jlo ? 2 : 0), s, m, l, O, buf + voff, ctile, true, j == jhi ? dlim : llim, r32, hi);
            if (more) at_store(lds + ((jhi - j + 1) & 1) * AT_BUF, st, tid);
            __syncthreads();
        }
        const float ltot = l + xor32(l, hi); const float sc = gate_w * __builtin_amdgcn_rcpf(ltot);
#pragma unroll
        for (int db = 0; db < 2; ++db)
#pragma unroll
            for (int r = 0; r < 16; ++r) out[db][r] = PARK[(db * 16 + r) * 64] + sc * O[db][r];
    }
#undef KV_SRC
    {
        float ss = 0.f;
#pragma unroll
        for (int db = 0; db < 2; ++db)
#pragma unroll
            for (int r = 0; r < 16; ++r) ss += out[db][r] * out[db][r];
        ss += xor32(ss, hi);
        if (hi == 0) SSQ[h * 32 + r32] = ss;
        __syncthreads();
        float tot = 0.f;
#pragma unroll
        for (int hh = 0; hh < 8; ++hh) tot += SSQ[hh * 32 + r32];
        const float rstd = rsqrtf(tot * (1.0f / 512.0f) + EPS);
        bf16_t* yp = (bf16_t*)(F.ws + WS_YCAT) + row * 1024 + 512 + h * 64 + 4 * hi;
#pragma unroll
        for (int db = 0; db < 2; ++db)
#pragma unroll
            for (int qq = 0; qq < 4; ++qq) { u32x2 w; w.x = cvtpk(out[db][4 * qq] * rstd, out[db][4 * qq + 1] * rstd); w.y = cvtpk(out[db][4 * qq + 2] * rstd, out[db][4 * qq + 3] * rstd);
                *(u32x2*)(yp + 32 * db + 8 * qq) = w; }
        __syncthreads();
    }
}

__global__ void __launch_bounds__(512) hybrid_fwd(Args args) {
    extern __shared__ __attribute__((aligned(16))) unsigned char lds_raw[];
    cg::grid_group grid = cg::this_grid();
    Frame F; F.lds = (LAS unsigned char*)lds_raw; F.tid = threadIdx.x; F.lane = F.tid & 63; F.wave = __builtin_amdgcn_readfirstlane(F.tid >> 6);
    F.G = gridDim.x; F.bid = blockIdx.x; F.ws = args.ws; F.in = args.in;
    unsigned char* ws = args.ws;
    volatile LAS unsigned* MISC = (volatile LAS unsigned*)(F.lds + LDS_MISC);
    if (F.tid < 2) MISC[F.tid] = 0u;
    __syncthreads();
    XcdBarrier xbar = xcd_barrier_post((unsigned*)ws, MISC);
    const int wave_u = __builtin_amdgcn_readfirstlane((int)threadIdx.x >> 6);
#define FRESH_TID() fresh_tid2(wave_u)
#define REFRESH() do { F.tid = FRESH_TID(); F.lane = F.tid & 63; F.wave = wave_u; } while (0)
#ifdef PROBE_A
    int nst_ = 0; unsigned long long* tsb_ = (unsigned long long*)(ws + 32768);
#define STAMP() do { if (blockIdx.x == 0 && threadIdx.x == 0) tsb_[nst_] = __builtin_amdgcn_s_memrealtime(); ++nst_; } while (0)
#else
#define STAMP() do {} while (0)
#endif
    STAMP();
#define GRID_BAR() do { xcd_barrier(xbar); REFRESH(); STAMP(); } while (0)
#define GRID_BAR_CG() do { grid.sync(); REFRESH(); STAMP(); } while (0)
    p0_prologue(F);
#ifdef DUP_P0
    __syncthreads(); REFRESH(); p0_prologue(F);
#endif
    if (args.ws == nullptr) grid.sync();
    GRID_BAR();
#ifdef DUP_BAR
    GRID_BAR(); GRID_BAR(); GRID_BAR(); GRID_BAR(); GRID_BAR(); GRID_BAR(); GRID_BAR(); GRID_BAR(); GRID_BAR(); GRID_BAR();
#endif
    p1_rows(F);
#ifdef DUP_P1
    __syncthreads(); REFRESH(); p1_rows(F);
#endif
    GRID_BAR();
    { pg8::Gemm g{(const bf16_t*)(ws + WS_H), (const bf16_t*)(ws + WS_WINT), M, NZ, DM, DM, DM}; pg8::StaticOrder S; S.init(M, NZ, F.G, F.bid);
      EpiZ E{ws}; pg8::gemm_phase<EpiZ, pg8::StaticOrder>(F.lds, g, S, E, FRESH_TID()); }
#ifdef DUP_P2
    __syncthreads(); REFRESH();
    { pg8::Gemm g{(const bf16_t*)(ws + WS_H), (const bf16_t*)(ws + WS_WINT), M, NZ, DM, DM, DM}; pg8::StaticOrder S; S.init(M, NZ, F.G, F.bid);
      EpiZ E{ws}; pg8::gemm_phase<EpiZ, pg8::StaticOrder>(F.lds, g, S, E, FRESH_TID()); }
#endif
    GRID_BAR();
    { for (int n = F.bid; n < 256; n += F.G) { const int mat = n >> 7, pm = (n >> 3) & 15, pn = (n >> 2) & 1, ks = n & 3;
        pg8::Gemm g{(const bf16_t*)(ws + WS_KV + (size_t)mat * KV_STRIDE) + (size_t)pm * 256 * 1024 + ks * 256,
                    (const bf16_t*)(ws + (mat ? WS_CW1VT : WS_CW1KT)) + pn * 1024 + ks * 256, 256, 256, 256, 1024, 2048};
        EpiBf16<0> E{(bf16_t*)(ws + WS_CP) + ((size_t)(mat * 4 + ks) * 4096 + pm * 256) * 512 + pn * 256, 512, nullptr};
        pg8::gemm_phase<EpiBf16<0>, pg8::OneUnit>(F.lds, g, pg8::OneUnit{}, E, FRESH_TID()); }
      __syncthreads(); REFRESH();
      for (int it = F.bid; it < 512; it += F.G) rnn_item<1>(F, it >> 6, it & 63); }
#ifdef DUP_P3
    __syncthreads(); REFRESH();
    { for (int n = F.bid; n < 256; n += F.G) { const int mat = n >> 7, pm = (n >> 3) & 15, pn = (n >> 2) & 1, ks = n & 3;
        pg8::Gemm g{(const bf16_t*)(ws + WS_KV + (size_t)mat * KV_STRIDE) + (size_t)pm * 256 * 1024 + ks * 256,
                    (const bf16_t*)(ws + (mat ? WS_CW1VT : WS_CW1KT)) + pn * 1024 + ks * 256, 256, 256, 256, 1024, 2048};
        EpiBf16<0> E{(bf16_t*)(ws + WS_CP) + ((size_t)(mat * 4 + ks) * 4096 + pm * 256) * 512 + pn * 256, 512, nullptr};
        pg8::gemm_phase<EpiBf16<0>, pg8::OneUnit>(F.lds, g, pg8::OneUnit{}, E, FRESH_TID()); }
      __syncthreads(); REFRESH();
      for (int it = F.bid; it < 512; it += F.G) rnn_item<1>(F, it >> 6, it & 63); }
#endif
    GRID_BAR();
    { const int gw = F.bid * 8 + F.wave, NGW = F.G * 8;
      for (int it = gw; it < 512 + 64; it += NGW) {
          if (it < 512) { cmp2_item(F, it); continue; }
          const int r = it - 512, b = r >> 3, ch = 64 * (r & 7) + F.lane; const float* RA = (const float*)(ws + WS_RA); const float* RH = (const float*)(ws + WS_RH); float* HIN = (float*)(ws + WS_RHIN);
          float h = 0.f;
#pragma unroll 32
          for (int c = 0; c < 64; ++c) { const size_t o = (size_t)(b * 64 + c) * 512 + ch; const float a = RA[o], hh = RH[o]; HIN[o] = h; h = a * h + hh; } } }
#ifdef DUP_P4
    __syncthreads(); REFRESH();
    { const int gw = F.bid * 8 + F.wave, NGW = F.G * 8;
      for (int it = gw; it < 512 + 64; it += NGW) {
          if (it < 512) { cmp2_item(F, it); continue; }
          const int r = it - 512, b = r >> 3, ch = 64 * (r & 7) + F.lane; const float* RA = (const float*)(ws + WS_RA); const float* RH = (const float*)(ws + WS_RH); float* HIN = (float*)(ws + WS_RHIN);
          float h = 0.f;
#pragma unroll 32
          for (int c = 0; c < 64; ++c) { const size_t o = (size_t)(b * 64 + c) * 512 + ch; const float a = RA[o], hh = RH[o]; HIN[o] = h; h = a * h + hh; } } }
#endif
    GRID_BAR();
    { for (int n = F.bid; n < 1024; n += F.G) { const int k = n >> 8, c = n & 255, b = c & 7, r = c >> 3;     const int i = (k == 0) ? r : (k == 1) ? 63 - r : (k == 2) ? 64 + r : 127 - r; attn_item(F, b, i); }
#ifdef DUP_ATT
      __syncthreads(); REFRESH();
      for (int n = F.bid; n < 1024; n += F.G) { const int k = n >> 8, c = n & 255, b = c & 7, r = c >> 3; const int i = (k == 0) ? r : (k == 1) ? 63 - r : (k == 2) ? 64 + r : 127 - r; attn_item(F, b, i); }
#endif
      __syncthreads();
      for (int it = F.bid; it < 512; it += F.G) rnn_item<2>(F, it >> 6, it & 63);
#ifdef DUP_RNN2
      __syncthreads(); REFRESH();
      for (int it = F.bid; it < 512; it += F.G) rnn_item<2>(F, it >> 6, it & 63);
#endif
    }
#ifdef DUP_P5
    __syncthreads(); REFRESH();
    { for (int n = F.bid; n < 1024; n += F.G) { const int k = n >> 8, c = n & 255, b = c & 7, r = c >> 3;     const int i = (k == 0) ? r : (k == 1) ? 63 - r : (k == 2) ? 64 + r : 127 - r; attn_item(F, b, i); }
      __syncthreads();
      for (int it = F.bid; it < 512; it += F.G) rnn_item<2>(F, it >> 6, it & 63);
#endif
    GRID_BAR();
    { pg8::Gemm g{(const bf16_t*)(ws + WS_YCAT), (const bf16_t*)(ws + WS_WOUTT), M, DM, DM, DM, DM}; pg8::StaticOrder S; S.init(M, DM, F.G, F.bid);
      EpiBf16<0> E{(bf16_t*)(ws + WS_Y), DM, nullptr}; pg8::gemm_phase<EpiBf16<0>, pg8::StaticOrder>(F.lds, g, S, E, FRESH_TID()); }
#ifdef DUP_P6
    __syncthreads(); REFRESH();
    { pg8::Gemm g{(const bf16_t*)(ws + WS_YCAT), (const bf16_t*)(ws + WS_WOUTT), M, DM, DM, DM, DM}; pg8::StaticOrder S; S.init(M, DM, F.G, F.bid);
      EpiBf16<0> E{(bf16_t*)(ws + WS_Y), DM, nullptr}; pg8::gemm_phase<EpiBf16<0>, pg8::StaticOrder>(F.lds, g, S, E, FRESH_TID()); }
#endif
    GRID_BAR();
    p7_rows(F);
#ifdef DUP_P7
    __syncthreads(); REFRESH(); p7_rows(F);
#endif
    GRID_BAR();
    { pg8::Gemm g{(const bf16_t*)(ws + WS_H), (const bf16_t*)(ws + WS_WFF1T), M, DFF, DM, DM, DM}; pg8::StaticOrder S; S.init(M, DFF, F.G, F.bid);
      EpiBf16<1> E{(bf16_t*)(ws + WS_HID), DFF, nullptr}; pg8::gemm_phase<EpiBf16<1>, pg8::StaticOrder>(F.lds, g, S, E, FRESH_TID()); }
#ifdef DUP_P8
    __syncthreads(); REFRESH();
    { pg8::Gemm g{(const bf16_t*)(ws + WS_H), (const bf16_t*)(ws + WS_WFF1T), M, DFF, DM, DM, DM}; pg8::StaticOrder S; S.init(M, DFF, F.G, F.bid);
      EpiBf16<1> E{(bf16_t*)(ws + WS_HID), DFF, nullptr}; pg8::gemm_phase<EpiBf16<1>, pg8::StaticOrder>(F.lds, g, S, E, FRESH_TID()); }
#endif
    GRID_BAR();
    { pg8::Gemm g{(const bf16_t*)(ws + WS_HID), (const bf16_t*)(ws + WS_WFF2T), M, DM, DFF, DFF, DFF}; pg8::StaticOrder S; S.init(M, DM, F.G, F.bid);
      EpiBf16<0> E{(bf16_t*)(ws + WS_Y2), DM, nullptr}; pg8::gemm_phase<EpiBf16<0>, pg8::StaticOrder>(F.lds, g, S, E, FRESH_TID()); }
#ifdef DUP_P9
    __syncthreads(); REFRESH();
    { pg8::Gemm g{(const bf16_t*)(ws + WS_HID), (const bf16_t*)(ws + WS_WFF2T), M, DM, DFF, DFF, DFF}; pg8::StaticOrder S; S.init(M, DM, F.G, F.bid);
      EpiBf16<0> E{(bf16_t*)(ws + WS_Y2), DM, nullptr}; pg8::gemm_phase<EpiBf16<0>, pg8::StaticOrder>(F.lds, g, S, E, FRESH_TID()); }
#endif
    GRID_BAR();
    p10_rows(F, args.out);
#ifdef DUP_P10
    __syncthreads(); REFRESH(); p10_rows(F, args.out);
#endif
#ifdef PROBE_A
    GRID_BAR();
    { const float Ta = (float)(tsb_[PROBE_A + 1] - tsb_[PROBE_A]) * 0.01f, Tb = (float)(tsb_[PROBE_B + 1] - tsb_[PROBE_B]) * 0.01f;
      if (blockIdx.x == 0 && threadIdx.x == 0) args.out[0] += Ta;
      for (int idx = 1024 + blockIdx.x * 512 + threadIdx.x; idx < 1024 + (1 << 20); idx += gridDim.x * 512) args.out[idx] += Tb * 0.01f; }
#endif
}

extern "C" void kernel_launch(void* const* d_in, const int* in_sizes, int n_in, void* d_out, int out_size, void* d_ws, size_t ws_size, hipStream_t stream) {
    static int grid = 0;
    if (grid == 0) {
        if (n_in != 27 || out_size != M * DM || ws_size < WS_END) { fprintf(stderr, "kernel_launch: unexpected problem (n_in %d out %d ws %zu)\n", n_in, out_size, ws_size); grid = -1; return; }
        int dev = 0, cus = 0, per_cu = 0;
        (void)hipGetDevice(&dev); (void)hipDeviceGetAttribute(&cus, hipDeviceAttributeMultiprocessorCount, dev);
        (void)hipFuncSetAttribute((const void*)hybrid_fwd, hipFuncAttributeMaxDynamicSharedMemorySize, LDS_BYTES);
        if (hipOccupancyMaxActiveBlocksPerMultiprocessor(&per_cu, (const void*)hybrid_fwd, 512, LDS_BYTES) != hipSuccess || per_cu < 1) per_cu = 1;
        (void)hipGetLastError();
        grid = cus * 1;
        fprintf(stderr, "kernel_launch: grid %d (per_cu %d)\n", grid, per_cu);
    }
    if (grid < 0) return;
    (void)hipMemsetAsync(d_ws, 0, 16384, stream);
    Args a{};
    for (int i = 0; i < 27; ++i) a.in[i] = (const float*)d_in[i];
    a.out = (float*)d_out; a.ws = (unsigned char*)d_ws;
    void* kargs[] = {&a};
    hipError_t e = hipLaunchCooperativeKernel((const void*)hybrid_fwd, dim3(grid), dim3(512), kargs, LDS_BYTES, stream);
    if (e != hipSuccess) fprintf(stderr, "kernel_launch: cooperative launch failed: %s\n", hipGetErrorString(e));
}
```
